# Optimizing an MI355X kernel written in HIP

```python
import math
import jax, jax.numpy as jnp
from jax import lax
import numpy as np

D_MODEL = 1024
BATCH = 8
SEQ = 2048
DEPTH = 2

MIX_WIDTH = D_MODEL
HEAD_DIM = 64
A_WIDTH = MIX_WIDTH // 2
B_WIDTH = MIX_WIDTH - A_WIDTH
A_GROUPS = A_WIDTH // HEAD_DIM
B_HEADS = B_WIDTH // HEAD_DIM
IN_COLS = 2 * A_WIDTH + 3 * B_WIDTH
CHUNK = 128
DILATED_CONFIGS = ((128, 1), (512, 4), (2048, 16))
ATTN_BLOCK = 128
REL_BUCKETS = 32
REL_MAX_EXACT = REL_BUCKETS // 2
REL_MAX_DISTANCE = 2048
N_EXPERTS = 16
N_EXPERT_GROUPS = 4
EXPERTS_PER_GROUP = N_EXPERTS // N_EXPERT_GROUPS
TOP_K = 2
D_EXPERT = D_MODEL // 2
N_MOD = 6
EPS = 1e-6
NEG_INF = -1e30

kernel_name = "hybrid_gmlp_dilated_attn_grouped_moe"


def rms_norm(x, g):
    xf = x.astype(jnp.float32)
    y = xf * lax.rsqrt(jnp.mean(xf * xf, axis=-1, keepdims=True) + EPS)
    return (y * g.astype(jnp.float32)).astype(x.dtype)


def layer_norm(x, g, b):
    xf = x.astype(jnp.float32)
    mu = jnp.mean(xf, axis=-1, keepdims=True)
    xc = xf - mu
    y = xc * lax.rsqrt(jnp.mean(xc * xc, axis=-1, keepdims=True) + EPS)
    return (y * g.astype(jnp.float32) + b.astype(jnp.float32)).astype(x.dtype)


def t5_bucket_np(dist):
    dist = np.maximum(dist, 0)
    ratio = np.log(np.maximum(dist, 1) / REL_MAX_EXACT) / np.log(REL_MAX_DISTANCE / REL_MAX_EXACT)
    large = REL_MAX_EXACT + np.floor(ratio * (REL_BUCKETS - REL_MAX_EXACT)).astype(np.int64)
    large = np.minimum(large, REL_BUCKETS - 1)
    return np.where(dist < REL_MAX_EXACT, dist, large).astype(np.int32)


def chunked_spatial_gating(u, v, ln_g, ln_b, w_s, b_s):
    B, S, _ = u.shape
    v = layer_norm(v, ln_g, ln_b)
    vc = v.reshape(B, S // CHUNK, CHUNK, A_GROUPS, HEAD_DIM)
    causal = jnp.tril(jnp.ones((CHUNK, CHUNK), dtype=w_s.dtype))
    s = jnp.einsum('gts,bnsge->bntge', w_s * causal, vc) + b_s.T[None, None, :, :, None]
    return u * s.reshape(B, S, A_WIDTH)


def dilated_window_attention(q, k, v, rel_bias, window, dilation):
    B, S, H, Dh = q.shape
    d = dilation
    L = S // d
    span = window // d
    blk = ATTN_BLOCK
    nb = -(-L // blk)
    Lp = nb * blk

    def gather(t):
        t = t.reshape(B, L, d, H, Dh).transpose(0, 2, 1, 3, 4)
        return jnp.pad(t, ((0, 0), (0, 0), (0, Lp - L), (0, 0), (0, 0)))

    def band(t):
        tb = t.reshape(B, d, nb, blk, H, Dh)
        prev = jnp.pad(tb, ((0, 0), (0, 0), (1, 0), (0, 0), (0, 0), (0, 0)))[:, :, :-1]
        return jnp.concatenate([prev, tb], axis=3)

    qb = gather(q).reshape(B, d, nb, blk, H, Dh).astype(jnp.float32)
    kb = band(gather(k)).astype(jnp.float32)
    vb = band(gather(v)).astype(jnp.float32)
    scores = jnp.einsum('brnqhe,brnkhe->brnhqk', qb, kb)

    qi = np.arange(blk)[:, None]
    kj = np.arange(2 * blk)[None, :]
    rel = qi + blk - kj
    bucket = t5_bucket_np(np.clip(rel, 0, span) * d)
    bias = jnp.transpose(rel_bias.astype(jnp.float32)[bucket], (2, 0, 1))
    key_pos = np.arange(nb)[:, None, None] * blk + kj[None] - blk
    valid = ((rel >= 0) & (rel <= span))[None] & (key_pos >= 0)
    scores = jnp.where(valid[None, None, :, None], scores + bias, NEG_INF)

    lse = jax.nn.logsumexp(scores, axis=-1)
    p = jnp.exp(scores - lse[..., None])
    o = jnp.einsum('brnhqk,brnkhe->brnqhe', p, vb)
    o = o.reshape(B, d, Lp, H, Dh)[:, :, :L].transpose(0, 2, 1, 3, 4).reshape(B, S, H, Dh)
    lse = lse.transpose(0, 1, 2, 4, 3).reshape(B, d, Lp, H)[:, :, :L]
    lse = lse.transpose(0, 2, 1, 3).reshape(B, S, H)
    return o, lse


def dilated_mixture_attention(q, k, v, rel_bias):
    B, S, _ = q.shape
    q = q.reshape(B, S, B_HEADS, HEAD_DIM) * (HEAD_DIM ** -0.5)
    k = k.reshape(B, S, B_HEADS, HEAD_DIM)
    v = v.reshape(B, S, B_HEADS, HEAD_DIM)
    outs, lses = [], []
    for window, dilation in DILATED_CONFIGS:
        o, lse = dilated_window_attention(q, k, v, rel_bias, window, dilation)
        outs.append(o)
        lses.append(lse)
    w = jax.nn.softmax(jnp.stack(lses, axis=0), axis=0)
    o = jnp.sum(w[..., None] * jnp.stack(outs, axis=0), axis=0)
    return o.reshape(B, S, B_WIDTH).astype(v.dtype)


def grouped_top2_moe(h, router_w, router_b, w_gate, w_up, w_down):
    B, S, D = h.shape
    t = h.reshape(-1, D)
    probs = jax.nn.softmax((t @ router_w).astype(jnp.float32), axis=-1)
    sel = probs + router_b.astype(jnp.float32)
    grp = sel.reshape(-1, N_EXPERT_GROUPS, EXPERTS_PER_GROUP)
    grp_score = jnp.sum(lax.top_k(grp, TOP_K)[0], axis=-1)
    best = jnp.argmax(grp_score, axis=-1)
    in_group = (jnp.arange(N_EXPERTS) // EXPERTS_PER_GROUP)[None, :] == best[:, None]
    _, idx = lax.top_k(jnp.where(in_group, sel, NEG_INF), TOP_K)
    g = jnp.take_along_axis(probs, idx, axis=-1)
    g = g / jnp.sum(g, axis=-1, keepdims=True)
    gates = jnp.sum(jax.nn.one_hot(idx, N_EXPERTS, dtype=jnp.float32) * g[..., None], axis=1)
    hg = jnp.einsum('td,edf->tef', t, w_gate)
    hu = jnp.einsum('td,edf->tef', t, w_up)
    act = jax.nn.silu(hg) * hu * gates[:, :, None].astype(hu.dtype)
    y = jnp.einsum('tef,efd->td', act, w_down)
    return y.reshape(B, S, D)


def setup_inputs(seed: int = 0) -> dict:
    key = jax.random.key(seed)
    ks = jax.random.split(key, 24)
    f32 = jnp.float32
    nrm = lambda k, shape, s: (jax.random.normal(k, shape, f32) * s)
    return {
        "x": nrm(ks[0], (BATCH, SEQ, D_MODEL), 1.0),
        "c": nrm(ks[1], (BATCH, D_MODEL), 1.0),
        "rel_bias": nrm(ks[2], (REL_BUCKETS, B_HEADS), 0.5),
        "router_w": nrm(ks[3], (D_MODEL, N_EXPERTS), D_MODEL ** -0.5),
        "router_b": nrm(ks[4], (N_EXPERTS,), 0.01),
        "mod_w": nrm(ks[5], (DEPTH, D_MODEL, N_MOD * D_MODEL), 0.5 * D_MODEL ** -0.5),
        "mod_b": nrm(ks[6], (DEPTH, N_MOD * D_MODEL), 0.02),
        "norm1_g": 1.0 + nrm(ks[7], (DEPTH, D_MODEL), 0.05),
        "w_in": nrm(ks[8], (DEPTH, D_MODEL, IN_COLS), D_MODEL ** -0.5),
        "gmlp_ln_g": 1.0 + nrm(ks[9], (DEPTH, A_WIDTH), 0.05),
        "gmlp_ln_b": nrm(ks[10], (DEPTH, A_WIDTH), 0.02),
        "gmlp_ws": nrm(ks[11], (DEPTH, A_GROUPS, CHUNK, CHUNK), CHUNK ** -0.5),
        "gmlp_bs": 1.0 + nrm(ks[12], (DEPTH, A_GROUPS, CHUNK), 0.1),
        "out_norm_a_g": 1.0 + nrm(ks[13], (DEPTH, A_WIDTH), 0.05),
        "out_norm_b_g": 1.0 + nrm(ks[14], (DEPTH, B_WIDTH), 0.05),
        "w_out": nrm(ks[15], (DEPTH, MIX_WIDTH, D_MODEL), MIX_WIDTH ** -0.5),
        "norm2_g": 1.0 + nrm(ks[16], (DEPTH, D_MODEL), 0.05),
        "moe_w_gate": nrm(ks[17], (DEPTH, N_EXPERTS, D_MODEL, D_EXPERT), D_MODEL ** -0.5),
        "moe_w_up": nrm(ks[18], (DEPTH, N_EXPERTS, D_MODEL, D_EXPERT), D_MODEL ** -0.5),
        "moe_w_down": nrm(ks[19], (DEPTH, N_EXPERTS, D_EXPERT, D_MODEL), D_EXPERT ** -0.5),
        "final_g": 1.0 + nrm(ks[20], (D_MODEL,), 0.05),
    }


def reference(x, c, rel_bias, router_w, router_b, mod_w, mod_b, norm1_g, w_in,
              gmlp_ln_g, gmlp_ln_b, gmlp_ws, gmlp_bs, out_norm_a_g, out_norm_b_g,
              w_out, norm2_g, moe_w_gate, moe_w_up, moe_w_down, final_g):
    split_at = [A_WIDTH, 2 * A_WIDTH, 2 * A_WIDTH + B_WIDTH, 2 * A_WIDTH + 2 * B_WIDTH]
    c_act = jax.nn.silu(c)
    for l in range(DEPTH):
        mod = (c_act @ mod_w[l] + mod_b[l])[:, None, :]
        sh1, sc1, g1, sh2, sc2, g2 = jnp.split(mod, N_MOD, axis=-1)

        h = rms_norm(x, norm1_g[l]) * (1.0 + sc1) + sh1
        proj = h @ w_in[l]
        u, va, q, k, vb = jnp.split(proj, split_at, axis=-1)
        out_a = chunked_spatial_gating(jax.nn.gelu(u, approximate=False),
                                       jax.nn.gelu(va, approximate=False),
                                       gmlp_ln_g[l], gmlp_ln_b[l], gmlp_ws[l], gmlp_bs[l])
        out_b = dilated_mixture_attention(q, k, vb, rel_bias)
        mixed = jnp.concatenate([rms_norm(out_a, out_norm_a_g[l]),
                                 rms_norm(out_b, out_norm_b_g[l])], axis=-1) @ w_out[l]
        x = x + g1 * mixed

        h = rms_norm(x, norm2_g[l]) * (1.0 + sc2) + sh2
        x = x + g2 * grouped_top2_moe(h, router_w, router_b,
                                      moe_w_gate[l], moe_w_up[l], moe_w_down[l])
    return rms_norm(x, final_g)
```

```cpp
#include <hip/hip_runtime.h>
#include <cstdio>
#include <cstdint>

constexpr int D = 1024, BATCH = 8, SEQ = 2048, T = BATCH * SEQ, DEPTH = 2;
constexpr int AW = 512, HD = 64, INC = 2560, CHUNK = 128;
constexpr int NE = 16, DE = 512, NBKT = 24, TOKCAP = 16384;
constexpr float EPS = 1e-6f;
constexpr float LOG2E = 1.4426950408889634f;
constexpr float C2 = 0.125f * LOG2E;
#ifndef N_LAUNCH_MODE
#define N_LAUNCH_MODE 0
#endif

constexpr size_t MiB = 1u << 20;
constexpr size_t WS_CTL = 0, CTL_BYTES = 65536;
constexpr size_t WS_SMALL = 1 * MiB;
constexpr size_t WS_WIN = 9 * MiB;
constexpr size_t WS_WOUT = 19 * MiB;
constexpr size_t WS_WS = 23 * MiB;
constexpr size_t WS_WGU = 24 * MiB;
constexpr size_t WS_WD = 56 * MiB;
constexpr size_t WS_XA = 72 * MiB;
constexpr size_t WS_ACTX = 136 * MiB;
constexpr size_t WS_PROJ = 168 * MiB;
constexpr size_t WS_OC = 248 * MiB;
constexpr size_t WS_END = 298 * MiB;
constexpr size_t WS_A3 = WS_OC;
constexpr size_t WS_ACT = WS_OC;
constexpr size_t SO_MODV = 0;
constexpr size_t SO_G1 = 512 * 1024;
constexpr size_t SO_G2 = 576 * 1024;
constexpr size_t SO_BIAS1 = 640 * 1024;
constexpr size_t SO_RBIAS = 800 * 1024;
constexpr size_t SO_BIASGU = 1 * MiB;
constexpr size_t SO_GATES = 2 * MiB;
constexpr size_t SO_TOKL = 2 * MiB + 512 * 1024;
constexpr size_t SO_SSQA = 4 * MiB;
constexpr size_t SO_SSQB = 5 * MiB;
constexpr int CW_TMO = 0, CW_CNT = 64  , CW_BAR = 1024;

constexpr int NWAVES = 8, NTHREADS = 512;
constexpr int LDS_BYTES = 147456;
constexpr int LDSCTL_OFF = 143360;

#define GAS __attribute__((address_space(1)))
#define LAS __attribute__((address_space(3)))
typedef unsigned short bf16;
typedef short bf16x8 __attribute__((ext_vector_type(8)));
typedef float f32x4 __attribute__((ext_vector_type(4)));
typedef unsigned u32x4 __attribute__((ext_vector_type(4)));
#define LDS_WAIT() asm volatile("s_waitcnt lgkmcnt(0)" ::: "memory")

__device__ __forceinline__ float bf2f(bf16 b) { return __uint_as_float((unsigned)b << 16); }
__device__ __forceinline__ unsigned f2bf(float f) { unsigned u = __float_as_uint(f); return (u + 0x7fffu + ((u >> 16) & 1u)) >> 16; }
__device__ __forceinline__ unsigned pk2(float lo, float hi) { return f2bf(lo) | (f2bf(hi) << 16); }
__device__ __forceinline__ float wave_sum(float v) {
#pragma unroll
    for (int o = 1; o < 64; o <<= 1) v += __shfl_xor(v, o);
    return v;
}
__device__ __forceinline__ float gelu_exact(float x) { return 0.5f * x * (1.0f + erff(x * 0.70710678118654752f)); }
__device__ __forceinline__ float silu_f(float x) { return x / (1.0f + __expf(-x)); }

__device__ const unsigned char T5B[3][132] = {
{0,1,2,3,4,5,6,7,8,9,10,11,12,13,14,15,16,16,16,16,16,16,17,17,17,17,17,17,17,17,18,18,18,18,18,18,18,18,18,18,19,19,19,19,19,19,19,19,19,19,19,19,19,19,20,20,20,20,20,20,20,20,20,20,20,20,20,20,20,20,20,20,20,21,21,21,21,21,21,21,21,21,21,21,21,21,21,21,21,21,21,21,21,21,21,21,21,21,21,22,22,22,22,22,22,22,22,22,22,22,22,22,22,22,22,22,22,22,22,22,22,22,22,22,22,22,22,22,22,0,0,0},
{0,4,8,12,16,16,17,17,18,18,19,19,19,19,20,20,20,20,20,21,21,21,21,21,21,22,22,22,22,22,22,22,22,22,23,23,23,23,23,23,23,23,23,23,23,23,24,24,24,24,24,24,24,24,24,24,24,24,24,24,24,24,25,25,25,25,25,25,25,25,25,25,25,25,25,25,25,25,25,25,25,25,25,26,26,26,26,26,26,26,26,26,26,26,26,26,26,26,26,26,26,26,26,26,26,26,26,26,26,26,26,26,26,27,27,27,27,27,27,27,27,27,27,27,27,27,27,27,27,0,0,0},
{0,16,18,19,20,21,21,22,22,23,23,23,24,24,24,24,25,25,25,25,25,26,26,26,26,26,26,26,26,27,27,27,27,27,27,27,27,27,27,28,28,28,28,28,28,28,28,28,28,28,28,28,29,29,29,29,29,29,29,29,29,29,29,29,29,29,29,29,29,29,30,30,30,30,30,30,30,30,30,30,30,30,30,30,30,30,30,30,30,30,30,30,30,30,30,31,31,31,31,31,31,31,31,31,31,31,31,31,31,31,31,31,31,31,31,31,31,31,31,31,31,31,31,31,31,31,31,31,31,0,0,0}};

#define XB_TMO      128
#define XB_XCNT(j)  (256  + 64 * (j))
#define XB_XSUB(j)  (1280 + 64 * (j))
#define XB_XGEN(j)  (2304 + 64 * (j))
#define XB_TOP      3328
#define XB_TOPGEN   3392
#define XCD_BAR_WORDS 3456
#define XB_SPIN_CAP (1u << 18)

__device__ __forceinline__ unsigned xb_ld(unsigned* p)              { return __hip_atomic_load(p, __ATOMIC_RELAXED, __HIP_MEMORY_SCOPE_AGENT); }
__device__ __forceinline__ unsigned xb_add(unsigned* p, unsigned v) { return __hip_atomic_fetch_add(p, v, __ATOMIC_RELAXED, __HIP_MEMORY_SCOPE_AGENT); }
__device__ __forceinline__ unsigned xb_xcc_id() { return (unsigned)__builtin_amdgcn_s_getreg((3 << 11) | 20) & 0xFu; }
#define XB_SPIN(cond, bar) do { unsigned _sp = 0; while (cond) { __builtin_amdgcn_s_sleep(1); \
    if ((++_sp & 255u) == 0u) { if (xb_ld(&(bar)[XB_TMO])) break; if (_sp > XB_SPIN_CAP) { atomicAdd(&(bar)[XB_TMO], 1u); break; } } } } while (0)

struct XcdBarrier {
    unsigned* bar; unsigned x;
    volatile LAS unsigned* st;
};
__device__ __forceinline__ XcdBarrier xcd_barrier_post(unsigned* bar, volatile LAS unsigned* st) {
    XcdBarrier b; b.bar = bar; b.x = xb_xcc_id(); b.st = st;
    if (threadIdx.x == 0) (void)xb_add(&bar[XB_XCNT(b.x)], 1u);
    return b;
}
__device__ __forceinline__ void xcd_barrier_complete(unsigned* bar, unsigned x, unsigned& nloc, unsigned& nx) {
    const unsigned G = gridDim.x * gridDim.y * gridDim.z;
    unsigned sum, cnt, mine, sp = 0u;
    for (;;) {
        sum = 0u; cnt = 0u; mine = 0u;
#pragma unroll
        for (unsigned j = 0; j < 16; ++j) { const unsigned c = xb_ld(&bar[XB_XCNT(j)]); sum += c; cnt += (c > 0u) ? 1u : 0u; mine = (j == x) ? c : mine; }
        if (sum == G) break;
        __builtin_amdgcn_s_sleep(1);
        if ((++sp & 255u) == 0u) { if (xb_ld(&bar[XB_TMO])) break; if (sp > XB_SPIN_CAP) { atomicAdd(&bar[XB_TMO], 1u); break; } }
    }
    nloc = mine > 0u ? mine : 1u; nx = cnt > 0u ? cnt : 1u;
}
__device__ __forceinline__ void xcd_barrier(const XcdBarrier& b) {
    asm volatile("s_waitcnt vmcnt(0)" ::: "memory");
    __syncthreads();
    if (threadIdx.x == 0) {
        unsigned* bar = b.bar;
        __builtin_amdgcn_s_waitcnt(0);
        unsigned nloc = b.st[0], nx = b.st[1];
        if (nloc == 0u) { xcd_barrier_complete(bar, b.x, nloc, nx); b.st[0] = nloc; b.st[1] = nx; }
        const unsigned old = xb_add(&bar[XB_XSUB(b.x)], 1u);
        const unsigned gen = old / nloc;
        if (old + 1u == (gen + 1u) * nloc) {
            __builtin_amdgcn_fence(__ATOMIC_RELEASE, "agent");
            asm volatile("s_waitcnt vmcnt(0)" ::: "memory");
            const unsigned og = xb_add(&bar[XB_TOP], 1u);
            const unsigned tg = og / nx;
            if (og + 1u == (tg + 1u) * nx) xb_add(&bar[XB_TOPGEN], 1u);
            else XB_SPIN(xb_ld(&bar[XB_TOPGEN]) == tg, bar);
            __builtin_amdgcn_fence(__ATOMIC_ACQUIRE, "agent");
            xb_add(&bar[XB_XGEN(b.x)], 1u);
            asm volatile("s_waitcnt vmcnt(0)" ::: "memory");
        } else {
            XB_SPIN(xb_ld(&bar[XB_XGEN(b.x)]) == gen, bar);
            __builtin_amdgcn_fence(__ATOMIC_ACQUIRE, "agent");
            asm volatile("s_waitcnt vmcnt(0)" ::: "memory");
        }
    }
    __syncthreads();
}

struct Args { const float* in[21]; float* out; unsigned char* ws; int ph_lo, ph_hi; };
enum { I_X = 0, I_C, I_RELB, I_RW, I_RB, I_MODW, I_MODB, I_N1G, I_WIN, I_LNG, I_LNB, I_GWS, I_GBS, I_ONA, I_ONB, I_WOUT, I_N2G, I_WG, I_WU, I_WD, I_FING };

struct Ctx {
    int tid, lane, wave, wg, nwg, gw, ngw, gtid, ngt;
    LAS unsigned char* lds;
};

__device__ __forceinline__ void bucket_experts(int bkt, int& e0, int& e1) {
    const int grp = bkt / 6, pi = bkt % 6;
    const int pa = (pi >= 3) + (pi >= 5);
    const int pb = pi + 1 - (pa == 0 ? 0 : (pa == 1 ? 2 : 3));
    e0 = grp * 4 + pa; e1 = grp * 4 + pb;
}
__device__ __forceinline__ float rstd_from16(const float* ssq, int t) {
    const f32x4* p = (const f32x4*)(ssq + (size_t)t * 16);
    const f32x4 a = p[0], b = p[1], c = p[2], d = p[3];
    const float s = ((a.x + a.y) + (a.z + a.w)) + ((b.x + b.y) + (b.z + b.w)) + ((c.x + c.y) + (c.z + c.w)) + ((d.x + d.y) + (d.z + d.w));
    return rsqrtf(s * (1.0f / 1024.0f) + EPS);
}

__device__ __forceinline__ void tr_item(const float* W, int ldw, int k0, int n0, bf16* WT, int ldt, int drow0, const float* kscale, float nscale, LAS float* scr, int lane) {
#pragma unroll 8
    for (int i = 0; i < 32; ++i) {
        const int kk = 2 * i + (lane >> 5);
        float v = W[(size_t)(k0 + kk) * ldw + n0 + (lane & 31)];
        if (kscale) v *= kscale[k0 + kk];
        scr[kk * 33 + (lane & 31)] = v * nscale;
    }
    LDS_WAIT(); asm volatile("" ::: "memory");
    const int c = lane & 7;
#pragma unroll
    for (int j = 0; j < 4; ++j) {
        const int n = (lane >> 3) + 8 * j; const LAS float* s = scr + (8 * c) * 33 + n;
        u32x4 o; o.x = pk2(s[0 * 33], s[1 * 33]); o.y = pk2(s[2 * 33], s[3 * 33]); o.z = pk2(s[4 * 33], s[5 * 33]); o.w = pk2(s[6 * 33], s[7 * 33]);
        *(u32x4*)(WT + (size_t)(drow0 + n) * ldt + k0 + 8 * c) = o;
    }
    LDS_WAIT(); asm volatile("" ::: "memory");
}
__device__ __forceinline__ void conv_moe_weights(const Args& a, const Ctx& c, int l) {
    LAS float* scr = (LAS float*)(c.lds + c.wave * 8704);
    bf16* wgu = (bf16*)(a.ws + WS_WGU); bf16* wd = (bf16*)(a.ws + WS_WD);
    for (int it = c.gw; it < NE * 768; it += c.ngw) {
        const int e = it / 768, r = it % 768, kind = r / 256, q = r % 256;
        if (kind < 2) {
            const float* W = a.in[kind == 0 ? I_WG : I_WU] + ((size_t)l * NE + e) * 1024 * 512;
            const int kb = q / 16, nb = q % 16, n0 = nb * 32;
            const int drow0 = (n0 / 128) * 256 + (n0 % 128) + kind * 128;
            tr_item(W, 512, kb * 64, n0, wgu + (size_t)e * 1024 * 1024, 1024, drow0, nullptr, 1.0f, scr, c.lane);
        } else {
            const float* W = a.in[I_WD] + ((size_t)l * NE + e) * 512 * 1024;
            const int kb = q / 32, nb = q % 32;
            tr_item(W, 1024, kb * 64, nb * 32, wd + (size_t)e * 1024 * 512, 512, nb * 32, nullptr, 1.0f, scr, c.lane);
        }
    }
}

__device__ __forceinline__ void phase_p0a(const Args& a, const Ctx& c) {
    float* modv = (float*)(a.ws + WS_SMALL + SO_MODV);
    {
        const float* cc = a.in[I_C]; const float* mw = a.in[I_MODW]; const float* mb = a.in[I_MODB];
        for (int i = c.gtid; i < DEPTH * BATCH * 6144; i += c.ngt) {
            const int j = i % 6144, b = (i / 6144) % BATCH, l = i / (6144 * BATCH);
            const float* w = mw + (size_t)l * 1024 * 6144 + j; const float* cb = cc + b * 1024;
            float acc = 0.f;
#pragma unroll 8
            for (int k = 0; k < 1024; ++k) { const float cv = cb[k]; acc += silu_f(cv) * w[(size_t)k * 6144]; }
            modv[i] = acc + mb[l * 6144 + j];
        }
    }
    LAS float* scr = (LAS float*)(c.lds + c.wave * 8704);
    {
        bf16* wtin = (bf16*)(a.ws + WS_WIN); bf16* wtout = (bf16*)(a.ws + WS_WOUT);
        constexpr int I_IN = 16 * 80, I_OUT = 16 * 32;
        for (int it = c.gw; it < DEPTH * (I_IN + I_OUT); it += c.ngw) {
            const int l = it / (I_IN + I_OUT), r = it % (I_IN + I_OUT);
            if (r < I_IN) {
                const int kb = r / 80, nb = r % 80, n0 = nb * 32;
                tr_item(a.in[I_WIN] + (size_t)l * 1024 * INC, INC, kb * 64, n0, wtin + (size_t)l * INC * 1024, 1024, n0, nullptr, (n0 >= 1024 && n0 < 1536) ? C2 : 1.0f, scr, c.lane);
            } else {
                const int q = r - I_IN, kb = q / 32, nb = q % 32, k0 = kb * 64;
                const float* ks = (k0 < 512) ? (a.in[I_ONA] + l * 512) : (a.in[I_ONB] + l * 512 - 512);
                tr_item(a.in[I_WOUT] + (size_t)l * 1024 * 1024, 1024, k0, nb * 32, wtout + (size_t)l * 1024 * 1024, 1024, nb * 32, ks, 1.0f, scr, c.lane);
            }
        }
    }
    {
        bf16* ws = (bf16*)(a.ws + WS_WS); const float* g = a.in[I_GWS];
        for (int i = c.gtid; i < DEPTH * 8 * 128 * 128; i += c.ngt) { const int s = i & 127, t = (i >> 7) & 127; ws[i] = (bf16)f2bf(s <= t ? g[i] : 0.f); }
    }
    conv_moe_weights(a, c, 0);
}

__device__ __forceinline__ void bias_item(const float* Wc, int ldw, const float* sh, float* out, int ob, float scale, LAS float* red, int tid) {
    const int nn = tid & 63, kc = tid >> 6;
    float acc[8];
#pragma unroll
    for (int b = 0; b < 8; ++b) acc[b] = 0.f;
#pragma unroll 4
    for (int k = kc * 128; k < kc * 128 + 128; ++k) {
        const float w = Wc[(size_t)k * ldw + nn];
#pragma unroll
        for (int b = 0; b < 8; ++b) acc[b] += sh[b * 6144 + k] * w;
    }
#pragma unroll
    for (int b = 0; b < 8; ++b) red[(kc * 8 + b) * 64 + nn] = acc[b];
    __syncthreads();
    {
        const int b = tid >> 6; float s = 0.f;
#pragma unroll
        for (int k2 = 0; k2 < 8; ++k2) s += red[(k2 * 8 + b) * 64 + nn];
        out[(size_t)b * ob + nn] = s * scale;
    }
    __syncthreads();
}
__device__ __forceinline__ void phase_p0b(const Args& a, const Ctx& c) {
    const float* modv = (const float*)(a.ws + WS_SMALL + SO_MODV);
    float* G1 = (float*)(a.ws + WS_SMALL + SO_G1); float* G2 = (float*)(a.ws + WS_SMALL + SO_G2);
    for (int i = c.gtid; i < DEPTH * BATCH * 1024; i += c.ngt) {
        const int k = i & 1023, lb = i >> 10, l = lb / BATCH;
        G1[i] = a.in[I_N1G][l * 1024 + k] * (1.0f + modv[(size_t)lb * 6144 + 1024 + k]);
        G2[i] = a.in[I_N2G][l * 1024 + k] * (1.0f + modv[(size_t)lb * 6144 + 4096 + k]);
    }
    {
        float* rb = (float*)(a.ws + WS_SMALL + SO_RBIAS);
        for (int i = c.gtid; i < DEPTH * BATCH * 16; i += c.ngt) {
            const int e = i & 15, lb = i >> 4; const float* sh = modv + (size_t)lb * 6144 + 3072; float acc = 0.f;
            for (int k = 0; k < 1024; ++k) acc += sh[k] * a.in[I_RW][k * 16 + e];
            rb[i] = acc;
        }
    }
    {
        LAS float* red = (LAS float*)c.lds;
        float* bias1 = (float*)(a.ws + WS_SMALL + SO_BIAS1); float* biasgu = (float*)(a.ws + WS_SMALL + SO_BIASGU);
        for (int it = c.wg; it < 80 + 512; it += c.nwg) {
            if (it < 80) {
                const int l = it / 40, n0 = (it % 40) * 64;
                bias_item(a.in[I_WIN] + (size_t)l * 1024 * INC + n0, INC, modv + (size_t)l * 8 * 6144 + 0, bias1 + (size_t)l * 8 * INC + n0, INC, (n0 >= 1024 && n0 < 1536) ? C2 : 1.0f, red, c.tid);
            } else {
                const int r = it - 80, l = r / 256, q = r % 256, e = q / 16, half = (q % 16) / 8, fb = q % 8, f0 = fb * 64;
                const float* W = a.in[half ? I_WU : I_WG] + ((size_t)l * NE + e) * 1024 * 512 + f0;
                const int nd = (f0 / 128) * 256 + half * 128 + (f0 % 128);
                bias_item(W, 512, modv + (size_t)l * 8 * 6144 + 3072, biasgu + ((size_t)l * 8 * 16 + e) * 1024 + nd, 16 * 1024, 1.0f, red, c.tid);
            }
        }
    }
    {
        bf16* A1 = (bf16*)(a.ws + WS_ACTX); float* ssq = (float*)(a.ws + WS_SMALL + SO_SSQA);
        const float* x = a.in[I_X];
        for (int t = c.gw; t < T; t += c.ngw) {
            const int b = t / SEQ; float s = 0.f;
            const f32x4* xr = (const f32x4*)(x + (size_t)t * 1024);
#pragma unroll
            for (int j = 0; j < 4; ++j) {
                const int k = (c.lane + 64 * j) * 4; const f32x4 v = xr[c.lane + 64 * j];
                s += (v.x * v.x + v.y * v.y) + (v.z * v.z + v.w * v.w);
                float g[4];
#pragma unroll
                for (int q = 0; q < 4; ++q) g[q] = a.in[I_N1G][k + q] * (1.0f + modv[(size_t)b * 6144 + 1024 + k + q]);
                uint2 o; o.x = pk2(v.x * g[0], v.y * g[1]); o.y = pk2(v.z * g[2], v.w * g[3]);
                *(uint2*)(A1 + (size_t)t * 1024 + k) = o;
            }
            s = wave_sum(s);
            if (c.lane < 16) ssq[(size_t)t * 16 + c.lane] = (c.lane == 0) ? s : 0.f;
        }
    }
}

__device__ __forceinline__ void sg_core(const bf16* a0, const bf16* a1, const bf16* b0, const bf16* b1, int K, f32x4 (&acc)[2][2], int lane) {
    const int ko = 8 * (lane >> 4);
    for (int k0 = 0; k0 < K; k0 += 32) {
        const bf16x8 A0 = *(const bf16x8*)(a0 + k0 + ko), A1 = *(const bf16x8*)(a1 + k0 + ko);
        const bf16x8 B0 = *(const bf16x8*)(b0 + k0 + ko), B1 = *(const bf16x8*)(b1 + k0 + ko);
        acc[0][0] = __builtin_amdgcn_mfma_f32_16x16x32_bf16(A0, B0, acc[0][0], 0, 0, 0);
        acc[0][1] = __builtin_amdgcn_mfma_f32_16x16x32_bf16(A0, B1, acc[0][1], 0, 0, 0);
        acc[1][0] = __builtin_amdgcn_mfma_f32_16x16x32_bf16(A1, B0, acc[1][0], 0, 0, 0);
        acc[1][1] = __builtin_amdgcn_mfma_f32_16x16x32_bf16(A1, B1, acc[1][1], 0, 0, 0);
    }
}
#define ZERO_ACC(acc) do { _Pragma("unroll") for (int _i = 0; _i < 2; ++_i) _Pragma("unroll") for (int _j = 0; _j < 2; ++_j) acc[_i][_j] = (f32x4){0.f, 0.f, 0.f, 0.f}; } while (0)

__device__ __forceinline__ void phase_p1_simple(const Args& a, const Ctx& c, int l) {
    const bf16* A1 = (const bf16*)(a.ws + WS_ACTX); const bf16* W = (const bf16*)(a.ws + WS_WIN) + (size_t)l * INC * 1024;
    const float* ssq = (const float*)(a.ws + WS_SMALL + SO_SSQA); const float* bias1 = (const float*)(a.ws + WS_SMALL + SO_BIAS1) + (size_t)l * 8 * INC;
    bf16* proj = (bf16*)(a.ws + WS_PROJ);
    const int fr = c.lane & 15, fq = c.lane >> 4;
    for (int it = c.gw; it < 512 * 80; it += c.ngw) {
        const int rt = it / 80, ct = it % 80, r0 = rt * 32, c0 = ct * 32;
        f32x4 acc[2][2]; ZERO_ACC(acc);
        sg_core(A1 + (size_t)(r0 + fr) * 1024, A1 + (size_t)(r0 + 16 + fr) * 1024, W + (size_t)(c0 + fr) * 1024, W + (size_t)(c0 + 16 + fr) * 1024, 1024, acc, c.lane);
#pragma unroll
        for (int i = 0; i < 2; ++i)
#pragma unroll
            for (int q = 0; q < 4; ++q) {
                const int t = r0 + 16 * i + 4 * fq + q, b = t / SEQ; const float rs = rstd_from16(ssq, t);
#pragma unroll
                for (int j = 0; j < 2; ++j) {
                    const int n = c0 + 16 * j + fr; float v = rs * acc[i][j][q] + bias1[b * INC + n];
                    if (n < 1024) v = gelu_exact(v);
                    proj[(size_t)t * INC + n] = (bf16)f2bf(v);
                }
            }
    }
}

__device__ __forceinline__ void phase_p2_simple(const Args& a, const Ctx& c, int l) {
    const bf16* proj = (const bf16*)(a.ws + WS_PROJ); bf16* A3 = (bf16*)(a.ws + WS_A3);
    {
        LAS bf16* vn = (LAS bf16*)c.lds;
        LAS float* st = (LAS float*)(c.lds + 131072);
        LAS float* part = (LAS float*)(c.lds + 131072 + 1024);
        const float* lng = a.in[I_LNG] + l * 512; const float* lnb = a.in[I_LNB] + l * 512;
        const float* gws = a.in[I_GWS] + (size_t)l * 8 * 128 * 128; const float* gbs = a.in[I_GBS] + l * 8 * 128;
        for (int u = c.wg; u < BATCH * (SEQ / CHUNK); u += c.nwg) {
            const int t0 = u * CHUNK;
            for (int s = c.wave; s < 128; s += NWAVES) {
                const bf16* r = proj + (size_t)(t0 + s) * INC + 512; float v[8]; float sm = 0.f;
#pragma unroll
                for (int j = 0; j < 8; ++j) { v[j] = bf2f(r[c.lane + 64 * j]); sm += v[j]; }
                const float mu = wave_sum(sm) * (1.0f / 512.0f); float q = 0.f;
#pragma unroll
                for (int j = 0; j < 8; ++j) { const float d = v[j] - mu; q += d * d; }
                q = wave_sum(q) * (1.0f / 512.0f);
                if (c.lane == 0) { st[s] = mu; st[128 + s] = rsqrtf(q + EPS); }
            }
            __syncthreads();
            const int ch = c.tid, g = ch >> 6;
            for (int s = 0; s < 128; ++s) {
                const float v = bf2f(proj[(size_t)(t0 + s) * INC + 512 + ch]);
                vn[s * 512 + ch] = (bf16)f2bf((v - st[s]) * st[128 + s] * lng[ch] + lnb[ch]);
            }
            __syncthreads();
            for (int t = 0; t < 128; ++t) {
                const float* wr = gws + ((size_t)g * 128 + t) * 128; float acc = 0.f;
                for (int s = 0; s <= t; ++s) acc += wr[s] * bf2f(vn[s * 512 + ch]);
                acc += gbs[g * 128 + t];
                const float o = bf2f(proj[(size_t)(t0 + t) * INC + ch]) * acc;
                const float ps = wave_sum(o * o);
                if (c.lane == 0) part[c.wave] = ps;
                __syncthreads();
                float tot = 0.f;
#pragma unroll
                for (int w = 0; w < 8; ++w) tot += part[w];
                A3[(size_t)(t0 + t) * 1024 + ch] = (bf16)f2bf(o * rsqrtf(tot * (1.0f / 512.0f) + EPS));
                __syncthreads();
            }
        }
    }
    {
        LAS float* part = (LAS float*)(c.lds + 131072 + 2048);
        const float* relb = a.in[I_RELB];
        for (int t = c.wg; t < T; t += c.nwg) {
            const int ts = t % SEQ, h = c.wave;
            const float q = bf2f(proj[(size_t)t * INC + 1024 + h * 64 + c.lane]);
            float m = -INFINITY, lsum = 0.f, o = 0.f;
            for (int cfg = 0; cfg < 3; ++cfg) {
                const int d = 1 << (2 * cfg); const int jmax = min(128, ts / d);
                for (int j = 0; j <= jmax; ++j) {
                    const bf16* kr = proj + (size_t)(t - j * d) * INC + h * 64 + c.lane;
                    const float s = wave_sum(q * bf2f(kr[1536])) + relb[(int)T5B[cfg][j] * 8 + h] * LOG2E;
                    const float mn = fmaxf(m, s), sc = exp2f(m - mn), p = exp2f(s - mn);
                    lsum = lsum * sc + p; o = o * sc + p * bf2f(kr[2048]); m = mn;
                }
            }
            o /= lsum;
            const float ps = wave_sum(o * o);
            if (c.lane == 0) part[h] = ps;
            __syncthreads();
            float tot = 0.f;
#pragma unroll
            for (int w = 0; w < 8; ++w) tot += part[w];
            A3[(size_t)t * 1024 + 512 + h * 64 + c.lane] = (bf16)f2bf(o * rsqrtf(tot * (1.0f / 512.0f) + EPS));
            __syncthreads();
        }
    }
}

__device__ __forceinline__ void phase_p3_simple(const Args& a, const Ctx& c, int l) {
    const bf16* A3 = (const bf16*)(a.ws + WS_A3); const bf16* W = (const bf16*)(a.ws + WS_WOUT) + (size_t)l * 1024 * 1024;
    const float* xprev = (l == 0) ? a.in[I_X] : a.out; float* x1 = (float*)(a.ws + WS_XA); bf16* A2 = (bf16*)(a.ws + WS_ACTX);
    const float* modv = (const float*)(a.ws + WS_SMALL + SO_MODV) + (size_t)l * 8 * 6144; const float* G2 = (const float*)(a.ws + WS_SMALL + SO_G2) + (size_t)l * 8 * 1024;
    const int fr = c.lane & 15, fq = c.lane >> 4;
    for (int it = c.gw; it < 512 * 32; it += c.ngw) {
        const int rt = it / 32, ct = it % 32, r0 = rt * 32, c0 = ct * 32;
        f32x4 acc[2][2]; ZERO_ACC(acc);
        sg_core(A3 + (size_t)(r0 + fr) * 1024, A3 + (size_t)(r0 + 16 + fr) * 1024, W + (size_t)(c0 + fr) * 1024, W + (size_t)(c0 + 16 + fr) * 1024, 1024, acc, c.lane);
#pragma unroll
        for (int i = 0; i < 2; ++i)
#pragma unroll
            for (int q = 0; q < 4; ++q) {
                const int t = r0 + 16 * i + 4 * fq + q, b = t / SEQ;
#pragma unroll
                for (int j = 0; j < 2; ++j) {
                    const int n = c0 + 16 * j + fr;
                    const float v = xprev[(size_t)t * 1024 + n] + modv[b * 6144 + 2048 + n] * acc[i][j][q];
                    x1[(size_t)t * 1024 + n] = v; A2[(size_t)t * 1024 + n] = (bf16)f2bf(v * G2[b * 1024 + n]);
                }
            }
    }
}

__device__ __forceinline__ void phase_p3b_simple(const Args& a, const Ctx& c, int l) {
    const float* x1 = (const float*)(a.ws + WS_XA); float* ssq = (float*)(a.ws + WS_SMALL + SO_SSQB);
    const float* modv = (const float*)(a.ws + WS_SMALL + SO_MODV) + (size_t)l * 8 * 6144; const float* G2 = (const float*)(a.ws + WS_SMALL + SO_G2) + (size_t)l * 8 * 1024;
    const float* rbias = (const float*)(a.ws + WS_SMALL + SO_RBIAS) + l * 8 * 16;
    float* gates = (float*)(a.ws + WS_SMALL + SO_GATES); int* tokl = (int*)(a.ws + WS_SMALL + SO_TOKL);
    unsigned* cnt = (unsigned*)(a.ws + WS_CTL) + CW_CNT + l * 32;
    const float* rw = a.in[I_RW]; const float* rb = a.in[I_RB];
    for (int t = c.gw; t < T; t += c.ngw) {
        const int b = t / SEQ; const float* xr = x1 + (size_t)t * 1024;
        float xv[16]; float s = 0.f;
#pragma unroll
        for (int j = 0; j < 16; ++j) { xv[j] = xr[c.lane + 64 * j]; s += xv[j] * xv[j]; }
        s = wave_sum(s);
        if (c.lane < 16) ssq[(size_t)t * 16 + c.lane] = (c.lane == 0) ? s : 0.f;
        const float rs = rsqrtf(s * (1.0f / 1024.0f) + EPS);
        float lg[16];
#pragma unroll
        for (int e = 0; e < 16; ++e) lg[e] = 0.f;
#pragma unroll
        for (int j = 0; j < 16; ++j) {
            const int k = c.lane + 64 * j; const float hv = xv[j] * rs * G2[b * 1024 + k];
            const f32x4* w4 = (const f32x4*)(rw + k * 16);
#pragma unroll
            for (int e4 = 0; e4 < 4; ++e4) { const f32x4 w = w4[e4]; lg[4 * e4] += hv * w.x; lg[4 * e4 + 1] += hv * w.y; lg[4 * e4 + 2] += hv * w.z; lg[4 * e4 + 3] += hv * w.w; }
        }
#pragma unroll
        for (int e = 0; e < 16; ++e) lg[e] = wave_sum(lg[e]) + rbias[b * 16 + e];
        float mx = lg[0];
#pragma unroll
        for (int e = 1; e < 16; ++e) mx = fmaxf(mx, lg[e]);
        float p[16]; float ps = 0.f;
#pragma unroll
        for (int e = 0; e < 16; ++e) { p[e] = __expf(lg[e] - mx); ps += p[e]; }
        const float inv = 1.0f / ps;
        float sel[16];
#pragma unroll
        for (int e = 0; e < 16; ++e) { p[e] *= inv; sel[e] = p[e] + rb[e]; }
        int best = 0; float bests = -INFINITY;
#pragma unroll
        for (int g = 0; g < 4; ++g) {
            float m1 = -INFINITY, m2 = -INFINITY;
#pragma unroll
            for (int i = 0; i < 4; ++i) { const float v = sel[4 * g + i]; if (v > m1) { m2 = m1; m1 = v; } else if (v > m2) { m2 = v; } }
            const float gs = m1 + m2; if (gs > bests) { bests = gs; best = g; }
        }
        float s0 = 0.f, s1 = 0.f, s2 = 0.f, s3 = 0.f, p0 = 0.f, p1 = 0.f, p2 = 0.f, p3 = 0.f;
#pragma unroll
        for (int g = 0; g < 4; ++g) if (g == best) { s0 = sel[4 * g]; s1 = sel[4 * g + 1]; s2 = sel[4 * g + 2]; s3 = sel[4 * g + 3]; p0 = p[4 * g]; p1 = p[4 * g + 1]; p2 = p[4 * g + 2]; p3 = p[4 * g + 3]; }
        int i1 = 0; float v1 = s0;
        if (s1 > v1) { v1 = s1; i1 = 1; } if (s2 > v1) { v1 = s2; i1 = 2; } if (s3 > v1) { v1 = s3; i1 = 3; }
        int i2 = -1; float v2 = -INFINITY;
        if (i1 != 0 && s0 > v2) { v2 = s0; i2 = 0; } if (i1 != 1 && s1 > v2) { v2 = s1; i2 = 1; } if (i1 != 2 && s2 > v2) { v2 = s2; i2 = 2; } if (i1 != 3 && s3 > v2) { v2 = s3; i2 = 3; }
        const int ea = min(i1, i2), eb = max(i1, i2);
        const float pa = (ea == 0) ? p0 : (ea == 1) ? p1 : (ea == 2) ? p2 : p3;
        const float pb = (eb == 0) ? p0 : (eb == 1) ? p1 : (eb == 2) ? p2 : p3;
        const int pi = (ea == 0) ? (eb - 1) : (ea == 1) ? (eb + 1) : 5;
        const int bkt = best * 6 + pi;
        if (c.lane == 0) {
            const unsigned pos = atomicAdd(&cnt[bkt], 1u);
            tokl[bkt * TOKCAP + (int)pos] = t;
            gates[(size_t)t * 2] = pa / (pa + pb); gates[(size_t)t * 2 + 1] = pb / (pa + pb);
        }
    }
}

__device__ __forceinline__ int bucket_offset(const unsigned* cnt, int bkt) {
    int off = 0;
    for (int i = 0; i < bkt; ++i) off += (int)((cnt[i] + 255u) & ~255u);
    return off;
}

__device__ __forceinline__ void phase_p4_simple(const Args& a, const Ctx& c, int l) {
    const bf16* A2 = (const bf16*)(a.ws + WS_ACTX); const bf16* wgu = (const bf16*)(a.ws + WS_WGU); bf16* act = (bf16*)(a.ws + WS_ACT);
    const float* ssq = (const float*)(a.ws + WS_SMALL + SO_SSQB); const float* biasgu = (const float*)(a.ws + WS_SMALL + SO_BIASGU) + (size_t)l * 8 * 16 * 1024;
    const float* gates = (const float*)(a.ws + WS_SMALL + SO_GATES); const int* tokl = (const int*)(a.ws + WS_SMALL + SO_TOKL);
    const unsigned* cnt = (const unsigned*)(a.ws + WS_CTL) + CW_CNT + l * 32;
    const int fr = c.lane & 15, fq = c.lane >> 4;
    for (int bkt = 0; bkt < NBKT; ++bkt) {
        const int n = (int)cnt[bkt]; if (n == 0) continue;
        const int off = bucket_offset(cnt, bkt); int e0, e1; bucket_experts(bkt, e0, e1);
        const int nrt = (n + 31) / 32;
        for (int it = c.gw; it < nrt * 64; it += c.ngw) {
            const int rt = it / 64, cb = it % 64, slot = cb / 32, fb = cb % 32, f0 = fb * 16, e = slot ? e1 : e0;
            const int r0 = rt * 32;
            const int ra = r0 + fr, rb2 = r0 + 16 + fr;
            const int ta = tokl[bkt * TOKCAP + (ra < n ? ra : 0)], tb = tokl[bkt * TOKCAP + (rb2 < n ? rb2 : 0)];
            const int nrow = (f0 / 128) * 256 + (f0 % 128);
            const bf16* W = wgu + (size_t)e * 1024 * 1024;
            f32x4 acc[2][2]; ZERO_ACC(acc);
            sg_core(A2 + (size_t)ta * 1024, A2 + (size_t)tb * 1024, W + (size_t)(nrow + fr) * 1024, W + (size_t)(nrow + 128 + fr) * 1024, 1024, acc, c.lane);
#pragma unroll
            for (int i = 0; i < 2; ++i)
#pragma unroll
                for (int q = 0; q < 4; ++q) {
                    const int r = r0 + 16 * i + 4 * fq + q; float v = 0.f;
                    if (r < n) {
                        const int t = tokl[bkt * TOKCAP + r], b = t / SEQ; const float rs = rstd_from16(ssq, t);
                        const float hg = rs * acc[i][0][q] + biasgu[((size_t)b * 16 + e) * 1024 + nrow + fr];
                        const float hu = rs * acc[i][1][q] + biasgu[((size_t)b * 16 + e) * 1024 + nrow + 128 + fr];
                        v = silu_f(hg) * hu * gates[(size_t)t * 2 + slot];
                    }
                    act[(size_t)(off + r) * 1024 + slot * 512 + f0 + fr] = (bf16)f2bf(v);
                }
        }
    }
}

__device__ __forceinline__ void phase_p5_simple(const Args& a, const Ctx& c, int l) {
    const bf16* act = (const bf16*)(a.ws + WS_ACT); const bf16* wd = (const bf16*)(a.ws + WS_WD);
    const float* x1 = (const float*)(a.ws + WS_XA); float* x2 = a.out; bf16* A1 = (bf16*)(a.ws + WS_ACTX);
    const float* modv = (const float*)(a.ws + WS_SMALL + SO_MODV) + (size_t)l * 8 * 6144;
    const float* G1n = (const float*)(a.ws + WS_SMALL + SO_G1) + (size_t)(l + 1 < DEPTH ? l + 1 : l) * 8 * 1024;
    const int* tokl = (const int*)(a.ws + WS_SMALL + SO_TOKL);
    const unsigned* cnt = (const unsigned*)(a.ws + WS_CTL) + CW_CNT + l * 32;
    const int fr = c.lane & 15, fq = c.lane >> 4;
    for (int bkt = 0; bkt < NBKT; ++bkt) {
        const int n = (int)cnt[bkt]; if (n == 0) continue;
        const int off = bucket_offset(cnt, bkt); int e0, e1; bucket_experts(bkt, e0, e1);
        const int nrt = (n + 31) / 32;
        for (int it = c.gw; it < nrt * 32; it += c.ngw) {
            const int rt = it / 32, ct = it % 32, r0 = rt * 32, c0 = ct * 32;
            const bf16* a0 = act + (size_t)(off + r0 + fr) * 1024; const bf16* a1 = act + (size_t)(off + r0 + 16 + fr) * 1024;
            f32x4 acc[2][2]; ZERO_ACC(acc);
            sg_core(a0, a1, wd + ((size_t)e0 * 1024 + c0 + fr) * 512, wd + ((size_t)e0 * 1024 + c0 + 16 + fr) * 512, 512, acc, c.lane);
            sg_core(a0 + 512, a1 + 512, wd + ((size_t)e1 * 1024 + c0 + fr) * 512, wd + ((size_t)e1 * 1024 + c0 + 16 + fr) * 512, 512, acc, c.lane);
#pragma unroll
            for (int i = 0; i < 2; ++i)
#pragma unroll
                for (int q = 0; q < 4; ++q) {
                    const int r = r0 + 16 * i + 4 * fq + q;
                    if (r < n) {
                        const int t = tokl[bkt * TOKCAP + r], b = t / SEQ;
#pragma unroll
                        for (int j = 0; j < 2; ++j) {
                            const int nn = c0 + 16 * j + fr;
                            const float v = x1[(size_t)t * 1024 + nn] + modv[b * 6144 + 5120 + nn] * acc[i][j][q];
                            x2[(size_t)t * 1024 + nn] = v;
                            if (l + 1 < DEPTH) A1[(size_t)t * 1024 + nn] = (bf16)f2bf(v * G1n[b * 1024 + nn]);
                        }
                    }
                }
        }
    }
}

__device__ __forceinline__ void phase_p5b_simple(const Args& a, const Ctx& c) {
    float* ssq = (float*)(a.ws + WS_SMALL + SO_SSQA);
    for (int t = c.gw; t < T; t += c.ngw) {
        const float* xr = a.out + (size_t)t * 1024; float s = 0.f;
#pragma unroll
        for (int j = 0; j < 16; ++j) { const float v = xr[c.lane + 64 * j]; s += v * v; }
        s = wave_sum(s);
        if (c.lane < 16) ssq[(size_t)t * 16 + c.lane] = (c.lane == 0) ? s : 0.f;
    }
}
__device__ __forceinline__ void phase_p6(const Args& a, const Ctx& c) {
    const float* ssq = (const float*)(a.ws + WS_SMALL + SO_SSQA); const float* fg = a.in[I_FING];
    for (int t = c.gw; t < T; t += c.ngw) {
        const float rs = rstd_from16(ssq, t);
        f32x4* xr = (f32x4*)(a.out + (size_t)t * 1024);
#pragma unroll
        for (int j = 0; j < 4; ++j) {
            f32x4 v = xr[c.lane + 64 * j]; const f32x4 g = ((const f32x4*)fg)[c.lane + 64 * j];
            v.x *= rs * g.x; v.y *= rs * g.y; v.z *= rs * g.z; v.w *= rs * g.w; xr[c.lane + 64 * j] = v;
        }
    }
}

constexpr int NPL = 7;
constexpr int NPHASE = 2 + NPL * DEPTH + 1;
__global__ void __launch_bounds__(NTHREADS, 2) fwd_kernel(Args a) {
    extern __shared__ __attribute__((aligned(16))) unsigned char lds_raw[];
    Ctx c;
    c.lds = (LAS unsigned char*)lds_raw;
    c.tid = threadIdx.x; c.lane = c.tid & 63; c.wave = __builtin_amdgcn_readfirstlane(c.tid >> 6);
    c.wg = blockIdx.x; c.nwg = gridDim.x; c.gw = c.wg * NWAVES + c.wave; c.ngw = c.nwg * NWAVES; c.gtid = c.wg * NTHREADS + c.tid; c.ngt = c.nwg * NTHREADS;
    volatile LAS unsigned* MISC = (volatile LAS unsigned*)(c.lds + LDSCTL_OFF);
    for (int u = c.tid; u < (LDS_BYTES - LDSCTL_OFF) / 4; u += NTHREADS) MISC[u] = 0u;
    __syncthreads();
    const int lo = a.ph_lo, hi = a.ph_hi;
    XcdBarrier bar; bar.bar = (unsigned*)(a.ws + WS_CTL) + CW_BAR; bar.x = 0; bar.st = MISC + 8;
    if (hi - lo > 1) bar = xcd_barrier_post((unsigned*)(a.ws + WS_CTL) + CW_BAR, MISC + 8);
    int ph = 0;
#define RUN_PHASE(body) do { if (ph >= lo && ph < hi) { body; if (ph + 1 < hi) xcd_barrier(bar); } ++ph; } while (0)
    RUN_PHASE(phase_p0a(a, c));
    RUN_PHASE(phase_p0b(a, c));
    for (int l = 0; l < DEPTH; ++l) {
        RUN_PHASE(phase_p1_simple(a, c, l));
        RUN_PHASE(phase_p2_simple(a, c, l));
        RUN_PHASE(phase_p3_simple(a, c, l));
        RUN_PHASE({ phase_p3b_simple(a, c, l); if (l == 1) conv_moe_weights(a, c, 1); });
        RUN_PHASE(phase_p4_simple(a, c, l));
        RUN_PHASE(phase_p5_simple(a, c, l));
        RUN_PHASE(phase_p5b_simple(a, c));
    }
    RUN_PHASE(phase_p6(a, c));
#undef RUN_PHASE
}

extern "C" void kernel_launch(void* const* d_in, const int* in_sizes, int n_in, void* d_out, int out_size, void* d_ws, size_t ws_size, hipStream_t stream) {
    static int grid = 0;
    if (grid == 0) {
        if (n_in != 21 || out_size != T * D || ws_size < WS_END) { fprintf(stderr, "kernel_launch: unexpected shapes (n_in %d, out %d, ws %zu)\n", n_in, out_size, ws_size); grid = -1; return; }
        int dev = 0, cus = 0, per_cu = 0;
        if (hipGetDevice(&dev) != hipSuccess || hipDeviceGetAttribute(&cus, hipDeviceAttributeMultiprocessorCount, dev) != hipSuccess) { grid = -1; return; }
        if (hipFuncSetAttribute((const void*)fwd_kernel, hipFuncAttributeMaxDynamicSharedMemorySize, LDS_BYTES) != hipSuccess) { fprintf(stderr, "kernel_launch: hipFuncSetAttribute failed\n"); grid = -1; return; }
        if (hipOccupancyMaxActiveBlocksPerMultiprocessor(&per_cu, (const void*)fwd_kernel, NTHREADS, LDS_BYTES) != hipSuccess || per_cu < 1)
            fprintf(stderr, "kernel_launch: occupancy query reports %d workgroups per CU\n", per_cu);
        (void)hipGetLastError();
        grid = cus;
    }
    if (grid < 0) return;
    if (hipMemsetAsync((char*)d_ws + WS_CTL, 0, CTL_BYTES, stream) != hipSuccess) return;
    Args a{};
    for (int i = 0; i < 21; ++i) a.in[i] = (const float*)d_in[i];
    a.out = (float*)d_out; a.ws = (unsigned char*)d_ws;
#if N_LAUNCH_MODE == 1
    a.ph_lo = 0; a.ph_hi = NPHASE;
    hipLaunchKernelGGL(fwd_kernel, dim3(grid), dim3(NTHREADS), LDS_BYTES, stream, a);
#else
    for (int ph = 0; ph < NPHASE; ++ph) {
        a.ph_lo = ph; a.ph_hi = ph + 1;
        hipLaunchKernelGGL(fwd_kernel, dim3(grid), dim3(NTHREADS), LDS_BYTES, stream, a);
    }
#endif
}
```

```cpp
#include <hip/hip_runtime.h>
#include <cstdio>
#include <cstdint>

constexpr int D = 1024, BATCH = 8, SEQ = 2048, T = BATCH * SEQ, DEPTH = 2;
constexpr int AW = 512, HD = 64, INC = 2560, CHUNK = 128;
constexpr int NE = 16, DE = 512, NBKT = 24, TOKCAP = 16384;
constexpr float EPS = 1e-6f;
constexpr float LOG2E = 1.4426950408889634f;
constexpr float C2 = 0.125f * LOG2E;
#ifndef FAST_P2
#define FAST_P2 1
#endif
#ifndef MERGE45
#define MERGE45 1
#endif
#ifndef EPI_TWICE
#define EPI_TWICE 0
#endif
#ifndef P2_REP
#define P2_REP 0
#endif
#ifndef DUP_MASK
#define DUP_MASK 0
#endif
#ifndef N_LAUNCH_MODE
#define N_LAUNCH_MODE 1
#endif

constexpr size_t MiB = 1u << 20;
constexpr size_t WS_CTL = 0, CTL_BYTES = 131072;
constexpr size_t WS_SMALL = 1 * MiB;
constexpr size_t WS_WIN = 9 * MiB;
constexpr size_t WS_WOUT = 19 * MiB;
constexpr size_t WS_WS = 23 * MiB;
constexpr size_t WS_WGU = 24 * MiB;
constexpr size_t WS_WD = 88 * MiB;
constexpr size_t WS_XA = 120 * MiB;
constexpr size_t WS_X2B = 152 * MiB;
constexpr size_t WS_ACTX = 184 * MiB;
constexpr size_t WS_PROJ = 216 * MiB;
constexpr size_t WS_QH = WS_PROJ + 32 * MiB, WS_KH = WS_PROJ + 48 * MiB, WS_VH = WS_PROJ + 64 * MiB;
constexpr size_t WS_A3 = 296 * MiB;
constexpr size_t WS_END = 328 * MiB;
constexpr size_t WS_ACT = WS_PROJ;
constexpr size_t SO_MODV = 0;
constexpr size_t SO_G1 = 512 * 1024;
constexpr size_t SO_G2 = 576 * 1024;
constexpr size_t SO_BIAS1 = 640 * 1024;
constexpr size_t SO_RBIAS = 800 * 1024;
constexpr size_t SO_BIASGU = 1 * MiB;
constexpr size_t SO_GATES = 2 * MiB;
constexpr size_t SO_TOKL = 2 * MiB + 512 * 1024;
constexpr size_t SO_SSQA = 4 * MiB;
constexpr size_t SO_SSQB = 5 * MiB;
constexpr size_t SO_ROWX = 7 * MiB + 512 * 1024;
constexpr size_t SO_RWT = 7 * MiB;
constexpr size_t SO_SSQC = 6 * MiB;
constexpr int CW_TMO = 0, CW_CNT = 64  , CW_BAR = 1024, CW_RDY = 8192  , CW_MOD = 32  , CW_SIB = 24576  , CW_PNL = 16384  ,
              CW_XT = 28672  , CW_GRP = 29184  ;

constexpr int NWAVES = 8, NTHREADS = 512;
constexpr int LDS_BYTES = 162816;
constexpr int LDSCTL_OFF = 143360;

#define GAS __attribute__((address_space(1)))
#define LAS __attribute__((address_space(3)))
typedef unsigned short bf16;
typedef short bf16x8 __attribute__((ext_vector_type(8)));
typedef float f32x4 __attribute__((ext_vector_type(4)));
typedef unsigned u32x4 __attribute__((ext_vector_type(4)));
#define LDS_WAIT() asm volatile("s_waitcnt lgkmcnt(0)" ::: "memory")

__device__ __forceinline__ float bf2f(bf16 b) { return __uint_as_float((unsigned)b << 16); }
__device__ __forceinline__ unsigned f2bf(float f) { unsigned u = __float_as_uint(f); return (u + 0x7fffu + ((u >> 16) & 1u)) >> 16; }
__device__ __forceinline__ unsigned pk2(float lo, float hi) { unsigned r; asm volatile("v_cvt_pk_bf16_f32 %0, %1, %2" : "=v"(r) : "v"(lo), "v"(hi)); return r; }
__device__ __forceinline__ float wave_sum(float v) {
    v += __builtin_bit_cast(float, __builtin_amdgcn_update_dpp(0, __builtin_bit_cast(int, v), 0xB1, 0xF, 0xF, true));
    v += __builtin_bit_cast(float, __builtin_amdgcn_update_dpp(0, __builtin_bit_cast(int, v), 0x4E, 0xF, 0xF, true));
    v += __builtin_bit_cast(float, __builtin_amdgcn_update_dpp(0, __builtin_bit_cast(int, v), 0x141, 0xF, 0xF, true));
    v += __builtin_bit_cast(float, __builtin_amdgcn_update_dpp(0, __builtin_bit_cast(int, v), 0x140, 0xF, 0xF, true));
    { auto rr = __builtin_amdgcn_permlane16_swap(__float_as_uint(v), __float_as_uint(v), false, false); v = __uint_as_float(rr[0]) + __uint_as_float(rr[1]); }
    { auto rr = __builtin_amdgcn_permlane32_swap(__float_as_uint(v), __float_as_uint(v), false, false); v = __uint_as_float(rr[0]) + __uint_as_float(rr[1]); }
    return v;
}
__device__ __forceinline__ float rows_sum(float v) {
    { auto rr = __builtin_amdgcn_permlane16_swap(__float_as_uint(v), __float_as_uint(v), false, false); v = __uint_as_float(rr[0]) + __uint_as_float(rr[1]); }
    { auto rr = __builtin_amdgcn_permlane32_swap(__float_as_uint(v), __float_as_uint(v), false, false); v = __uint_as_float(rr[0]) + __uint_as_float(rr[1]); }
    return v;
}
__device__ __forceinline__ float rows_max(float v) {
    { auto rr = __builtin_amdgcn_permlane16_swap(__float_as_uint(v), __float_as_uint(v), false, false); v = fmaxf(__uint_as_float(rr[0]), __uint_as_float(rr[1])); }
    { auto rr = __builtin_amdgcn_permlane32_swap(__float_as_uint(v), __float_as_uint(v), false, false); v = fmaxf(__uint_as_float(rr[0]), __uint_as_float(rr[1])); }
    return v;
}
__device__ __forceinline__ float oct_sum(float v) {
    v += __builtin_bit_cast(float, __builtin_amdgcn_update_dpp(0, __builtin_bit_cast(int, v), 0xB1, 0xF, 0xF, true));
    v += __builtin_bit_cast(float, __builtin_amdgcn_update_dpp(0, __builtin_bit_cast(int, v), 0x4E, 0xF, 0xF, true));
    v += __builtin_bit_cast(float, __builtin_amdgcn_update_dpp(0, __builtin_bit_cast(int, v), 0x141, 0xF, 0xF, true));
    return v;
}
__device__ __forceinline__ float gelu_exact(float x) { return 0.5f * x * (1.0f + erff(x * 0.70710678118654752f)); }
__device__ __forceinline__ float silu_f(float x) { return x / (1.0f + __expf(-x)); }

__device__ const unsigned char T5B[3][132] = {
{0,1,2,3,4,5,6,7,8,9,10,11,12,13,14,15,16,16,16,16,16,16,17,17,17,17,17,17,17,17,18,18,18,18,18,18,18,18,18,18,19,19,19,19,19,19,19,19,19,19,19,19,19,19,20,20,20,20,20,20,20,20,20,20,20,20,20,20,20,20,20,20,20,21,21,21,21,21,21,21,21,21,21,21,21,21,21,21,21,21,21,21,21,21,21,21,21,21,21,22,22,22,22,22,22,22,22,22,22,22,22,22,22,22,22,22,22,22,22,22,22,22,22,22,22,22,22,22,22,0,0,0},
{0,4,8,12,16,16,17,17,18,18,19,19,19,19,20,20,20,20,20,21,21,21,21,21,21,22,22,22,22,22,22,22,22,22,23,23,23,23,23,23,23,23,23,23,23,23,24,24,24,24,24,24,24,24,24,24,24,24,24,24,24,24,25,25,25,25,25,25,25,25,25,25,25,25,25,25,25,25,25,25,25,25,25,26,26,26,26,26,26,26,26,26,26,26,26,26,26,26,26,26,26,26,26,26,26,26,26,26,26,26,26,26,26,27,27,27,27,27,27,27,27,27,27,27,27,27,27,27,27,0,0,0},
{0,16,18,19,20,21,21,22,22,23,23,23,24,24,24,24,25,25,25,25,25,26,26,26,26,26,26,26,26,27,27,27,27,27,27,27,27,27,27,28,28,28,28,28,28,28,28,28,28,28,28,28,29,29,29,29,29,29,29,29,29,29,29,29,29,29,29,29,29,29,30,30,30,30,30,30,30,30,30,30,30,30,30,30,30,30,30,30,30,30,30,30,30,30,30,31,31,31,31,31,31,31,31,31,31,31,31,31,31,31,31,31,31,31,31,31,31,31,31,31,31,31,31,31,31,31,31,31,31,0,0,0}};

#define XB_TMO      128
#define XB_XCNT(j)  (256  + 64 * (j))
#define XB_XSUB(j)  (1280 + 64 * (j))
#define XB_XGEN(j)  (2304 + 64 * (j))
#define XB_TOP      3328
#define XB_TOPGEN   3392
#define XCD_BAR_WORDS 3456
#define XB_SPIN_CAP (1u << 18)

__device__ __forceinline__ unsigned xb_ld(unsigned* p)              { return __hip_atomic_load(p, __ATOMIC_RELAXED, __HIP_MEMORY_SCOPE_AGENT); }
__device__ __forceinline__ unsigned xb_add(unsigned* p, unsigned v) { return __hip_atomic_fetch_add(p, v, __ATOMIC_RELAXED, __HIP_MEMORY_SCOPE_AGENT); }
__device__ __forceinline__ unsigned xb_xcc_id() { return (unsigned)__builtin_amdgcn_s_getreg((3 << 11) | 20) & 0xFu; }
#define XB_SPIN(cond, bar) do { unsigned _sp = 0; while (cond) { __builtin_amdgcn_s_sleep(1); \
    if ((++_sp & 255u) == 0u) { if (xb_ld(&(bar)[XB_TMO])) break; if (_sp > XB_SPIN_CAP) { atomicAdd(&(bar)[XB_TMO], 1u); break; } } } } while (0)

struct XcdBarrier {
    unsigned* bar; unsigned x;
    volatile LAS unsigned* st;
};
__device__ __forceinline__ XcdBarrier xcd_barrier_post(unsigned* bar, volatile LAS unsigned* st, int tid) {
    XcdBarrier b; b.bar = bar; b.x = xb_xcc_id(); b.st = st;
    if (tid == 0) (void)xb_add(&bar[XB_XCNT(b.x)], 1u);
    return b;
}
__device__ __forceinline__ void xcd_barrier_complete(unsigned* bar, unsigned x, unsigned& nloc, unsigned& nx) {
    const unsigned G = gridDim.x * gridDim.y * gridDim.z;
    unsigned sum, cnt, mine, sp = 0u;
    for (;;) {
        sum = 0u; cnt = 0u; mine = 0u;
#pragma unroll
        for (unsigned j = 0; j < 16; ++j) { const unsigned c = xb_ld(&bar[XB_XCNT(j)]); sum += c; cnt += (c > 0u) ? 1u : 0u; mine = (j == x) ? c : mine; }
        if (sum == G) break;
        __builtin_amdgcn_s_sleep(1);
        if ((++sp & 255u) == 0u) { if (xb_ld(&bar[XB_TMO])) break; if (sp > XB_SPIN_CAP) { atomicAdd(&bar[XB_TMO], 1u); break; } }
    }
    nloc = mine > 0u ? mine : 1u; nx = cnt > 0u ? cnt : 1u;
}
__device__ __forceinline__ void xcd_barrier(const XcdBarrier& b, int tid) {
    asm volatile("s_waitcnt vmcnt(0)" ::: "memory");
    __syncthreads();
    if (tid == 0) {
        unsigned* bar = b.bar;
        __builtin_amdgcn_s_waitcnt(0);
        unsigned nloc = b.st[0], nx = b.st[1];
        if (nloc == 0u) { xcd_barrier_complete(bar, b.x, nloc, nx); b.st[0] = nloc; b.st[1] = nx; }
        const unsigned old = xb_add(&bar[XB_XSUB(b.x)], 1u);
        const unsigned gen = old / nloc;
        if (old + 1u == (gen + 1u) * nloc) {
            __builtin_amdgcn_fence(__ATOMIC_RELEASE, "agent");
            asm volatile("s_waitcnt vmcnt(0)" ::: "memory");
            const unsigned og = xb_add(&bar[XB_TOP], 1u);
            const unsigned tg = og / nx;
            if (og + 1u == (tg + 1u) * nx) xb_add(&bar[XB_TOPGEN], 1u);
            else XB_SPIN(xb_ld(&bar[XB_TOPGEN]) == tg, bar);
            __builtin_amdgcn_fence(__ATOMIC_ACQUIRE, "agent");
            xb_add(&bar[XB_XGEN(b.x)], 1u);
            asm volatile("s_waitcnt vmcnt(0)" ::: "memory");
        } else {
            XB_SPIN(xb_ld(&bar[XB_XGEN(b.x)]) == gen, bar);
            __builtin_amdgcn_fence(__ATOMIC_ACQUIRE, "agent");
            asm volatile("s_waitcnt vmcnt(0)" ::: "memory");
        }
    }
    __syncthreads();
}

__device__ __forceinline__ void group_barrier(unsigned* ctl, int inst, int wg, int tid) {
    asm volatile("s_waitcnt vmcnt(0)" ::: "memory");
    __syncthreads();
    if (tid == 0) {
        unsigned* w = ctl + CW_GRP + (inst * 8 + (wg & 7)) * 16; unsigned* bar = ctl + CW_BAR;
        __builtin_amdgcn_s_waitcnt(0);
        (void)xb_add(w, 1u);
        XB_SPIN(xb_ld(w) < 32u, bar);
        __builtin_amdgcn_fence(__ATOMIC_ACQUIRE, "agent");
        asm volatile("s_waitcnt vmcnt(0)" ::: "memory");
    }
    __syncthreads();
}

struct Args { const float* in[21]; float* out; unsigned char* ws; int ph_lo, ph_hi; };
enum { I_X = 0, I_C, I_RELB, I_RW, I_RB, I_MODW, I_MODB, I_N1G, I_WIN, I_LNG, I_LNB, I_GWS, I_GBS, I_ONA, I_ONB, I_WOUT, I_N2G, I_WG, I_WU, I_WD, I_FING };

struct Ctx {
    int tid, lane, wave, wg, nwg, gw, ngw, gtid, ngt;
    LAS unsigned char* lds;
};

__device__ __forceinline__ void bucket_experts(int bkt, int& e0, int& e1) {
    const int grp = bkt / 6, pi = bkt % 6;
    const int pa = (pi >= 3) + (pi >= 5);
    const int pb = pi + 1 - (pa == 0 ? 0 : (pa == 1 ? 2 : 3));
    e0 = grp * 4 + pa; e1 = grp * 4 + pb;
}
__device__ __forceinline__ float rstd_from16(const float* ssq, int t) {
    const f32x4* p = (const f32x4*)(ssq + (size_t)t * 16);
    const f32x4 a = p[0], b = p[1], c = p[2], d = p[3];
    const float s = ((a.x + a.y) + (a.z + a.w)) + ((b.x + b.y) + (b.z + b.w)) + ((c.x + c.y) + (c.z + c.w)) + ((d.x + d.y) + (d.z + d.w));
    return rsqrtf(s * (1.0f / 1024.0f) + EPS);
}

__device__ __forceinline__ void tr_item(const float* W, int ldw, int k0, int n0, bf16* WT, int ldt, int drow0, const float* kscale, float nscale, LAS float* scr, int lane) {
    {
        f32x4 v[8];
#pragma unroll
        for (int j = 0; j < 8; ++j) v[j] = __builtin_nontemporal_load((const f32x4*)&W[(size_t)(k0 + 8 * j + (lane >> 3)) * ldw + n0 + (lane & 7) * 4]);
#pragma unroll
        for (int j = 0; j < 8; ++j) { const int kk = 8 * j + (lane >> 3); const float sc = (kscale ? kscale[k0 + kk] : 1.0f) * nscale; LAS float* d = scr + kk * 33 + (lane & 7) * 4;
            d[0] = v[j][0] * sc; d[1] = v[j][1] * sc; d[2] = v[j][2] * sc; d[3] = v[j][3] * sc; }
    }
    LDS_WAIT(); asm volatile("" ::: "memory");
    const int c = lane & 7;
#pragma unroll
    for (int j = 0; j < 4; ++j) {
        const int n = (lane >> 3) + 8 * j; const LAS float* s = scr + (8 * c) * 33 + n;
        u32x4 o; o.x = pk2(s[0 * 33], s[1 * 33]); o.y = pk2(s[2 * 33], s[3 * 33]); o.z = pk2(s[4 * 33], s[5 * 33]); o.w = pk2(s[6 * 33], s[7 * 33]);
        __builtin_nontemporal_store(o, (u32x4*)(WT + (size_t)(drow0 + n) * ldt + k0 + 8 * c));
    }
    LDS_WAIT(); asm volatile("" ::: "memory");
}
__device__ __forceinline__ void conv_wdown(const Args& a, const Ctx& c) {
    LAS float* scr = (LAS float*)(c.lds + c.wave * 8704);
    bf16* wd = (bf16*)(a.ws + WS_WD);
    for (int it = c.gw; it < DEPTH * NE * 256; it += c.ngw) {
        const int le = it >> 8, q = it & 255, kb = q / 32, nb = q % 32;
        tr_item(a.in[I_WD] + (size_t)le * 512 * 1024, 1024, kb * 64, nb * 32, wd + (size_t)le * 1024 * 512, 512, nb * 32, nullptr, 1.0f, scr, c.lane);
    }
}
__device__ __forceinline__ void conv_panel_item(const float* W, int ldw, int n0, bf16* WT, int drow0, float nscale, const float* sh, float* out, int ob, LAS unsigned char* lds, int wave, int lane, int tid, bool nts) {
    LAS float* scr = (LAS float*)(lds + wave * 12800); LAS float* shl = (LAS float*)(lds + wave * 12800 + 8704);
    LAS float* red = (LAS float*)(lds + 8 * 12800);
    const int kbase = wave * 128;
#pragma unroll
    for (int i = 0; i < 16; ++i) { const int id = lane + 64 * i, b = id >> 7, kk = id & 127; shl[id] = sh[b * 6144 + kbase + kk]; }
    const int n = lane & 31, bh = lane >> 5;
    float acc[4] = {0.f, 0.f, 0.f, 0.f};
#pragma unroll 1
    for (int tI = 0; tI < 2; ++tI) {
        const int k0 = kbase + 64 * tI;
        {
            f32x4 v[8];
#pragma unroll
            for (int j = 0; j < 8; ++j) v[j] = __builtin_nontemporal_load((const f32x4*)&W[(size_t)(k0 + 8 * j + (lane >> 3)) * ldw + n0 + (lane & 7) * 4]);
#pragma unroll
            for (int j = 0; j < 8; ++j) { LAS float* d = scr + (8 * j + (lane >> 3)) * 33 + (lane & 7) * 4; d[0] = v[j][0] * nscale; d[1] = v[j][1] * nscale; d[2] = v[j][2] * nscale; d[3] = v[j][3] * nscale; }
        }
        LDS_WAIT(); asm volatile("" ::: "memory");
        const int cc = lane & 7;
#pragma unroll
        for (int j = 0; j < 4; ++j) {
            const int nn = (lane >> 3) + 8 * j; const LAS float* s = scr + (8 * cc) * 33 + nn;
            u32x4 o; o.x = pk2(s[0 * 33], s[1 * 33]); o.y = pk2(s[2 * 33], s[3 * 33]); o.z = pk2(s[4 * 33], s[5 * 33]); o.w = pk2(s[6 * 33], s[7 * 33]);
            if (nts) __builtin_nontemporal_store(o, (u32x4*)(WT + (size_t)(drow0 + nn) * 1024 + k0 + 8 * cc)); else *(u32x4*)(WT + (size_t)(drow0 + nn) * 1024 + k0 + 8 * cc) = o;
        }
#pragma unroll 4
        for (int k4 = 0; k4 < 64; k4 += 4) {
            const float v0 = scr[(k4 + 0) * 33 + n], v1 = scr[(k4 + 1) * 33 + n], v2 = scr[(k4 + 2) * 33 + n], v3 = scr[(k4 + 3) * 33 + n];
#pragma unroll
            for (int i = 0; i < 4; ++i) { const f32x4 s4 = *(const LAS f32x4*)(shl + (4 * bh + i) * 128 + 64 * tI + k4); acc[i] += (s4.x * v0 + s4.y * v1) + (s4.z * v2 + s4.w * v3); }
        }
        LDS_WAIT(); asm volatile("" ::: "memory");
    }
#pragma unroll
    for (int i = 0; i < 4; ++i) red[(wave * 8 + 4 * bh + i) * 32 + n] = acc[i];
    __syncthreads();
    if (tid < 256) { const int b = tid >> 5, nn = tid & 31; float s = 0.f;
#pragma unroll
        for (int w = 0; w < 8; ++w) s += red[(w * 8 + b) * 32 + nn];
        out[(size_t)b * ob + nn] = s; }
    __syncthreads();
}
template <class SH>
__device__ __forceinline__ void bias_item(const float* Wc, int ldw, const SH* sh, int shs, float* out, int ob, float scale, const float* addv, LAS float* red, int tid) {
    const int c4 = tid & 15, kc = tid >> 4;
    f32x4 acc[8];
#pragma unroll
    for (int b = 0; b < 8; ++b) acc[b] = (f32x4){0.f, 0.f, 0.f, 0.f};
#pragma unroll 1
    for (int k0 = kc * 32; k0 < kc * 32 + 32; k0 += 16) {
        f32x4 w[16];
#pragma unroll
        for (int u = 0; u < 16; ++u) w[u] = __builtin_nontemporal_load((const f32x4*)&Wc[(size_t)(k0 + u) * ldw + c4 * 4]);
#pragma unroll
        for (int u = 0; u < 16; ++u)
#pragma unroll
            for (int b = 0; b < 8; ++b) acc[b] = acc[b] + w[u] * (float)sh[b * shs + k0 + u];
    }
#pragma unroll
    for (int b = 0; b < 8; ++b) *(LAS f32x4*)(red + (kc * 8 + b) * 64 + c4 * 4) = acc[b];
    __syncthreads();
    {
        const int b = tid >> 6, nn = tid & 63; float s = 0.f;
#pragma unroll
        for (int k2 = 0; k2 < 32; ++k2) s += red[(k2 * 8 + b) * 64 + nn];
        __hip_atomic_store(out + (size_t)b * ob + nn, s * scale + (addv ? addv[nn] : 0.f), __ATOMIC_RELAXED, __HIP_MEMORY_SCOPE_AGENT);
    }
    __syncthreads();
}
__device__ __forceinline__ void phase_p0a(const Args& a, const Ctx& c) {
    float* modv = (float*)(a.ws + WS_SMALL + SO_MODV);
    if (c.wg < 192) {
        LAS float* cact = (LAS float*)(c.lds + 65536);
        for (int i = c.tid; i < 8 * 1024; i += NTHREADS) cact[i] = silu_f(a.in[I_C][i]);
        __syncthreads();
        const int l = c.wg / 96, j0 = (c.wg % 96) * 64;
        bias_item(a.in[I_MODW] + (size_t)l * 1024 * 6144 + j0, 6144, cact, 1024, modv + (size_t)l * 8 * 6144 + j0, 6144, 1.0f, a.in[I_MODB] + l * 6144 + j0, (LAS float*)c.lds, c.tid);
        asm volatile("s_waitcnt vmcnt(0)" ::: "memory");
        __syncthreads();
        if (c.tid == 0) __hip_atomic_fetch_add((unsigned*)(a.ws + WS_CTL) + CW_MOD, 1u, __ATOMIC_RELAXED, __HIP_MEMORY_SCOPE_AGENT);
    }
    {
        bf16* rwt = (bf16*)(a.ws + WS_SMALL + SO_RWT);
        for (int i = c.gtid; i < 16 * 1024; i += c.ngt) { const int e = i >> 10, kk = i & 1023; rwt[i] = (bf16)f2bf(a.in[I_RW][kk * 16 + e]); }
    }
    LAS float* scr = (LAS float*)(c.lds + c.wave * 8704);
    {
        bf16* wtout = (bf16*)(a.ws + WS_WOUT);
        for (int it = c.gw; it < DEPTH * 512; it += c.ngw) {
            const int l = it >> 9, q = it & 511, kb = q / 32, nb = q % 32, k0 = kb * 64;
            const float* ks = (k0 < 512) ? (a.in[I_ONA] + l * 512) : (a.in[I_ONB] + l * 512 - 512);
            tr_item(a.in[I_WOUT] + (size_t)l * 1024 * 1024, 1024, k0, nb * 32, wtout + (size_t)l * 1024 * 1024, 1024, nb * 32, ks, 1.0f, scr, c.lane);
        }
    }
    {
        bf16* ws = (bf16*)(a.ws + WS_WS); const float* g = a.in[I_GWS];
        for (int i = c.gtid; i < DEPTH * 8 * 128 * 128; i += c.ngt) {
            const int col = i & 127, t = (i >> 7) & 127, ks = col >> 4, hh = (col >> 3) & 1, jj = col & 7, s = 16 * ks + 8 * (jj >> 2) + 4 * hh + (jj & 3);
            ws[i] = (bf16)f2bf(s <= t ? g[(i & ~127) + s] : 0.f);
        }
    }
    conv_wdown(a, c);
}

__device__ __forceinline__ void phase_p0b(const Args& a, const Ctx& c) {
    {
        unsigned* w = (unsigned*)(a.ws + WS_CTL) + CW_MOD; unsigned* tmo = (unsigned*)(a.ws + WS_CTL) + CW_TMO;
        if (c.tid < 64) {
            unsigned sp = 0;
            while ((unsigned)__builtin_amdgcn_readfirstlane(__hip_atomic_load(w, __ATOMIC_RELAXED, __HIP_MEMORY_SCOPE_AGENT)) < 192u) {
                __builtin_amdgcn_s_sleep(2);
                if ((++sp & 255u) == 0u) { if (__builtin_amdgcn_readfirstlane(__hip_atomic_load(tmo, __ATOMIC_RELAXED, __HIP_MEMORY_SCOPE_AGENT)) != 0u) break;
                    if (sp > (1u << 20)) { if (c.lane == 0) __hip_atomic_store(tmo, 0x11u, __ATOMIC_RELAXED, __HIP_MEMORY_SCOPE_AGENT); break; } }
            }
            __builtin_amdgcn_fence(__ATOMIC_ACQUIRE, "agent");
            asm volatile("s_waitcnt vmcnt(0)" ::: "memory");
        }
        __syncthreads();
    }
    const float* modv = (const float*)(a.ws + WS_SMALL + SO_MODV);
    float* G1 = (float*)(a.ws + WS_SMALL + SO_G1); float* G2 = (float*)(a.ws + WS_SMALL + SO_G2);
    for (int i = c.gtid; i < DEPTH * BATCH * 1024; i += c.ngt) {
        const int k = i & 1023, lb = i >> 10, l = lb / BATCH;
        G1[i] = a.in[I_N1G][l * 1024 + k] * (1.0f + modv[(size_t)lb * 6144 + 1024 + k]);
        G2[i] = a.in[I_N2G][l * 1024 + k] * (1.0f + modv[(size_t)lb * 6144 + 4096 + k]);
    }
    {
        float* rb = (float*)(a.ws + WS_SMALL + SO_RBIAS);
        for (int i = c.gw; i < DEPTH * BATCH * 16; i += c.ngw) {
            const int e = i & 15, lb = i >> 4; const float* sh = modv + (size_t)lb * 6144 + 3072; float acc = 0.f;
#pragma unroll
            for (int j = 0; j < 16; ++j) { const int kk = c.lane + 64 * j; acc += sh[kk] * a.in[I_RW][kk * 16 + e]; }
            acc = wave_sum(acc);
            if (c.lane == 0) rb[i] = acc;
        }
    }
    {
        float* bias1 = (float*)(a.ws + WS_SMALL + SO_BIAS1); float* biasgu = (float*)(a.ws + WS_SMALL + SO_BIASGU);
        bf16* wtin = (bf16*)(a.ws + WS_WIN); bf16* wgu = (bf16*)(a.ws + WS_WGU);
        for (int it = c.wg; it < 160 + 1024; it += c.nwg) {
            if (it < 160) {
                const int l = it / 80, n0 = (it % 80) * 32; const float sc = (n0 >= 1024 && n0 < 1536) ? C2 : 1.0f;
                conv_panel_item(a.in[I_WIN] + (size_t)l * 1024 * INC, INC, n0, wtin + (size_t)l * INC * 1024, n0, sc, modv + (size_t)l * 8 * 6144, bias1 + (size_t)l * 8 * INC + n0, INC, c.lds, c.wave, c.lane, c.tid, l != 0);
            } else {
                const int r = it - 160, le = r >> 5, q = r & 31, half = q >> 4, nb = q & 15, n0 = nb * 32, l = le >> 4, e = le & 15;
                const float* W = (half ? a.in[I_WU] : a.in[I_WG]) + (size_t)le * 1024 * 512;
                const int drow0 = (n0 / 128) * 256 + (n0 % 128) + half * 128;
                conv_panel_item(W, 512, n0, wgu + (size_t)le * 1024 * 1024, drow0, 1.0f, modv + (size_t)l * 8 * 6144 + 3072, biasgu + ((size_t)l * 8 * 16 + e) * 1024 + drow0, 16 * 1024, c.lds, c.wave, c.lane, c.tid, true);
            }
        }
    }
    {
        bf16* A1 = (bf16*)(a.ws + WS_ACTX); float* ssq = (float*)(a.ws + WS_SMALL + SO_SSQA);
        const float* x = a.in[I_X];
        for (int t = c.gw; t < T; t += c.ngw) {
            const int b = t / SEQ; float s = 0.f;
            const f32x4* xr = (const f32x4*)(x + (size_t)t * 1024);
#pragma unroll
            for (int j = 0; j < 4; ++j) {
                const int kk = (c.lane + 64 * j) * 4; const f32x4 v = __builtin_nontemporal_load(&xr[c.lane + 64 * j]);
                s += (v.x * v.x + v.y * v.y) + (v.z * v.z + v.w * v.w);
                const f32x4 ng = *(const f32x4*)(a.in[I_N1G] + kk), sc = *(const f32x4*)(modv + (size_t)b * 6144 + 1024 + kk);
                uint2 o; o.x = pk2(v.x * ng.x * (1.0f + sc.x), v.y * ng.y * (1.0f + sc.y)); o.y = pk2(v.z * ng.z * (1.0f + sc.z), v.w * ng.w * (1.0f + sc.w));
                *(uint2*)(A1 + (size_t)t * 1024 + kk) = o;
            }
            s = wave_sum(s);
            if (c.lane < 16) ssq[(size_t)t * 16 + c.lane] = (c.lane == 0) ? s : 0.f;
            if (c.lane == 0) ((int*)(a.ws + WS_SMALL + SO_ROWX))[t] = t;
        }
    }
}

__device__ __forceinline__ void route_tokens(const Args& a, const Ctx& c, int l, int cslot, int tbase, int nw) {
    const bf16* A2 = (const bf16*)(a.ws + WS_ACTX); const bf16* rwt = (const bf16*)(a.ws + WS_SMALL + SO_RWT);
    const float* ssq = (const float*)(a.ws + WS_SMALL + SO_SSQB); const float* rbias = (const float*)(a.ws + WS_SMALL + SO_RBIAS) + l * 8 * 16;
    float* gates = (float*)(a.ws + WS_SMALL + SO_GATES); int* tokl = (int*)(a.ws + WS_SMALL + SO_TOKL);
    unsigned* cnt = (unsigned*)(a.ws + WS_CTL) + CW_CNT + cslot * 32; const float* rb = a.in[I_RB];
    const int fr = c.lane & 15, fq = c.lane >> 4;
    LAS unsigned* hist = (LAS unsigned*)(c.lds + 131072 + 1024); LAS unsigned* base = (LAS unsigned*)(c.lds + 131072 + 1024 + 128);
    {
        if (c.tid < 32) hist[c.tid] = 0u;
        for (int i0 = c.tid; i0 < nw * 16 * 128; i0 += 8 * NTHREADS) {
            u32x4 rr[8];
#pragma unroll
            for (int j = 0; j < 8; ++j) { const int i = i0 + j * NTHREADS, row = i >> 7, ch = i & 127; rr[j] = *(const u32x4*)(A2 + (size_t)(tbase + row) * 1024 + ch * 8); }
#pragma unroll
            for (int j = 0; j < 8; ++j) { const int i = i0 + j * NTHREADS, row = i >> 7, ch = i & 127; *(LAS u32x4*)(c.lds + row * 2048 + ((ch ^ (row & 15)) << 4)) = rr[j]; }
        }
        __syncthreads();
        const bool act = c.wave < nw;
        const int rloc = (act ? c.wave : 0) * 16 + fr, t = tbase + rloc, b = t >> 11;
        const LAS unsigned char* arow = c.lds + rloc * 2048; const bf16* wrow = rwt + fr * 1024 + 8 * fq;
        f32x4 acc = {0.f, 0.f, 0.f, 0.f};
#pragma unroll 16
        for (int k0 = 0; k0 < 1024; k0 += 32) acc = __builtin_amdgcn_mfma_f32_16x16x32_bf16(*(const bf16x8*)(wrow + k0), *(const LAS bf16x8*)(arow + ((((k0 >> 3) + fq) ^ (rloc & 15)) << 4)), acc, 0, 0, 0);
        const float rs = rstd_from16(ssq, t);
        float lg[4], p[4], sel[4];
#pragma unroll
        for (int j = 0; j < 4; ++j) lg[j] = rs * acc[j] + rbias[b * 16 + 4 * fq + j];
        float mx = fmaxf(fmaxf(lg[0], lg[1]), fmaxf(lg[2], lg[3]));
        mx = rows_max(mx);
        float ps = 0.f;
#pragma unroll
        for (int j = 0; j < 4; ++j) { p[j] = __expf(lg[j] - mx); ps += p[j]; }
        ps = rows_sum(ps);
        const float inv = 1.0f / ps;
#pragma unroll
        for (int j = 0; j < 4; ++j) { p[j] *= inv; sel[j] = p[j] + rb[4 * fq + j]; }
        float m1 = -INFINITY, m2 = -INFINITY;
#pragma unroll
        for (int j = 0; j < 4; ++j) { const float v = sel[j]; if (v > m1) { m2 = m1; m1 = v; } else if (v > m2) { m2 = v; } }
        const float gs = m1 + m2;
        int best = 0; float bests = __shfl(gs, fr);
#pragma unroll
        for (int gg = 1; gg < 4; ++gg) { const float o = __shfl(gs, fr + 16 * gg); if (o > bests) { bests = o; best = gg; } }
        int bkt = 0; unsigned rank = 0u; float ga = 0.f, gb = 0.f;
        const bool win = act && (fq == best);
        if (win) {
            int i1 = 0; float v1 = sel[0];
            if (sel[1] > v1) { v1 = sel[1]; i1 = 1; } if (sel[2] > v1) { v1 = sel[2]; i1 = 2; } if (sel[3] > v1) { v1 = sel[3]; i1 = 3; }
            int i2 = -1; float v2 = -INFINITY;
            if (i1 != 0 && sel[0] > v2) { v2 = sel[0]; i2 = 0; } if (i1 != 1 && sel[1] > v2) { v2 = sel[1]; i2 = 1; } if (i1 != 2 && sel[2] > v2) { v2 = sel[2]; i2 = 2; } if (i1 != 3 && sel[3] > v2) { v2 = sel[3]; i2 = 3; }
            const int ea = min(i1, i2), eb = max(i1, i2);
            const float pa = (ea == 0) ? p[0] : (ea == 1) ? p[1] : (ea == 2) ? p[2] : p[3];
            const float pb = (eb == 0) ? p[0] : (eb == 1) ? p[1] : (eb == 2) ? p[2] : p[3];
            const int pi = (ea == 0) ? (eb - 1) : (ea == 1) ? (eb + 1) : 5;
            bkt = best * 6 + pi; ga = pa / (pa + pb); gb = pb / (pa + pb);
            rank = atomicAdd((unsigned*)(hist + bkt), 1u);
        }
        __syncthreads();
        if (c.tid < NBKT) { const unsigned n = hist[c.tid]; base[c.tid] = n ? atomicAdd(&cnt[c.tid], n) : 0u; }
        __syncthreads();
        if (win) {
            const unsigned pos = base[bkt] + rank;
            tokl[bkt * TOKCAP + (int)pos] = t;
            gates[(size_t)t * 2] = ga; gates[(size_t)t * 2 + 1] = gb;
        }
        __syncthreads();
    }
}

__device__ __forceinline__ void phase_p6(const Args& a, const Ctx& c) {
    const float* ssq = (const float*)(a.ws + WS_SMALL + SO_SSQA); const float* fg = a.in[I_FING];
    const int* rowx = (const int*)(a.ws + WS_SMALL + SO_ROWX); const bf16* x2b = (const bf16*)(a.ws + WS_X2B);
    for (int t = c.gw; t < T; t += c.ngw) {
        const int r = rowx[t]; const float rs = rstd_from16(ssq, t);
        const uint2* xr = (const uint2*)(x2b + (size_t)r * 1024); f32x4* orow = (f32x4*)(a.out + (size_t)t * 1024);
#pragma unroll
        for (int j = 0; j < 4; ++j) {
            typedef unsigned u32x2 __attribute__((ext_vector_type(2)));
            const u32x2 rw = __builtin_nontemporal_load((const u32x2*)&xr[c.lane + 64 * j]); uint2 raw; raw.x = rw.x; raw.y = rw.y; const f32x4 g = ((const f32x4*)fg)[c.lane + 64 * j];
            f32x4 v; v.x = __uint_as_float(raw.x << 16) * rs * g.x; v.y = __uint_as_float(raw.x & 0xffff0000u) * rs * g.y; v.z = __uint_as_float(raw.y << 16) * rs * g.z; v.w = __uint_as_float(raw.y & 0xffff0000u) * rs * g.w;
            __builtin_nontemporal_store(v, &orow[c.lane + 64 * j]);
        }
    }
}

namespace mm {
constexpr int BM = 256, BK = 64, HALF = 128, HTB = HALF * BK * 2, STAGE_BYTES = 8 * HTB;
__device__ __forceinline__ int lds_byte(int r, int c) { const int st = (r >> 4) * 2 + (c >> 5), rr = r & 15, cc = c & 31, ob = rr * 64 + cc * 2; return st * 1024 + (ob ^ (((ob >> 9) & 1) << 5)); }
__device__ __forceinline__ void stage_rc(int b, int& R, int& C) { const int st = b / 1024, sb = b % 1024, swz = sb ^ (((sb >> 9) & 1) << 5); R = (st >> 1) * 16 + swz / 64; C = (st & 1) * 32 + (swz % 64) / 2; }
__device__ __forceinline__ int perm32(int rho) { const int n = rho >> 4, i = rho & 15; return 8 * (i >> 2) + 4 * n + (i & 3); }
__device__ __forceinline__ int xcd_remap(int L, int nU) { const int q = nU / 8, r = nU % 8, xcd = L % 8, off = L / 8; return (xcd < r ? xcd * (q + 1) : r * (q + 1) + (xcd - r) * q) + off; }

constexpr int SIDE_OFF = 146432;
constexpr int TAB_OFF = 131072;
struct MUnit { const char* A; const char* B; int first, last; int i0, i1, i2, i3, i4, i5; };

__device__ __forceinline__ unsigned cvt_pk_bf16(float lo, float hi) { unsigned r; asm volatile("v_cvt_pk_bf16_f32 %0, %1, %2" : "=v"(r) : "v"(lo), "v"(hi)); return r; }
typedef float f32x2 __attribute__((ext_vector_type(2)));
__device__ __forceinline__ f32x2 gelu_pk(f32x2 v) {
    f32x2 c; c.x = __builtin_amdgcn_fmed3f(v.x, -4.25f, 4.25f); c.y = __builtin_amdgcn_fmed3f(v.y, -4.25f, 4.25f);
    const f32x2 u = c * c;
    f32x2 q = u * (-8.460361597e-10f) + 7.570799355e-08f;
    q = q * u + (-2.938792968e-06f); q = q * u + 6.552695497e-05f; q = q * u + (-9.404465092e-04f); q = q * u + 9.257818770e-03f; q = q * u + (-6.545349156e-02f); q = q * u + 3.984200383e-01f;
    const f32x2 ph = c * q + 0.5f;
    return v * ph;
}

template <class Epi, class Sched, bool GATHER>
__device__ __forceinline__ void mm_phase(LAS unsigned char* lds, const Sched& S, const Epi& E, const int tid) {
    const int wid = __builtin_amdgcn_readfirstlane(tid >> 6), lane = tid & 63, wr = wid >> 2, wc = wid & 3, fr = lane & 15, fq = lane >> 4;
    const int nt = S.nt; const unsigned lda = S.lda, ldb = S.ldb;
    int Rr[2], Cc;
    unsigned voffA[2], voffB[2];
#pragma unroll
    for (int i = 0; i < 2; ++i) { int R, C; stage_rc(tid * 16 + i * 8192, R, C); const int Rb = Epi::PERM ? ((R & ~31) + perm32(R & 31)) : R;
        Rr[i] = R; Cc = C; voffA[i] = (unsigned)R * lda + (unsigned)C * 2u; voffB[i] = (unsigned)Rb * ldb + (unsigned)C * 2u; }
    const size_t kstep = (size_t)(BK * 2);
    const size_t hstepA = (size_t)HALF * lda, hstepB = (size_t)HALF * ldb;
    const unsigned ldsw = (unsigned)wid * 1024u;
    const int aoff = lds_byte(wr * 64 + fr, fq * 8), boff = lds_byte(wc * 32 + fr, fq * 8);
#define MM_SA(b, h) (((b) * 2 + (h)) * HTB)
#define MM_SB(b, h) ((4 + (b) * 2 + (h)) * HTB)
#define MM_STAGE_B(bufoff, gbase) do { _Pragma("unroll") for (int _i = 0; _i < 2; ++_i) \
        __builtin_amdgcn_global_load_lds((const unsigned*)((const char*)(gbase) + voffB[_i]), (LAS unsigned*)(lds + (bufoff) + ldsw + _i * 8192), 16, 0, 0); } while (0)
#define MM_STAGE_A(bufoff, nx, h, koff) do { \
        const char* gb_ = GATHER ? (cA + (koff)) : (((nx) ? nA : cA) + (size_t)(h) * hstepA + (koff)); \
        _Pragma("unroll") for (int _i = 0; _i < 2; ++_i) { \
            unsigned vo_ = GATHER ? vAc[h][_i] : voffA[_i]; \
            if (GATHER) { if (nx) vo_ = S.gather1(nslot, (h) * 128 + Rr[_i], Cc, lds); } \
            __builtin_amdgcn_global_load_lds((const unsigned*)(gb_ + vo_), (LAS unsigned*)(lds + (bufoff) + ldsw + _i * 8192), 16, 0, 0); } } while (0)
#define MM_LDA(dst, b, h) do { _Pragma("unroll") for (int m = 0; m < 4; ++m) _Pragma("unroll") for (int k = 0; k < 2; ++k) dst[m][k] = *(const LAS bf16x8*)(lds + MM_SA(b, h) + aoff + m * 2048 + k * 1024); } while (0)
#define MM_LDB(dst, b, h) do { _Pragma("unroll") for (int n = 0; n < 2; ++n) _Pragma("unroll") for (int k = 0; k < 2; ++k) dst[n][k] = *(const LAS bf16x8*)(lds + MM_SB(b, h) + boff + n * 2048 + k * 1024); } while (0)
#define MM_MMA(ai, bj, At, Bt) do { __builtin_amdgcn_s_setprio(1); _Pragma("unroll") for (int m = 0; m < 4; ++m) _Pragma("unroll") for (int n = 0; n < 2; ++n) _Pragma("unroll") for (int k = 0; k < 2; ++k) \
        acc[ai][bj][m][n] = __builtin_amdgcn_mfma_f32_16x16x32_bf16(Bt[n][k], At[m][k], acc[ai][bj][m][n], 0, 0, 0); __builtin_amdgcn_s_setprio(0); } while (0)
#define MM_WAIT_V(n) asm volatile("s_waitcnt vmcnt(" #n ")" ::: "memory")
#define MM_WAIT_L(n) asm volatile("s_waitcnt lgkmcnt(" #n ")" ::: "memory")
#define MM_BAR __builtin_amdgcn_s_barrier()
#define MM_SCHED __builtin_amdgcn_sched_barrier(0)
#define MM_ZERO() do { _Pragma("unroll") for (int a_ = 0; a_ < 2; ++a_) _Pragma("unroll") for (int b_ = 0; b_ < 2; ++b_) _Pragma("unroll") for (int m_ = 0; m_ < 4; ++m_) _Pragma("unroll") for (int n_ = 0; n_ < 2; ++n_) \
        acc[a_][b_][m_][n_] = (f32x4){0.f, 0.f, 0.f, 0.f}; } while (0)
    MUnit cur, nxt; int ui = 0;
    if (!S.next(0, cur)) return;
    f32x4 acc[2][2][4][2];
    MM_ZERO();
    bf16x8 At[4][2], B0[2][2], B1[2][2];
    unsigned vAc[2][2]; int nslot = 0;
    if constexpr (GATHER) { S.gather(0, Rr, Cc, vAc, lds); }
    else {
#pragma unroll
        for (int h = 0; h < 2; ++h)
#pragma unroll
            for (int i = 0; i < 2; ++i) vAc[h][i] = 0u;
    }
    const char* cA = cur.A; const char* cB = cur.B;
    const char* nA = cA;
    MM_STAGE_B(MM_SB(0, 0), cB); MM_STAGE_B(MM_SB(0, 1), cB + hstepB); MM_STAGE_A(MM_SA(0, 0), false, 0, 0); MM_STAGE_A(MM_SA(0, 1), false, 1, 0);
    if (wr == 1) MM_BAR;
    MM_WAIT_V(2); MM_BAR;
    MM_STAGE_B(MM_SB(1, 0), cB + kstep); MM_STAGE_A(MM_SA(1, 0), false, 0, kstep); MM_STAGE_B(MM_SB(1, 1), cB + hstepB + kstep);
    MM_WAIT_V(6); MM_BAR;
    for (;;) {
        const bool has_next = S.next(ui + 1, nxt);
        nA = has_next ? nxt.A : cA; const char* nB = has_next ? nxt.B : cB;
        nslot = has_next ? ui + 1 : ui;
        for (int t = 0; t < nt; t += 2) {
            const bool last = (t == nt - 2);
            const size_t k1 = (size_t)(t + 1) * kstep;
            const size_t k2 = last ? 0 : (size_t)(t + 2) * kstep;
            const size_t k3 = k2 + kstep;
            const char* b2 = (last ? nB : cB) + k2; const char* b3 = b2 + kstep;
            MM_LDB(B0, 0, 0); MM_LDB(B1, 0, 1); MM_SCHED; MM_LDA(At, 0, 0); MM_STAGE_A(MM_SA(1, 1), false, 1, k1);
            MM_WAIT_V(8); MM_WAIT_L(0); MM_BAR; MM_MMA(0, 0, At, B0); MM_MMA(0, 1, At, B1); MM_BAR; MM_SCHED;
            MM_LDA(At, 0, 1); MM_STAGE_B(MM_SB(0, 0), b2); MM_STAGE_B(MM_SB(0, 1), b2 + hstepB); MM_STAGE_A(MM_SA(0, 0), last, 0, k2);
            MM_WAIT_V(8); MM_WAIT_L(0); MM_BAR; MM_MMA(1, 0, At, B0); MM_MMA(1, 1, At, B1); MM_BAR; MM_SCHED;
            MM_LDB(B0, 1, 0); MM_LDB(B1, 1, 1); MM_SCHED; MM_LDA(At, 1, 0); MM_STAGE_A(MM_SA(0, 1), last, 1, k2);
            MM_WAIT_V(8); MM_WAIT_L(0); MM_BAR; MM_MMA(0, 0, At, B0); MM_MMA(0, 1, At, B1); MM_BAR; MM_SCHED;
            MM_LDA(At, 1, 1); MM_STAGE_B(MM_SB(1, 0), b3); MM_STAGE_B(MM_SB(1, 1), b3 + hstepB); MM_STAGE_A(MM_SA(1, 0), last, 0, k3);
            MM_WAIT_V(8); MM_WAIT_L(0); MM_BAR; MM_MMA(1, 0, At, B0); MM_MMA(1, 1, At, B1); MM_BAR; MM_SCHED;
        }
        const bool epi = cur.last != 0;
        int fr_ = fr, fq_ = fq, wr_ = wr, wc_ = wc; asm volatile("" : "+v"(fr_), "+v"(fq_), "+s"(wr_), "+s"(wc_));
        if constexpr (Epi::HAS_MID) E.mid(acc, ui, epi, wr_, fr_, lds);
        if (epi) { if (wr == 0) MM_BAR; E(acc, cur, ui, wr_, wc_, fr_, fq_, lds);
#if EPI_TWICE
            E(acc, cur, ui, wr_, wc_, fr_, fq_, lds);
#endif
        }
        if (!has_next) break;
        if (nxt.first) MM_ZERO();
        cur = nxt; cA = nA; cB = nB; ++ui;
        if constexpr (GATHER) { S.gather(ui, Rr, Cc, vAc, lds); }
        if (epi) { if (wr == 1) MM_BAR; }
    }
    MM_WAIT_V(0);
    MM_BAR;
#undef MM_SA
#undef MM_SB
#undef MM_STAGE_A
#undef MM_STAGE_B
#undef MM_LDA
#undef MM_LDB
#undef MM_MMA
#undef MM_WAIT_V
#undef MM_WAIT_L
#undef MM_BAR
#undef MM_SCHED
#undef MM_ZERO
}

struct SchedDense {
    const char* A; const char* B; int nM, nN, nU, G, c, nt; unsigned lda, ldb;
    __device__ __forceinline__ bool next(int i, MUnit& u) const {
        const int L = i * G + c; if (L >= nU) return false;
        const int wgid = xcd_remap(L, nU);
        const int nig = 8 * nN, gid = wgid / nig, fm = gid * 8, gsz = (nM - fm) < 8 ? (nM - fm) : 8;
        const int pm = fm + ((wgid % nig) % gsz), pn = (wgid % nig) / gsz;
        u.A = A + (size_t)pm * 256 * lda; u.B = B + (size_t)pn * 256 * ldb; u.first = 1; u.last = 1; u.i0 = pm; u.i1 = pn; u.i2 = 0; u.i3 = 0; u.i4 = 0; u.i5 = 0;
        return true;
    }
    __device__ __forceinline__ void gather(int, const int (&)[2], int, unsigned (&)[2][2], LAS unsigned char*) const {}
    __device__ __forceinline__ unsigned gather1(int, int, int, LAS unsigned char*) const { return 0u; }
};
struct SchedP1 {
    const char* A; const char* B; int nM, nN, nU, G, c, nt; unsigned lda, ldb;
    __device__ __forceinline__ bool next(int i, MUnit& u) const {
        const int L = i * G + c; if (L >= nU) return false;
        const int wgid = xcd_remap(L, nU);
        const int nig = 8 * nN, gid = wgid / nig, fm = gid * 8, gsz = (nM - fm) < 8 ? (nM - fm) : 8;
        const int pm = fm + ((wgid % nig) % gsz), pn = (wgid % nig) / gsz;
        u.A = A; u.B = B + (size_t)pn * 256 * ldb; u.first = 1; u.last = 1; u.i0 = pm; u.i1 = pn; u.i2 = 0; u.i3 = 0; u.i4 = 0; u.i5 = 0;
        return true;
    }
    __device__ __forceinline__ void gather(int slot, const int (&Rr)[2], int Cc, unsigned (&v)[2][2], LAS unsigned char* lds) const {
        const LAS int* tk = (const LAS int*)(lds + TAB_OFF + slot * 3072);
#pragma unroll
        for (int h = 0; h < 2; ++h)
#pragma unroll
            for (int i = 0; i < 2; ++i) v[h][i] = (unsigned)tk[h * 128 + Rr[i]] * 2048u + (unsigned)Cc * 2u;
    }
    __device__ __forceinline__ unsigned gather1(int slot, int row, int Cc, LAS unsigned char* lds) const {
        return (unsigned)((const LAS int*)(lds + TAB_OFF + slot * 3072))[row] * 2048u + (unsigned)Cc * 2u;
    }
};
struct SchedP3 {
    const char* A; const char* B; int nM, nN, nU, G, c, nt; unsigned lda, ldb;
    __device__ __forceinline__ bool next(int i, MUnit& u) const {
        const int L = (i >> 1) * G + c, sub = i & 1; if (L >= nU) return false;
        const int wgid = xcd_remap(L, nU);
        const int nig = 8 * nN, gid = wgid / nig, fm = gid * 8, gsz = (nM - fm) < 8 ? (nM - fm) : 8;
        const int pm = fm + ((wgid % nig) % gsz), pn = (wgid % nig) / gsz;
        u.A = A + (size_t)pm * 256 * lda + sub * 1024; u.B = B + (size_t)pn * 256 * ldb + sub * 1024; u.first = (sub == 0); u.last = (sub == 1); u.i0 = pm; u.i1 = pn; u.i2 = 0; u.i3 = 0; u.i4 = 0; u.i5 = 0;
        return true;
    }
    __device__ __forceinline__ void gather(int, const int (&)[2], int, unsigned (&)[2][2], LAS unsigned char*) const {}
    __device__ __forceinline__ unsigned gather1(int, int, int, LAS unsigned char*) const { return 0u; }
};
struct SchedP4 {
    const int* tokl; const unsigned* cnt; const char* A2; const char* Wgu; LAS const int* pre; int nU, G, c, nt; unsigned lda, ldb;
    __device__ __forceinline__ bool next(int i, MUnit& u) const {
        const int L = i * G + c; if (L >= nU) return false;
        const int id = xcd_remap(L, nU), tile_id = id >> 3, pn = id & 7;
        int bkt = 0;
        for (int b = 1; b < NBKT; ++b) if (pre[b] <= tile_id) bkt = b;
        const int rt = tile_id - pre[bkt]; int e0, e1; bucket_experts(bkt, e0, e1);
        const int slot = pn >> 2, tile = pn & 3, e = slot ? e1 : e0;
        u.A = A2; u.B = Wgu + ((size_t)e * 1024 + tile * 256) * 2048; u.first = 1; u.last = 1;
        u.i0 = bkt; u.i1 = rt; u.i2 = pn; u.i3 = pre[32 + bkt]; u.i4 = pre[bkt] * 256; u.i5 = e;
        return true;
    }
    __device__ __forceinline__ void gather(int slot, const int (&Rr)[2], int Cc, unsigned (&v)[2][2], LAS unsigned char* lds) const {
        const LAS int* tk = (const LAS int*)(lds + TAB_OFF + slot * 3072);
#pragma unroll
        for (int h = 0; h < 2; ++h)
#pragma unroll
            for (int i = 0; i < 2; ++i) v[h][i] = (unsigned)tk[h * 128 + Rr[i]] * 2048u + (unsigned)Cc * 2u;
    }
    __device__ __forceinline__ unsigned gather1(int slot, int row, int Cc, LAS unsigned char* lds) const {
        return (unsigned)((const LAS int*)(lds + TAB_OFF + slot * 3072))[row] * 2048u + (unsigned)Cc * 2u;
    }
};
struct SchedP5 {
    const unsigned* cnt; const char* act; const char* Wd; LAS const int* pre; int nU, G, c, nt; unsigned lda, ldb;
    __device__ __forceinline__ bool next(int i, MUnit& u) const {
        const int L = (i >> 1) * G + c, sub = i & 1; if (L >= nU) return false;
        const int id = xcd_remap(L, nU), tile_id = id >> 2, pn = id & 3;
        int bkt = 0;
        for (int b = 1; b < NBKT; ++b) if (pre[b] <= tile_id) bkt = b;
        const int rt = tile_id - pre[bkt]; int e0, e1; bucket_experts(bkt, e0, e1);
        const int e = sub ? e1 : e0, off = pre[bkt] * 256;
        u.A = act + (size_t)(off + rt * 256) * 2048 + sub * 1024; u.B = Wd + ((size_t)e * 1024 + pn * 256) * 1024; u.first = (sub == 0); u.last = (sub == 1);
        u.i0 = bkt; u.i1 = rt; u.i2 = pn; u.i3 = pre[32 + bkt]; u.i4 = pre[64 + bkt]; u.i5 = (i >> 1) * 3072;
        return true;
    }
    __device__ __forceinline__ void gather(int, const int (&)[2], int, unsigned (&)[2][2], LAS unsigned char*) const {}
    __device__ __forceinline__ unsigned gather1(int, int, int, LAS unsigned char*) const { return 0u; }
};

struct EpiP1 {
    static constexpr bool PERM = true, HAS_MID = false;
    bf16* proj; const float* ssq; const float* bias1;
    __device__ __forceinline__ void operator()(const f32x4 (&acc)[2][2][4][2], const MUnit& u, int slot, int wr, int wc, int fr, int fq, LAS unsigned char* lds) const {
        const int pm = u.i0, pn = u.i1, b = pm >> 3;
        const int row0 = pm * 256 + wr * 64 + fr, col0 = pn * 256 + wc * 32 + 8 * fq;
        const LAS float* rtab = (const LAS float*)(lds + TAB_OFF + slot * 3072 + 1024);
        f32x4 bv[2][2];
#pragma unroll
        for (int bj = 0; bj < 2; ++bj)
#pragma unroll
            for (int n = 0; n < 2; ++n) bv[bj][n] = *(const f32x4*)(bias1 + b * INC + col0 + bj * 128 + 4 * n);
        const bool act = pn < 4;
#pragma unroll
        for (int ai = 0; ai < 2; ++ai)
#pragma unroll
            for (int m = 0; m < 4; ++m) {
                const int row = row0 + ai * 128 + m * 16; const float rs = rtab[wr * 64 + fr + ai * 128 + m * 16];
                const int tq = row & 2047;
#pragma unroll
                for (int bj = 0; bj < 2; ++bj) {
                    f32x4 v0 = acc[ai][bj][m][0] * rs + bv[bj][0], v1 = acc[ai][bj][m][1] * rs + bv[bj][1];
                    if (act) { const f32x2 p = gelu_pk((f32x2){v0[0], v0[1]}), q = gelu_pk((f32x2){v0[2], v0[3]}), r = gelu_pk((f32x2){v1[0], v1[1]}), s = gelu_pk((f32x2){v1[2], v1[3]});
                        v0 = (f32x4){p.x, p.y, q.x, q.y}; v1 = (f32x4){r.x, r.y, s.x, s.y}; }
                    u32x4 w; w.x = cvt_pk_bf16(v0[0], v0[1]); w.y = cvt_pk_bf16(v0[2], v0[3]); w.z = cvt_pk_bf16(v1[0], v1[1]); w.w = cvt_pk_bf16(v1[2], v1[3]);
                    if (act) *(u32x4*)(proj + (size_t)row * 1024 + col0 + bj * 128) = w;
                    else { const int c512 = ((pn - 4) & 1) * 256 + bj * 128 + wc * 32 + 8 * fq, which = (pn - 4) >> 1;
                        *(u32x4*)(proj + (size_t)(32 + 16 * which) * (MiB / 2) + ((size_t)((b * 8 + (c512 >> 6)) * 2048 + tq)) * 64 + (c512 & 63)) = w; }
                }
            }
    }
};
template <bool L0, bool WT>
struct EpiP3 {
    static constexpr bool PERM = true, HAS_MID = true;
    const float* xin;        const bf16* x2b;
    bf16* x1; bf16* A2; float* ssq; const float* g1;     const float* G2;
    __device__ __forceinline__ void mid(f32x4 (&acc)[2][2][4][2], int ui, bool epi, int wr, int fr, LAS unsigned char* lds) const {
        const LAS float* rho = (const LAS float*)(lds + TAB_OFF + (ui >> 1) * 3072 + 1024);
#pragma unroll
        for (int ai = 0; ai < 2; ++ai)
#pragma unroll
            for (int m = 0; m < 4; ++m) { const float r0 = rho[ai * 128 + wr * 64 + m * 16 + fr]; const float r = epi ? 1.0f : r0;
#pragma unroll
                for (int bj = 0; bj < 2; ++bj)
#pragma unroll
                    for (int n = 0; n < 2; ++n) acc[ai][bj][m][n] = acc[ai][bj][m][n] * r; }
    }
    __device__ __forceinline__ void operator()(const f32x4 (&acc)[2][2][4][2], const MUnit& u, int ui, int wr, int wc, int fr, int fq, LAS unsigned char* lds) const {
        const int pm = u.i0, pn = u.i1, b = pm >> 3;
        const int row0 = pm * 256 + wr * 64 + fr, col0 = pn * 256 + wc * 32 + 8 * fq;
        const LAS float* rbt = (const LAS float*)(lds + TAB_OFF + (ui >> 1) * 3072 + 2048); const LAS int* rxt = (const LAS int*)(lds + TAB_OFF + (ui >> 1) * 3072);
        f32x4 gv[2][2], Gv[2][2];
#pragma unroll
        for (int bj = 0; bj < 2; ++bj)
#pragma unroll
            for (int n = 0; n < 2; ++n) { gv[bj][n] = *(const f32x4*)(g1 + b * 6144 + col0 + bj * 128 + 4 * n); Gv[bj][n] = *(const f32x4*)(G2 + b * 1024 + col0 + bj * 128 + 4 * n); }
        constexpr int AH = L0 ? 2 : 4;
        f32x4 PF[L0 ? AH : 1][2][2]; u32x4 RW[L0 ? 1 : AH][2];
#define P3_LOAD(ai_, m_) do { const int rl_ = (ai_) * 128 + wr * 64 + (m_) * 16 + fr; _Pragma("unroll") for (int bj = 0; bj < 2; ++bj) { \
            if (L0) { const float* xp = xin + (size_t)(pm * 256 + rl_) * 1024 + col0 + bj * 128; PF[L0 ? ((m_) % AH) : 0][bj][0] = __builtin_nontemporal_load((const f32x4*)xp); PF[L0 ? ((m_) % AH) : 0][bj][1] = __builtin_nontemporal_load((const f32x4*)(xp + 4)); } \
            else RW[L0 ? 0 : ((m_) % AH)][bj] = *(const u32x4*)(x2b + (size_t)rxt[rl_] * 1024 + col0 + bj * 128); } } while (0)
#pragma unroll
        for (int m = 0; m < AH; ++m) P3_LOAD(0, m);
#pragma unroll
        for (int ai = 0; ai < 2; ++ai)
#pragma unroll
            for (int m = 0; m < 4; ++m) {
                const int rl = ai * 128 + wr * 64 + m * 16 + fr, row = pm * 256 + rl; float ss = 0.f; const float rb = rbt[rl];
                f32x4 pp[2][2];
#pragma unroll
                for (int bj = 0; bj < 2; ++bj) {
                    if (L0) { pp[bj][0] = PF[L0 ? (m % AH) : 0][bj][0]; pp[bj][1] = PF[L0 ? (m % AH) : 0][bj][1]; }
                    else { const u32x4 raw = RW[L0 ? 0 : (m % AH)][bj];
                        pp[bj][0] = (f32x4){__uint_as_float(raw.x << 16), __uint_as_float(raw.x & 0xffff0000u), __uint_as_float(raw.y << 16), __uint_as_float(raw.y & 0xffff0000u)};
                        pp[bj][1] = (f32x4){__uint_as_float(raw.z << 16), __uint_as_float(raw.z & 0xffff0000u), __uint_as_float(raw.w << 16), __uint_as_float(raw.w & 0xffff0000u)}; }
                }
                { constexpr int dummy_ = 0; (void)dummy_; const int it_ = ai * 4 + m + AH; if (it_ < 8) P3_LOAD(it_ >> 2, it_ & 3); }
#pragma unroll
                for (int bj = 0; bj < 2; ++bj) {
                    const f32x4 p0 = pp[bj][0], p1 = pp[bj][1];
                    const f32x4 v0 = p0 + gv[bj][0] * (acc[ai][bj][m][0] * rb), v1 = p1 + gv[bj][1] * (acc[ai][bj][m][1] * rb);
                    ss += ((v0[0] * v0[0] + v0[1] * v0[1]) + (v0[2] * v0[2] + v0[3] * v0[3])) + ((v1[0] * v1[0] + v1[1] * v1[1]) + (v1[2] * v1[2] + v1[3] * v1[3]));
                    const size_t o = (size_t)row * 1024 + col0 + bj * 128;
                    u32x4 w; w.x = cvt_pk_bf16(v0[0], v0[1]); w.y = cvt_pk_bf16(v0[2], v0[3]); w.z = cvt_pk_bf16(v1[0], v1[1]); w.w = cvt_pk_bf16(v1[2], v1[3]);
                    *(u32x4*)(x1 + o) = w;
                    const f32x4 a0 = v0 * Gv[bj][0], a1 = v1 * Gv[bj][1];
                    u32x4 z; z.x = cvt_pk_bf16(a0[0], a0[1]); z.y = cvt_pk_bf16(a0[2], a0[3]); z.z = cvt_pk_bf16(a1[0], a1[1]); z.w = cvt_pk_bf16(a1[2], a1[3]);
                    if constexpr (WT) { const __amdgpu_buffer_rsrc_t rs2 = __builtin_amdgcn_make_buffer_rsrc((void*)A2, (short)0, 0x2000000, 0x00020000);
                      __builtin_amdgcn_raw_buffer_store_b128(z, rs2, (int)((unsigned)o * 2u), 0, 16); }
                    else *(u32x4*)(A2 + o) = z;
                }
                ss = rows_sum(ss);
                if (fq == 0) { if constexpr (WT) __hip_atomic_store(ssq + (size_t)row * 16 + pn * 4 + wc, ss, __ATOMIC_RELAXED, __HIP_MEMORY_SCOPE_AGENT); else ssq[(size_t)row * 16 + pn * 4 + wc] = ss; }
            }
#undef P3_LOAD
    }
};
struct EpiP4 {
    static constexpr bool PERM = true, HAS_MID = false;
    bf16* act; const int* tokl; const float* ssq; const float* biasgu;     const float* gates; int wt;
    __device__ __forceinline__ void side(const MUnit& u, int wid, int lane, LAS unsigned char* lds) const {
        const float* src = biasgu + ((size_t)wid * 16 + u.i5) * 1024 + (u.i2 & 3) * 256 + ((lane ^ wid) << 2);
        __builtin_amdgcn_global_load_lds((const unsigned*)src, (LAS unsigned*)(lds + SIDE_OFF + wid * 1024), 16, 0, 0);
    }
    __device__ __forceinline__ void operator()(const f32x4 (&acc)[2][2][4][2], const MUnit& u, int uslot, int wr, int wc, int fr, int fq, LAS unsigned char* lds) const {
        const int rt = u.i1, pn = u.i2, off = u.i4, e = u.i5, slot = pn >> 2, tile = pn & 3;
        const LAS int* ttab = (const LAS int*)(lds + TAB_OFF + uslot * 3072); const LAS float* rtab = (const LAS float*)(lds + TAB_OFF + uslot * 3072 + 1024); const LAS float* gtab = (const LAS float*)(lds + TAB_OFF + uslot * 3072 + 2048);
        const LAS unsigned char* sb = lds + SIDE_OFF; const int ch = wc * 8 + 2 * fq;
#pragma unroll
        for (int ai = 0; ai < 2; ++ai)
#pragma unroll
            for (int m = 0; m < 4; ++m) {
                const int rl = ai * 128 + wr * 64 + m * 16 + fr, r = rt * 256 + rl;
                const int t = ttab[rl]; const int b = t >> 11;
                const float rs = rtab[rl]; const float g = gtab[rl];
                unsigned wv[4];
#pragma unroll
                for (int nn = 0; nn < 2; ++nn) {
                    const f32x4 bg = *(const LAS f32x4*)(sb + b * 1024 + (((ch + nn) ^ b) << 4)), bu = *(const LAS f32x4*)(sb + b * 1024 + (((32 + ch + nn) ^ b) << 4));
                    const f32x4 hg = acc[ai][0][m][nn] * rs + bg, hu = acc[ai][1][m][nn] * rs + bu;
                    float o[4];
#pragma unroll
                    for (int j = 0; j < 4; ++j) o[j] = hg[j] * __builtin_amdgcn_rcpf(1.0f + __expf(-hg[j])) * hu[j] * g;
                    wv[2 * nn] = cvt_pk_bf16(o[0], o[1]); wv[2 * nn + 1] = cvt_pk_bf16(o[2], o[3]);
                }
                u32x4 w; w.x = wv[0]; w.y = wv[1]; w.z = wv[2]; w.w = wv[3];
                if (wt) { const __amdgpu_buffer_rsrc_t rs = __builtin_amdgcn_make_buffer_rsrc((void*)act, (short)0, 0x3000000, 0x00020000);
                    __builtin_amdgcn_raw_buffer_store_b128(w, rs, (int)(((unsigned)(off + r) * 1024u + (unsigned)(slot * 512 + tile * 128 + wc * 32 + 8 * fq)) * 2u), 0, 16); }
                else *(u32x4*)(act + (size_t)(off + r) * 1024 + slot * 512 + tile * 128 + wc * 32 + 8 * fq) = w;
                ;
            }
    }
};
struct EpiP5 {
    static constexpr bool PERM = true, HAS_MID = false;
    const bf16* x1; bf16* x2b; bf16* A1; float* ssq; const float* g2;     const float* G1n; int haveNext;
    __device__ __forceinline__ void side(const MUnit& u, int wid, int lane, LAS unsigned char* lds) const {
        const int co = u.i2 * 256 + ((lane ^ wid) << 2);
        __builtin_amdgcn_global_load_lds((const unsigned*)(g2 + wid * 6144 + co), (LAS unsigned*)(lds + SIDE_OFF + wid * 1024), 16, 0, 0);
        if (haveNext) __builtin_amdgcn_global_load_lds((const unsigned*)(G1n + wid * 1024 + co), (LAS unsigned*)(lds + SIDE_OFF + 8192 + wid * 1024), 16, 0, 0);
    }
    __device__ __forceinline__ void operator()(const f32x4 (&acc)[2][2][4][2], const MUnit& u, int ui, int wr, int wc, int fr, int fq, LAS unsigned char* lds) const {
        const int rt = u.i1, pn = u.i2, n = u.i3, xoff = u.i4;
        const int col0 = pn * 256 + wc * 32 + 8 * fq;
        const LAS int* ttab = (const LAS int*)(lds + TAB_OFF + u.i5);
        const LAS unsigned char* sb = lds + SIDE_OFF; const int ch = wc * 8 + 2 * fq;
        u32x4 raw[4][2];
#pragma unroll
        for (int m = 0; m < 4; ++m) { const int t = ttab[wr * 64 + m * 16 + fr];
#pragma unroll
            for (int bj = 0; bj < 2; ++bj) raw[m][bj] = *(const u32x4*)(x1 + (size_t)t * 1024 + col0 + bj * 128); }
#pragma unroll
        for (int ai = 0; ai < 2; ++ai)
#pragma unroll
            for (int m = 0; m < 4; ++m) {
                const int rl = ai * 128 + wr * 64 + m * 16 + fr, r = rt * 256 + rl; const bool valid = r < n;
                const int t = ttab[rl]; const int b = t >> 11; float ss = 0.f;
                const size_t orow = (size_t)(xoff + r);
                u32x4 w[2], z[2];
                const u32x4 rw0 = raw[m][0], rw1 = raw[m][1];
                if (ai == 0) { const int tn = ttab[128 + wr * 64 + m * 16 + fr];
#pragma unroll
                    for (int bj = 0; bj < 2; ++bj) raw[m][bj] = *(const u32x4*)(x1 + (size_t)tn * 1024 + col0 + bj * 128); }
#pragma unroll
                for (int bj = 0; bj < 2; ++bj) {
                    const int c0 = ch + 32 * bj;
                    const f32x4 ga = *(const LAS f32x4*)(sb + b * 1024 + ((c0 ^ b) << 4)), gb = *(const LAS f32x4*)(sb + b * 1024 + (((c0 + 1) ^ b) << 4));
                    const u32x4 rw = bj ? rw1 : rw0;
                    const f32x4 p0 = (f32x4){__uint_as_float(rw.x << 16), __uint_as_float(rw.x & 0xffff0000u), __uint_as_float(rw.y << 16), __uint_as_float(rw.y & 0xffff0000u)};
                    const f32x4 p1 = (f32x4){__uint_as_float(rw.z << 16), __uint_as_float(rw.z & 0xffff0000u), __uint_as_float(rw.w << 16), __uint_as_float(rw.w & 0xffff0000u)};
                    const f32x4 v0 = p0 + ga * acc[ai][bj][m][0], v1 = p1 + gb * acc[ai][bj][m][1];
                    ss += ((v0[0] * v0[0] + v0[1] * v0[1]) + (v0[2] * v0[2] + v0[3] * v0[3])) + ((v1[0] * v1[0] + v1[1] * v1[1]) + (v1[2] * v1[2] + v1[3] * v1[3]));
                    w[bj].x = cvt_pk_bf16(v0[0], v0[1]); w[bj].y = cvt_pk_bf16(v0[2], v0[3]); w[bj].z = cvt_pk_bf16(v1[0], v1[1]); w[bj].w = cvt_pk_bf16(v1[2], v1[3]);
                    if (haveNext) { const f32x4 Ga = *(const LAS f32x4*)(sb + 8192 + b * 1024 + ((c0 ^ b) << 4)), Gb = *(const LAS f32x4*)(sb + 8192 + b * 1024 + (((c0 + 1) ^ b) << 4));
                        const f32x4 a0 = v0 * Ga, a1 = v1 * Gb;
                        z[bj].x = cvt_pk_bf16(a0[0], a0[1]); z[bj].y = cvt_pk_bf16(a0[2], a0[3]); z[bj].z = cvt_pk_bf16(a1[0], a1[1]); z[bj].w = cvt_pk_bf16(a1[2], a1[3]); }
                }
                ss = rows_sum(ss);
                if (valid) {
#pragma unroll
                    for (int bj = 0; bj < 2; ++bj) {
                        *(u32x4*)(x2b + orow * 1024 + col0 + bj * 128) = w[bj];
                        if (haveNext) *(u32x4*)(A1 + (size_t)t * 1024 + col0 + bj * 128) = z[bj];
                    }
                    if (fq == 0) ssq[(size_t)t * 16 + pn * 4 + wc] = ss;
                }
            }
    }
};

struct MUnit45 : MUnit { int kind, nt, slot, tile; unsigned ldb; };
struct Sched45 {
    const char* A2; const char* Wgu; const char* act; const char* Wd; LAS const int* pre; int t0, ntl, rank, n4;
    __device__ __forceinline__ bool next(int i, MUnit45& u) const {
        if (i < n4) {
            const int en = rank + 32 * i, tile_id = t0 + (en >> 3), pn = en & 7;
            int bkt = 0;
            for (int b = 1; b < NBKT; ++b) if (pre[b] <= tile_id) bkt = b;
            bkt = __builtin_amdgcn_readfirstlane(bkt);
            const int pb_ = __builtin_amdgcn_readfirstlane(pre[bkt]);
            const int rt = tile_id - pb_; int e0, e1; bucket_experts(bkt, e0, e1);
            const int slot = pn >> 2, tile = pn & 3, e = slot ? e1 : e0;
            u.A = A2; u.B = Wgu + ((size_t)e * 1024 + tile * 256) * 2048; u.first = 1; u.last = 1;
            u.i0 = bkt; u.i1 = rt; u.i2 = pn; u.i3 = __builtin_amdgcn_readfirstlane(pre[32 + bkt]); u.i4 = pb_ * 256; u.i5 = e;
            u.kind = 0; u.nt = 16; u.slot = i; u.tile = tile_id; u.ldb = 2048u;
            return true;
        }
        const int j = i - n4, k5 = j >> 1, sub = j & 1, en = rank + 32 * (n4 + k5) - 8 * ntl; if (en >= 4 * ntl) return false;
        const int tile_id = t0 + (en >> 2), pn = en & 3;
        int bkt = 0;
        for (int b = 1; b < NBKT; ++b) if (pre[b] <= tile_id) bkt = b;
        bkt = __builtin_amdgcn_readfirstlane(bkt);
        const int pb_ = __builtin_amdgcn_readfirstlane(pre[bkt]);
        const int rt = tile_id - pb_; int e0, e1; bucket_experts(bkt, e0, e1);
        const int e = sub ? e1 : e0, off = pb_ * 256;
        u.A = act + (size_t)(off + rt * 256) * 2048 + sub * 1024; u.B = Wd + ((size_t)e * 1024 + pn * 256) * 1024; u.first = (sub == 0); u.last = (sub == 1);
        u.i0 = bkt; u.i1 = rt; u.i2 = pn; u.i3 = __builtin_amdgcn_readfirstlane(pre[32 + bkt]); u.i4 = __builtin_amdgcn_readfirstlane(pre[64 + bkt]); u.i5 = 9216 + k5 * 1024;
        u.kind = 1; u.nt = 8; u.slot = k5; u.tile = tile_id; u.ldb = 1024u;
        return true;
    }
    __device__ __forceinline__ unsigned aoff(const MUnit45& u, int row, int Cc, LAS unsigned char* lds) const {
        if (u.kind == 0) return (unsigned)((const LAS int*)(lds + TAB_OFF + u.slot * 3072))[row] * 2048u + (unsigned)Cc * 2u;
        return (unsigned)row * 2048u + (unsigned)Cc * 2u;
    }
};
template <class Epi4, class Epi5>
__device__ __forceinline__ void mm_phase45(LAS unsigned char* lds, const Sched45& S, const Epi4& E4, const Epi5& E5, const int tid, unsigned* ready, unsigned* tmo) {
    const int wid = __builtin_amdgcn_readfirstlane(tid >> 6), lane = tid & 63, wr = wid >> 2, wc = wid & 3, fr = lane & 15, fq = lane >> 4;
    int Rr[2], RbV[2], Cc;
#pragma unroll
    for (int i = 0; i < 2; ++i) { int R, C; stage_rc(tid * 16 + i * 8192, R, C); Rr[i] = R; RbV[i] = (R & ~31) + perm32(R & 31); Cc = C; }
    const size_t kstep = (size_t)(BK * 2);
    const unsigned ldsw = (unsigned)wid * 1024u;
    const int aoff = lds_byte(wr * 64 + fr, fq * 8), boff = lds_byte(wc * 32 + fr, fq * 8);
#define MM_SA(b, h) (((b) * 2 + (h)) * HTB)
#define MM_SB(b, h) ((4 + (b) * 2 + (h)) * HTB)
#define MM_STAGE_B(bufoff, nx, hb, koff) do { \
        const unsigned ldb_ = (nx) ? pf.ldb : cur.ldb; const char* gb_ = ((nx) ? pf.B : cur.B) + (size_t)(hb) * 128u * ldb_ + (koff); \
        _Pragma("unroll") for (int _i = 0; _i < 2; ++_i) { \
            const unsigned vo_ = (unsigned)RbV[_i] * ldb_ + (unsigned)Cc * 2u; \
            __builtin_amdgcn_global_load_lds((const unsigned*)(gb_ + vo_), (LAS unsigned*)(lds + (bufoff) + ldsw + _i * 8192), 16, 0, 0); } } while (0)
#define MM_STAGE_A(bufoff, nx, h, koff) do { \
        const char* gb_ = ((nx) ? pf.A : cur.A) + (koff); \
        _Pragma("unroll") for (int _i = 0; _i < 2; ++_i) { \
            unsigned vo_ = vAc[h][_i]; \
            if (nx) vo_ = S.aoff(pf, (h) * 128 + Rr[_i], Cc, lds); \
            __builtin_amdgcn_global_load_lds((const unsigned*)(gb_ + vo_), (LAS unsigned*)(lds + (bufoff) + ldsw + _i * 8192), 16, 0, 0); } } while (0)
#define MM_LDA(dst, b, h) do { _Pragma("unroll") for (int m = 0; m < 4; ++m) _Pragma("unroll") for (int k = 0; k < 2; ++k) dst[m][k] = *(const LAS bf16x8*)(lds + MM_SA(b, h) + aoff + m * 2048 + k * 1024); } while (0)
#define MM_LDB(dst, b, h) do { _Pragma("unroll") for (int n = 0; n < 2; ++n) _Pragma("unroll") for (int k = 0; k < 2; ++k) dst[n][k] = *(const LAS bf16x8*)(lds + MM_SB(b, h) + boff + n * 2048 + k * 1024); } while (0)
#define MM_MMA(ai, bj, At, Bt) do { __builtin_amdgcn_s_setprio(1); _Pragma("unroll") for (int m = 0; m < 4; ++m) _Pragma("unroll") for (int n = 0; n < 2; ++n) _Pragma("unroll") for (int k = 0; k < 2; ++k) \
        acc[ai][bj][m][n] = __builtin_amdgcn_mfma_f32_16x16x32_bf16(Bt[n][k], At[m][k], acc[ai][bj][m][n], 0, 0, 0); __builtin_amdgcn_s_setprio(0); } while (0)
#define MM_WAIT_V(n) asm volatile("s_waitcnt vmcnt(" #n ")" ::: "memory")
#define MM_WAIT_L(n) asm volatile("s_waitcnt lgkmcnt(" #n ")" ::: "memory")
#define MM_BAR __builtin_amdgcn_s_barrier()
#define MM_SCHED __builtin_amdgcn_sched_barrier(0)
#define MM_ZERO() do { _Pragma("unroll") for (int a_ = 0; a_ < 2; ++a_) _Pragma("unroll") for (int b_ = 0; b_ < 2; ++b_) _Pragma("unroll") for (int m_ = 0; m_ < 4; ++m_) _Pragma("unroll") for (int n_ = 0; n_ < 2; ++n_) \
        acc[a_][b_][m_][n_] = (f32x4){0.f, 0.f, 0.f, 0.f}; } while (0)
    MUnit45 cur, nxt, pf; int ui = 0;
    if (!S.next(0, cur)) return;
    nxt = cur; pf = cur;
    f32x4 acc[2][2][4][2];
    MM_ZERO();
    bf16x8 At[4][2], B0[2][2], B1[2][2];
    unsigned vAc[2][2];
#pragma unroll
    for (int h = 0; h < 2; ++h)
#pragma unroll
        for (int i = 0; i < 2; ++i) vAc[h][i] = S.aoff(cur, h * 128 + Rr[i], Cc, lds);
    MM_STAGE_B(MM_SB(0, 0), false, 0, 0); MM_STAGE_B(MM_SB(0, 1), false, 1, 0); MM_STAGE_A(MM_SA(0, 0), false, 0, 0); MM_STAGE_A(MM_SA(0, 1), false, 1, 0);
    if (wr == 1) MM_BAR;
    MM_WAIT_V(2); MM_BAR;
    MM_STAGE_B(MM_SB(1, 0), false, 0, kstep); MM_STAGE_A(MM_SA(1, 0), false, 0, kstep); MM_STAGE_B(MM_SB(1, 1), false, 1, kstep);
    MM_WAIT_V(6); MM_BAR;
    for (;;) {
        const bool has_next = S.next(ui + 1, nxt);
        const bool need_wait = has_next && nxt.kind == 1 && nxt.first;
        const bool defer = need_wait && cur.kind == 0;
        pf = (has_next && !defer) ? nxt : cur;
        const int nt = cur.nt;
        for (int t = 0; t < nt; t += 2) {
            const bool last = (t == nt - 2);
            const size_t k1 = (size_t)(t + 1) * kstep;
            const size_t k2 = last ? 0 : (size_t)(t + 2) * kstep;
            const size_t k3 = k2 + kstep;
            if (t == 2 && cur.last) { int ln_ = lane, wd_ = wid; asm volatile("" : "+v"(ln_), "+s"(wd_)); if (cur.kind == 0) E4.side(cur, wd_, ln_, lds); else E5.side(cur, wd_, ln_, lds); }
            if (last && need_wait && !defer) {
                if (tid < 64) {
                    unsigned* w = ready + 16 * nxt.tile; unsigned sp = 0;
                    while ((unsigned)__builtin_amdgcn_readfirstlane(__hip_atomic_load(w, __ATOMIC_RELAXED, __HIP_MEMORY_SCOPE_AGENT)) < 64u) {
                        __builtin_amdgcn_s_sleep(2);
                        if ((++sp & 255u) == 0u) { if (__builtin_amdgcn_readfirstlane(__hip_atomic_load(tmo, __ATOMIC_RELAXED, __HIP_MEMORY_SCOPE_AGENT)) != 0u) break;
                            if (sp > (1u << 20)) { if (lane == 0) __hip_atomic_store(tmo, 0x45u, __ATOMIC_RELAXED, __HIP_MEMORY_SCOPE_AGENT); break; } }
                    }
                    __builtin_amdgcn_fence(__ATOMIC_ACQUIRE, "agent");
                    asm volatile("s_waitcnt vmcnt(0)" ::: "memory");
                }
                asm volatile("" ::: "memory"); MM_BAR; asm volatile("" ::: "memory");
            }
            MM_LDB(B0, 0, 0); MM_LDB(B1, 0, 1); MM_SCHED; MM_LDA(At, 0, 0); MM_STAGE_A(MM_SA(1, 1), false, 1, k1);
            MM_WAIT_V(8); MM_WAIT_L(0); MM_BAR; MM_MMA(0, 0, At, B0); MM_MMA(0, 1, At, B1); MM_BAR; MM_SCHED;
            MM_LDA(At, 0, 1); MM_STAGE_B(MM_SB(0, 0), last, 0, k2); MM_STAGE_B(MM_SB(0, 1), last, 1, k2); MM_STAGE_A(MM_SA(0, 0), last, 0, k2);
            MM_WAIT_V(8); MM_WAIT_L(0); MM_BAR; MM_MMA(1, 0, At, B0); MM_MMA(1, 1, At, B1); MM_BAR; MM_SCHED;
            MM_LDB(B0, 1, 0); MM_LDB(B1, 1, 1); MM_SCHED; MM_LDA(At, 1, 0); MM_STAGE_A(MM_SA(0, 1), last, 1, k2);
            MM_WAIT_V(8); MM_WAIT_L(0); MM_BAR; MM_MMA(0, 0, At, B0); MM_MMA(0, 1, At, B1); MM_BAR; MM_SCHED;
            MM_LDA(At, 1, 1); MM_STAGE_B(MM_SB(1, 0), last, 0, k3); MM_STAGE_B(MM_SB(1, 1), last, 1, k3); MM_STAGE_A(MM_SA(1, 0), last, 0, k3);
            MM_WAIT_V(8); MM_WAIT_L(0); MM_BAR; MM_MMA(1, 0, At, B0); MM_MMA(1, 1, At, B1); MM_BAR; MM_SCHED;
        }
        const bool epi = cur.last != 0;
        int fr_ = fr, fq_ = fq, wr_ = wr, wc_ = wc; asm volatile("" : "+v"(fr_), "+v"(fq_), "+s"(wr_), "+s"(wc_));
        if (epi) {
            if (wr == 0) MM_BAR;
            if (cur.kind == 0) {
                E4(acc, cur, cur.slot, wr_, wc_, fr_, fq_, lds);
                asm volatile("s_waitcnt vmcnt(0)" ::: "memory");
                if (lane == 0) __hip_atomic_fetch_add(ready + 16 * cur.tile, 1u, __ATOMIC_RELAXED, __HIP_MEMORY_SCOPE_AGENT);
            } else E5(acc, cur, ui, wr_, wc_, fr_, fq_, lds);
        }
        if (!has_next) break;
        if (nxt.first) MM_ZERO();
        cur = nxt; ++ui;
#pragma unroll
        for (int h = 0; h < 2; ++h)
#pragma unroll
            for (int i = 0; i < 2; ++i) vAc[h][i] = S.aoff(cur, h * 128 + Rr[i], Cc, lds);
        if (defer) {
            MM_WAIT_V(0);
            if (tid < 64) {
                unsigned* w = ready + 16 * cur.tile; unsigned sp = 0;
                while ((unsigned)__builtin_amdgcn_readfirstlane(__hip_atomic_load(w, __ATOMIC_RELAXED, __HIP_MEMORY_SCOPE_AGENT)) < 64u) {
                    __builtin_amdgcn_s_sleep(2);
                    if ((++sp & 255u) == 0u) { if (__builtin_amdgcn_readfirstlane(__hip_atomic_load(tmo, __ATOMIC_RELAXED, __HIP_MEMORY_SCOPE_AGENT)) != 0u) break;
                        if (sp > (1u << 20)) { if (lane == 0) __hip_atomic_store(tmo, 0x46u, __ATOMIC_RELAXED, __HIP_MEMORY_SCOPE_AGENT); break; } }
                }
                __builtin_amdgcn_fence(__ATOMIC_ACQUIRE, "agent");
                asm volatile("s_waitcnt vmcnt(0)" ::: "memory");
            }
            asm volatile("" ::: "memory"); MM_BAR; asm volatile("" ::: "memory");
            MM_STAGE_B(MM_SB(0, 0), false, 0, 0); MM_STAGE_B(MM_SB(0, 1), false, 1, 0); MM_STAGE_A(MM_SA(0, 0), false, 0, 0); MM_STAGE_A(MM_SA(0, 1), false, 1, 0);
            if (wr == 1) MM_BAR;
            MM_WAIT_V(2); MM_BAR;
            MM_STAGE_B(MM_SB(1, 0), false, 0, kstep); MM_STAGE_A(MM_SA(1, 0), false, 0, kstep); MM_STAGE_B(MM_SB(1, 1), false, 1, kstep);
            MM_WAIT_V(6); MM_BAR;
        } else if (epi) { if (wr == 1) MM_BAR; }
    }
    MM_WAIT_V(0);
    MM_BAR;
#undef MM_SA
#undef MM_SB
#undef MM_STAGE_A
#undef MM_STAGE_B
#undef MM_LDA
#undef MM_LDB
#undef MM_MMA
#undef MM_WAIT_V
#undef MM_WAIT_L
#undef MM_BAR
#undef MM_SCHED
#undef MM_ZERO
}
}

__device__ __forceinline__ int build_tile_prefix(const unsigned* cnt, LAS int* pre, int tid) {
    if (tid == 0) { int s = 0, x = 0; for (int b = 0; b < NBKT; ++b) { const unsigned n = cnt[b]; pre[b] = s; pre[32 + b] = (int)n; pre[64 + b] = x; s += (int)((n + 255u) >> 8); x += (int)n; } pre[NBKT] = s; }
    __syncthreads();
    return pre[NBKT];
}
__device__ __forceinline__ void phase_p1_fast(const Args& a, const Ctx& c, int l) {
    mm::SchedP1 S; S.A = (const char*)(a.ws + (l == 0 ? WS_ACTX : WS_A3)); S.B = (const char*)(a.ws + WS_WIN) + (size_t)l * INC * 1024 * 2;
    S.nM = 64; S.nN = 10; S.nU = 640; S.G = c.nwg; S.c = c.wg; S.nt = 16; S.lda = 2048; S.ldb = 2048;
    mm::EpiP1 E{(bf16*)(a.ws + WS_PROJ), (const float*)(a.ws + WS_SMALL + SO_SSQA), (const float*)(a.ws + WS_SMALL + SO_BIAS1) + (size_t)l * 8 * INC};
    {
        const int* rowx = (const int*)(a.ws + WS_SMALL + SO_ROWX);
        mm::MUnit u;
        for (int i = 0; i < 3 && S.next(i, u); ++i) {
            if (c.tid < 256) { const int r = u.i0 * 256 + c.tid;
                ((LAS int*)(c.lds + mm::TAB_OFF + i * 3072))[c.tid] = r;
                ((LAS float*)(c.lds + mm::TAB_OFF + i * 3072 + 1024))[c.tid] = rstd_from16(E.ssq, r); }
        }
        __syncthreads();
    }
    mm::mm_phase<mm::EpiP1, mm::SchedP1, true>(c.lds, S, E, c.tid);
}
template <bool L0, bool WT>
__device__ __forceinline__ void phase_p3_impl(const Args& a, const Ctx& c, int l, int cslot) {
    mm::SchedP3 S; S.A = (const char*)(a.ws + WS_A3); S.B = (const char*)(a.ws + WS_WOUT) + (size_t)l * 1024 * 1024 * 2;
    S.nM = 64; S.nN = 4; S.nU = 256; S.G = c.nwg; S.c = c.wg; S.nt = 8; S.lda = 2048; S.ldb = 2048;
    mm::EpiP3<L0, WT> E{a.in[I_X], (const bf16*)(a.ws + WS_X2B), (bf16*)(a.ws + WS_XA), (bf16*)(a.ws + WS_ACTX), (float*)(a.ws + WS_SMALL + SO_SSQB),
                    (const float*)(a.ws + WS_SMALL + SO_MODV) + (size_t)l * 8 * 6144 + 2048, (const float*)(a.ws + WS_SMALL + SO_G2) + (size_t)l * 8 * 1024};
    {
        const float* ssqc = (const float*)(a.ws + WS_SMALL + SO_SSQC); const int* rowx = (const int*)(a.ws + WS_SMALL + SO_ROWX);
        mm::MUnit u;
        for (int i = 0; i < 3 && S.next(2 * i, u); ++i) {
            if (c.tid < 256) {
                const f32x4* p = (const f32x4*)(ssqc + (size_t)(u.i0 * 256 + c.tid) * 16);
                const f32x4 a0 = p[0], a1 = p[1], b0 = p[2], b1 = p[3];
                const float sa = ((a0.x + a0.y) + (a0.z + a0.w)) + ((a1.x + a1.y) + (a1.z + a1.w)), sb = ((b0.x + b0.y) + (b0.z + b0.w)) + ((b1.x + b1.y) + (b1.z + b1.w));
                const float ra = rsqrtf(sa * (1.0f / 512.0f) + EPS), rb = rsqrtf(sb * (1.0f / 512.0f) + EPS);
                ((LAS int*)(c.lds + mm::TAB_OFF + i * 3072))[c.tid] = rowx[u.i0 * 256 + c.tid];
                ((LAS float*)(c.lds + mm::TAB_OFF + i * 3072 + 1024))[c.tid] = ra / rb;
                ((LAS float*)(c.lds + mm::TAB_OFF + i * 3072 + 2048))[c.tid] = rb;
            }
        }
        __syncthreads();
    }
    mm::mm_phase<mm::EpiP3<L0, WT>, mm::SchedP3, false>(c.lds, S, E, c.tid);
    mm::MUnit u0;
    if (S.next(0, u0)) {
        unsigned* pnl = (unsigned*)(a.ws + WS_CTL) + CW_PNL + (cslot * 64 + u0.i0) * 16; unsigned* tmo = (unsigned*)(a.ws + WS_CTL) + CW_TMO;
        asm volatile("s_waitcnt vmcnt(0)" ::: "memory");
        __syncthreads();
        if (c.tid == 0) __hip_atomic_fetch_add(pnl, 1u, __ATOMIC_RELAXED, __HIP_MEMORY_SCOPE_AGENT);
        if (c.tid < 64) {
            unsigned sp = 0;
            while ((unsigned)__builtin_amdgcn_readfirstlane(__hip_atomic_load(pnl, __ATOMIC_RELAXED, __HIP_MEMORY_SCOPE_AGENT)) < 4u) {
                __builtin_amdgcn_s_sleep(2);
                if ((++sp & 255u) == 0u) { if (__builtin_amdgcn_readfirstlane(__hip_atomic_load(tmo, __ATOMIC_RELAXED, __HIP_MEMORY_SCOPE_AGENT)) != 0u) break;
                    if (sp > (1u << 20)) { if (c.lane == 0) __hip_atomic_store(tmo, 0x33u, __ATOMIC_RELAXED, __HIP_MEMORY_SCOPE_AGENT); break; } }
            }
            __builtin_amdgcn_fence(__ATOMIC_ACQUIRE, "agent");
            asm volatile("s_waitcnt vmcnt(0)" ::: "memory");
        }
        __syncthreads();
        route_tokens(a, c, l, cslot, u0.i0 * 256 + u0.i1 * 64, 4);
    }
}
__device__ __forceinline__ void phase_p3_fast(const Args& a, const Ctx& c, int l, int cslot, int pure) {
    if (pure) { if (l == 0) phase_p3_impl<true, false>(a, c, l, cslot); else phase_p3_impl<false, false>(a, c, l, cslot); }
    else { if (l == 0) phase_p3_impl<true, true>(a, c, l, cslot); else phase_p3_impl<false, true>(a, c, l, cslot); }
}
__device__ __forceinline__ void phase_p4_fast(const Args& a, const Ctx& c, int l) {
    const unsigned* cnt = (const unsigned*)(a.ws + WS_CTL) + CW_CNT + l * 32;
    LAS int* pre = (LAS int*)(c.lds + LDSCTL_OFF + 256);
    const int ntile = build_tile_prefix(cnt, pre, c.tid);
    mm::SchedP4 S; S.tokl = (const int*)(a.ws + WS_SMALL + SO_TOKL); S.cnt = cnt; S.A2 = (const char*)(a.ws + WS_ACTX); S.Wgu = (const char*)(a.ws + WS_WGU) + (size_t)l * NE * 1024 * 1024 * 2; S.pre = pre;
    S.nU = ntile * 8; S.G = c.nwg; S.c = c.wg; S.nt = 16; S.lda = 2048; S.ldb = 2048;
    mm::EpiP4 E{(bf16*)(a.ws + WS_ACT), S.tokl, (const float*)(a.ws + WS_SMALL + SO_SSQB), (const float*)(a.ws + WS_SMALL + SO_BIASGU) + (size_t)l * 8 * 16 * 1024, (const float*)(a.ws + WS_SMALL + SO_GATES), 0};
    {
        mm::MUnit u;
        for (int i = 0; i < 3 && S.next(i, u); ++i) {
            if (c.tid < 256) {
                const int rr = u.i1 * 256 + c.tid; const bool valid = rr < u.i3; const int t = valid ? S.tokl[u.i0 * TOKCAP + rr] : 0;
                ((LAS int*)(c.lds + mm::TAB_OFF + i * 3072))[c.tid] = t;
                ((LAS float*)(c.lds + mm::TAB_OFF + i * 3072 + 1024))[c.tid] = rstd_from16(E.ssq, t);
                ((LAS float*)(c.lds + mm::TAB_OFF + i * 3072 + 2048))[c.tid] = valid ? E.gates[(size_t)t * 2 + (u.i2 >> 2)] : 0.f;
                if (valid && u.i2 == 0) ((int*)(a.ws + WS_SMALL + SO_ROWX))[t] = pre[64 + u.i0] + rr;
            }
        }
        __syncthreads();
    }
    mm::mm_phase<mm::EpiP4, mm::SchedP4, true>(c.lds, S, E, c.tid);
}
__device__ __forceinline__ void phase_p5_fast(const Args& a, const Ctx& c, int l) {
    const unsigned* cnt = (const unsigned*)(a.ws + WS_CTL) + CW_CNT + l * 32;
    LAS int* pre = (LAS int*)(c.lds + LDSCTL_OFF + 256);
    const int ntile = build_tile_prefix(cnt, pre, c.tid);
    mm::SchedP5 S; S.cnt = cnt; S.act = (const char*)(a.ws + WS_ACT); S.Wd = (const char*)(a.ws + WS_WD) + (size_t)l * NE * 1024 * 512 * 2; S.pre = pre;
    S.nU = ntile * 4; S.G = c.nwg; S.c = c.wg; S.nt = 8; S.lda = 2048; S.ldb = 1024;
    mm::EpiP5 E{(const bf16*)(a.ws + WS_XA), (bf16*)(a.ws + WS_X2B), (bf16*)(a.ws + WS_A3), (float*)(a.ws + WS_SMALL + SO_SSQA),
                (const float*)(a.ws + WS_SMALL + SO_MODV) + (size_t)l * 8 * 6144 + 5120, (const float*)(a.ws + WS_SMALL + SO_G1) + (size_t)(l + 1 < DEPTH ? l + 1 : l) * 8 * 1024, (l + 1 < DEPTH) ? 1 : 0};
    const int* tokl_ = (const int*)(a.ws + WS_SMALL + SO_TOKL);
    {
        mm::MUnit u;
        for (int i = 0; i < 3 && S.next(2 * i, u); ++i) {
            if (c.tid < 256) { const int rr = u.i1 * 256 + c.tid; ((LAS int*)(c.lds + mm::TAB_OFF + i * 3072))[c.tid] = (rr < u.i3) ? tokl_[u.i0 * TOKCAP + rr] : 0; }
        }
        __syncthreads();
    }
    mm::mm_phase<mm::EpiP5, mm::SchedP5, false>(c.lds, S, E, c.tid);
}


__device__ __forceinline__ void phase_p45(const Args& a, const Ctx& c, int l, int rslot, int pure) {
    const unsigned* cnt = (const unsigned*)(a.ws + WS_CTL) + CW_CNT + l * 32;
    LAS int* pre = (LAS int*)(c.lds + LDSCTL_OFF + 256);
    const int ntile = build_tile_prefix(cnt, pre, c.tid);
    mm::Sched45 S; S.A2 = (const char*)(a.ws + WS_ACTX); S.Wgu = (const char*)(a.ws + WS_WGU) + (size_t)l * NE * 1024 * 1024 * 2; S.act = (const char*)(a.ws + WS_ACT);
    S.Wd = (const char*)(a.ws + WS_WD) + (size_t)l * NE * 1024 * 512 * 2; S.pre = pre;
    { const int x = c.wg & 7; S.t0 = (x * ntile) >> 3; S.ntl = (((x + 1) * ntile) >> 3) - S.t0; S.rank = c.wg >> 3; S.n4 = (8 * S.ntl > S.rank) ? (8 * S.ntl - S.rank + 31) / 32 : 0; }
    const int* tokl = (const int*)(a.ws + WS_SMALL + SO_TOKL);
    mm::EpiP4 E4{(bf16*)(a.ws + WS_ACT), tokl, (const float*)(a.ws + WS_SMALL + SO_SSQB), (const float*)(a.ws + WS_SMALL + SO_BIASGU) + (size_t)l * 8 * 16 * 1024, (const float*)(a.ws + WS_SMALL + SO_GATES), pure ? 0 : 1};
    mm::EpiP5 E5{(const bf16*)(a.ws + WS_XA), (bf16*)(a.ws + WS_X2B), (bf16*)(a.ws + WS_A3), (float*)(a.ws + WS_SMALL + SO_SSQA),
                 (const float*)(a.ws + WS_SMALL + SO_MODV) + (size_t)l * 8 * 6144 + 5120, (const float*)(a.ws + WS_SMALL + SO_G1) + (size_t)(l + 1 < DEPTH ? l + 1 : l) * 8 * 1024, (l + 1 < DEPTH) ? 1 : 0};
    {
        mm::MUnit45 u;
        for (int i = 0; i < 3 + 4 && S.next(i, u); ++i) {
            if (u.kind == 1 && !u.first) continue;
            if (c.tid < 256) {
                const int rr = u.i1 * 256 + c.tid; const bool valid = rr < u.i3; const int t = valid ? tokl[u.i0 * TOKCAP + rr] : 0;
                if (u.kind == 0) {
                    ((LAS int*)(c.lds + mm::TAB_OFF + u.slot * 3072))[c.tid] = t;
                    ((LAS float*)(c.lds + mm::TAB_OFF + u.slot * 3072 + 1024))[c.tid] = rstd_from16(E4.ssq, t);
                    ((LAS float*)(c.lds + mm::TAB_OFF + u.slot * 3072 + 2048))[c.tid] = valid ? E4.gates[(size_t)t * 2 + (u.i2 >> 2)] : 0.f;
                    if (valid && u.i2 == 0) ((int*)(a.ws + WS_SMALL + SO_ROWX))[t] = pre[64 + u.i0] + rr;
                } else ((LAS int*)(c.lds + mm::TAB_OFF + u.i5))[c.tid] = t;
            }
        }
        __syncthreads();
    }
    mm::mm_phase45(c.lds, S, E4, E5, c.tid, (unsigned*)(a.ws + WS_CTL) + CW_RDY + rslot * 96 * 16, (unsigned*)(a.ws + WS_CTL) + CW_TMO);
}
namespace p2 {
typedef float f32x16 __attribute__((ext_vector_type(16)));
typedef short s16x4 __attribute__((ext_vector_type(4)));
constexpr int EXT_OFF = 131072;
constexpr int ST_OFF = 131072 + 4096;
constexpr float NEG = -1e30f;
__device__ __forceinline__ int crow(int r, int hi) { return (r & 3) + 8 * (r >> 2) + 4 * hi; }
__device__ __forceinline__ s16x4 vtr(const LAS unsigned char* p) { return __builtin_bit_cast(s16x4, __builtin_amdgcn_ds_read_tr16_b64_v4i16((LAS s16x4*)p)); }
__device__ __forceinline__ unsigned cvtpk(float lo, float hi) { unsigned r; asm volatile("v_cvt_pk_bf16_f32 %0, %1, %2" : "=v"(r) : "v"(lo), "v"(hi)); return r; }
__device__ __forceinline__ float halves_max(float v) { auto rr = __builtin_amdgcn_permlane32_swap(__float_as_uint(v), __float_as_uint(v), false, false); return fmaxf(__uint_as_float(rr[0]), __uint_as_float(rr[1])); }
__device__ __forceinline__ float halves_sum(float v) { auto rr = __builtin_amdgcn_permlane32_swap(__float_as_uint(v), __float_as_uint(v), false, false); return __uint_as_float(rr[0]) + __uint_as_float(rr[1]); }
__device__ __forceinline__ u32x4 pair_swap(uint2 a, uint2 b) {
    auto r0 = __builtin_amdgcn_permlane32_swap(a.x, b.x, false, false); auto r1 = __builtin_amdgcn_permlane32_swap(a.y, b.y, false, false);
    u32x4 w; w.x = r0[0]; w.y = r1[0]; w.z = r0[1]; w.w = r1[1]; return w;
}
__device__ __forceinline__ void pair_unswap(u32x4 w, uint2& a, uint2& b) {
    auto r0 = __builtin_amdgcn_permlane32_swap(w.x, w.z, false, false); auto r1 = __builtin_amdgcn_permlane32_swap(w.y, w.w, false, false);
    a.x = r0[0]; a.y = r1[0]; b.x = r0[1]; b.y = r1[1];
}

__device__ __forceinline__ void attn_task(const bf16* qh, const bf16* kh, const bf16* vh, int b, int h, int cfg, int r, int iq0, int blk, LAS unsigned char* lds, LAS unsigned char* vbuf, bf16* osc, float* lsc, int lane) {
    const int d = 1 << (2 * cfg), q = lane & 31, hi = lane >> 5;
    const int kbase = iq0 - 128;
    const size_t rowq = ((size_t)(b * 8 + h) * SEQ + d * (iq0 + q) + r) * 64;
    bf16x8 qf[4];
#pragma unroll
    for (int d0 = 0; d0 < 4; ++d0) qf[d0] = *(const bf16x8*)(qh + rowq + 16 * d0 + 8 * hi);
    f32x16 S[5];
    const int e0_ = 31 - q + 4 * hi, sft_ = e0_ & 3;
    const LAS float* ext = (const LAS float*)(lds + EXT_OFF) + sft_ * 768 + cfg * 256 + (e0_ - sft_);
#pragma unroll
    for (int a = 0; a < 5; ++a) {
        if (kbase + 32 * a >= 0) {
            const size_t rowk = ((size_t)(b * 8 + h) * SEQ + d * (kbase + 32 * a + q) + r) * 64 + 8 * hi;
            bf16x8 kf[4];
#pragma unroll
            for (int d0 = 0; d0 < 4; ++d0) kf[d0] = *(const bf16x8*)(kh + rowk + 16 * d0);
            f32x16 s;
#pragma unroll
            for (int k8 = 0; k8 < 4; ++k8) { const f32x4 ev = *(const LAS f32x4*)(ext + 32 * a + 8 * k8); s[4 * k8] = ev[0]; s[4 * k8 + 1] = ev[1]; s[4 * k8 + 2] = ev[2]; s[4 * k8 + 3] = ev[3]; }
#pragma unroll
            for (int d0 = 0; d0 < 4; ++d0) s = __builtin_amdgcn_mfma_f32_32x32x16_bf16(kf[d0], qf[d0], s, 0, 0, 0);
            S[a] = s;
        } else {
#pragma unroll
            for (int rr = 0; rr < 16; ++rr) S[a][rr] = NEG;
        }
    }
    float m = NEG;
#pragma unroll
    for (int a = 0; a < 5; ++a)
#pragma unroll
        for (int rr = 0; rr < 16; ++rr) m = fmaxf(m, S[a][rr]);
    m = halves_max(m);
    float lsum = 0.f;
#pragma unroll
    for (int a = 0; a < 5; ++a)
#pragma unroll
        for (int rr = 0; rr < 16; ++rr) { const float p = __builtin_amdgcn_exp2f(S[a][rr] - m); S[a][rr] = p; lsum += p; }
    lsum = halves_sum(lsum);
    f32x16 o[2];
#pragma unroll
    for (int dh = 0; dh < 2; ++dh)
#pragma unroll
        for (int rr = 0; rr < 16; ++rr) o[dh][rr] = 0.f;
    const LAS unsigned char* vrd = vbuf + ((lane >> 4) & 1) * 32 + (lane & 3) * 8 + (4 * hi + ((lane & 15) >> 2)) * 64;
    u32x4 vreg[4][4];
#pragma unroll
    for (int a = 1; a < 5; ++a)
        if (kbase + 32 * a >= 0) {
#pragma unroll
            for (int i = 0; i < 4; ++i) { const int id = lane + 64 * i, kv = id >> 3, d8 = id & 7;
                vreg[a - 1][i] = *(const u32x4*)(vh + ((size_t)(b * 8 + h) * SEQ + d * (kbase + 32 * a + kv) + r) * 64 + d8 * 8); }
        }
#pragma unroll
    for (int a = 1; a < 5; ++a) {
        if (kbase + 32 * a >= 0) {
#pragma unroll
            for (int i = 0; i < 4; ++i) { const int id = lane + 64 * i, kv = id >> 3, d8 = id & 7;
                *(LAS u32x4*)(vbuf + (d8 >> 2) * 2048 + (kv >> 4) * 1024 + (kv & 15) * 64 + (d8 & 3) * 16) = vreg[a - 1][i]; }
            asm volatile("s_waitcnt lgkmcnt(0)" ::: "memory");
            const LAS unsigned char* vr = vrd;
#pragma unroll
            for (int ks = 0; ks < 2; ++ks) {
                u32x4 pw; pw.x = cvtpk(S[a][8 * ks + 0], S[a][8 * ks + 1]); pw.y = cvtpk(S[a][8 * ks + 2], S[a][8 * ks + 3]); pw.z = cvtpk(S[a][8 * ks + 4], S[a][8 * ks + 5]); pw.w = cvtpk(S[a][8 * ks + 6], S[a][8 * ks + 7]);
                const bf16x8 pb = __builtin_bit_cast(bf16x8, pw);
#pragma unroll
                for (int dh = 0; dh < 2; ++dh) {
                    const s16x4 lo = vtr(vr + dh * 2048 + ks * 1024), hh = vtr(vr + dh * 2048 + ks * 1024 + 512);
                    const bf16x8 vf = (bf16x8){lo[0], lo[1], lo[2], lo[3], hh[0], hh[1], hh[2], hh[3]};
                    o[dh] = __builtin_amdgcn_mfma_f32_32x32x16_bf16(vf, pb, o[dh], 0, 0, 0);
                }
            }
            asm volatile("s_waitcnt lgkmcnt(0)" ::: "memory");
        }
    }
    const int tl = d * (iq0 + q) + r - 512 * blk;
    const float inv = __builtin_amdgcn_rcpf(lsum);
    bf16* orow = osc + (size_t)tl * 64;
#pragma unroll
    for (int dh = 0; dh < 2; ++dh)
#pragma unroll
        for (int k2 = 0; k2 < 2; ++k2) {
            uint2 pa, pb;
            pa.x = cvtpk(o[dh][8 * k2] * inv, o[dh][8 * k2 + 1] * inv); pa.y = cvtpk(o[dh][8 * k2 + 2] * inv, o[dh][8 * k2 + 3] * inv);
            pb.x = cvtpk(o[dh][8 * k2 + 4] * inv, o[dh][8 * k2 + 5] * inv); pb.y = cvtpk(o[dh][8 * k2 + 6] * inv, o[dh][8 * k2 + 7] * inv);
            *(u32x4*)(orow + 32 * dh + 16 * k2 + 8 * hi) = pair_swap(pa, pb);
        }
    if (hi == 0) lsc[cfg * 512 + tl] = m + __builtin_amdgcn_logf(lsum);
}

__device__ __forceinline__ void stage_kv(const bf16* kh, const bf16* vh, int b, int h, int d, int r, int kb0, int R, LAS unsigned char* kl, LAS unsigned char* vl, int wave, int lane, int slot0, int nslots) {
    const int nk = R >> 3;
    for (int n = slot0 + wave; n < 2 * nk; n += nslots) {
        if (n < nk) {
            const int row = 8 * n + (lane >> 3), idx = max(kb0 + row, 0);
            {
                const int cch = (lane & 7) ^ ((row >> 1) & 7);
                const bf16* src = kh + ((size_t)(b * 8 + h) * SEQ + d * idx + r) * 64 + cch * 8;
                __builtin_amdgcn_global_load_lds((const unsigned*)src, (LAS unsigned*)(kl + n * 1024), 16, 0, 0);
            }
        } else {
            const int m = n - nk, p = m >> 1, dh = m & 1, row = 16 * p + (lane >> 2), idx = max(kb0 + row, 0);
            {
                const bf16* src = vh + ((size_t)(b * 8 + h) * SEQ + d * idx + r) * 64 + dh * 32 + (lane & 3) * 8;
                __builtin_amdgcn_global_load_lds((const unsigned*)src, (LAS unsigned*)(vl + dh * (R * 64) + p * 1024), 16, 0, 0);
            }
        }
    }
}
struct MergeArgs { const bf16* osc0; const bf16* osc2; const float* lsc; bf16* a3; float* ssq; };
template <bool WT, bool MG>
__device__ __forceinline__ void attn_task_lds(const bf16* proj, int b, int h, int cfg, int r, int iq0, int blk, const bf16x8 (&qf)[4], const LAS unsigned char* kl, const LAS unsigned char* vl, int vdh, int row0,
                                              LAS unsigned char* lds, bf16* osc, float* lsrow, int lane, const MergeArgs& mg) {
    const int d = 1 << (2 * cfg), q = lane & 31, hi = lane >> 5;
    const int kbase = iq0 - 128;
    f32x16 S[5];
    const int e0_ = 31 - q + 4 * hi, sft_ = e0_ & 3;
    const LAS float* ext = (const LAS float*)(lds + EXT_OFF) + sft_ * 768 + cfg * 256 + (e0_ - sft_);
#pragma unroll
    for (int a = 0; a < 5; ++a) {
        const int eo = (kbase + 32 * a >= 0) ? 32 * a : 160;
#pragma unroll
        for (int k8 = 0; k8 < 4; ++k8) { const f32x4 ev = *(const LAS f32x4*)(ext + eo + 8 * k8); S[a][4 * k8] = ev[0]; S[a][4 * k8 + 1] = ev[1]; S[a][4 * k8 + 2] = ev[2]; S[a][4 * k8 + 3] = ev[3]; }
    }
    const int tl = d * (iq0 + q) + r - 512 * blk;
    u32x4 A0[2][2], A2[2][2]; float l0 = 0.f, l2 = 0.f;
    if constexpr (MG) {
        l0 = mg.lsc[tl]; l2 = mg.lsc[1024 + tl];
#pragma unroll
        for (int dh = 0; dh < 2; ++dh)
#pragma unroll
            for (int k2 = 0; k2 < 2; ++k2) { A0[dh][k2] = *(const u32x4*)(mg.osc0 + (size_t)tl * 64 + 32 * dh + 16 * k2 + 8 * hi); A2[dh][k2] = *(const u32x4*)(mg.osc2 + (size_t)tl * 64 + 32 * dh + 16 * k2 + 8 * hi); }
    }
    {
        bf16x8 kf[2][4];
#define AT_LDK(buf, a_) do { const int row_ = row0 + 32 * (a_) + q; const LAS unsigned char* kr_ = kl + row_ * 128; const int sw_ = (row_ >> 1) & 7; \
            _Pragma("unroll") for (int d0 = 0; d0 < 4; ++d0) kf[buf][d0] = *(const LAS bf16x8*)(kr_ + (((2 * d0 + hi) ^ sw_) << 4)); } while (0)
        AT_LDK(0, 0);
#pragma unroll
        for (int a = 0; a < 5; ++a) {
            if (a < 4) AT_LDK((a + 1) & 1, a + 1);
#pragma unroll
            for (int d0 = 0; d0 < 4; ++d0) S[a] = __builtin_amdgcn_mfma_f32_32x32x16_bf16(kf[a & 1][d0], qf[d0], S[a], 0, 0, 0);
        }
#undef AT_LDK
    }
    float m = NEG;
#pragma unroll
    for (int a = 0; a < 5; ++a)
#pragma unroll
        for (int rr = 0; rr < 16; ++rr) m = fmaxf(m, S[a][rr]);
    m = halves_max(m);
#pragma unroll
    for (int a = 0; a < 5; ++a)
#pragma unroll
        for (int rr = 0; rr < 16; ++rr) S[a][rr] = __builtin_amdgcn_exp2f(S[a][rr] - m);
    f32x16 o[2], osum;
#pragma unroll
    for (int dh = 0; dh < 2; ++dh)
#pragma unroll
        for (int rr = 0; rr < 16; ++rr) o[dh][rr] = 0.f;
#pragma unroll
    for (int rr = 0; rr < 16; ++rr) osum[rr] = 0.f;
    const bf16x8 ones = (bf16x8){0x3F80, 0x3F80, 0x3F80, 0x3F80, 0x3F80, 0x3F80, 0x3F80, 0x3F80};
    const LAS unsigned char* vrd = vl + ((lane >> 4) & 1) * 32 + (lane & 3) * 8 + (4 * hi + ((lane & 15) >> 2)) * 64 + (row0 >> 4) * 1024;
    {
        s16x4 vr[2][4];
#define AT_LDV(buf, st_) do { _Pragma("unroll") for (int dh = 0; dh < 2; ++dh) { const LAS unsigned char* vp_ = vrd + dh * vdh + (st_) * 1024; vr[buf][2 * dh] = vtr(vp_); vr[buf][2 * dh + 1] = vtr(vp_ + 512); } } while (0)
        AT_LDV(0, 0);
#pragma unroll
        for (int st = 0; st < 10; ++st) {
            if (st < 9) AT_LDV((st + 1) & 1, st + 1);
            const int a = st >> 1, ks = st & 1;
            u32x4 pw; pw.x = cvtpk(S[a][8 * ks + 0], S[a][8 * ks + 1]); pw.y = cvtpk(S[a][8 * ks + 2], S[a][8 * ks + 3]); pw.z = cvtpk(S[a][8 * ks + 4], S[a][8 * ks + 5]); pw.w = cvtpk(S[a][8 * ks + 6], S[a][8 * ks + 7]);
            const bf16x8 pb = __builtin_bit_cast(bf16x8, pw);
            osum = __builtin_amdgcn_mfma_f32_32x32x16_bf16(ones, pb, osum, 0, 0, 0);
#pragma unroll
            for (int dh = 0; dh < 2; ++dh) {
                const s16x4 lo = vr[st & 1][2 * dh], hh = vr[st & 1][2 * dh + 1];
                const bf16x8 vf = (bf16x8){lo[0], lo[1], lo[2], lo[3], hh[0], hh[1], hh[2], hh[3]};
                o[dh] = __builtin_amdgcn_mfma_f32_32x32x16_bf16(vf, pb, o[dh], 0, 0, 0);
            }
        }
#undef AT_LDV
    }
    const float lsum = osum[0];
    const float inv = __builtin_amdgcn_rcpf(lsum);
    if constexpr (MG) {
        const float l1 = m + __builtin_amdgcn_logf(lsum);
        const float mx = fmaxf(l0, fmaxf(l1, l2));
        float w0 = __builtin_amdgcn_exp2f(l0 - mx), w1 = __builtin_amdgcn_exp2f(l1 - mx), w2 = __builtin_amdgcn_exp2f(l2 - mx);
        const float iw = __builtin_amdgcn_rcpf(w0 + w1 + w2); w0 *= iw; w2 *= iw; w1 *= iw * inv;
        float ss = 0.f;
        bf16* arow = mg.a3 + (size_t)tl * 1024;
#pragma unroll
        for (int dh = 0; dh < 2; ++dh)
#pragma unroll
            for (int k2 = 0; k2 < 2; ++k2) {
                uint2 x0[2], x2[2], pk[2]; pair_unswap(A0[dh][k2], x0[0], x0[1]); pair_unswap(A2[dh][k2], x2[0], x2[1]);
#pragma unroll
                for (int i = 0; i < 2; ++i) {
                    const int ob = 8 * k2 + 4 * i;
                    const float v0 = w1 * o[dh][ob] + w0 * __uint_as_float(x0[i].x << 16) + w2 * __uint_as_float(x2[i].x << 16);
                    const float v1 = w1 * o[dh][ob + 1] + w0 * __uint_as_float(x0[i].x & 0xffff0000u) + w2 * __uint_as_float(x2[i].x & 0xffff0000u);
                    const float v2 = w1 * o[dh][ob + 2] + w0 * __uint_as_float(x0[i].y << 16) + w2 * __uint_as_float(x2[i].y << 16);
                    const float v3 = w1 * o[dh][ob + 3] + w0 * __uint_as_float(x0[i].y & 0xffff0000u) + w2 * __uint_as_float(x2[i].y & 0xffff0000u);
                    pk[i].x = cvtpk(v0, v1); pk[i].y = cvtpk(v2, v3);
                    ss += (v0 * v0 + v1 * v1) + (v2 * v2 + v3 * v3);
                }
                *(u32x4*)(arow + 32 * dh + 16 * k2 + 8 * hi) = pair_swap(pk[0], pk[1]);
            }
        ss = halves_sum(ss);
        if (hi == 0) mg.ssq[(size_t)tl * 16] = ss;
        return;
    }
    bf16* orow = osc + (size_t)tl * 64;
#pragma unroll
    for (int dh = 0; dh < 2; ++dh)
#pragma unroll
        for (int k2 = 0; k2 < 2; ++k2) {
            uint2 pa, pb;
            pa.x = cvtpk(o[dh][8 * k2] * inv, o[dh][8 * k2 + 1] * inv); pa.y = cvtpk(o[dh][8 * k2 + 2] * inv, o[dh][8 * k2 + 3] * inv);
            pb.x = cvtpk(o[dh][8 * k2 + 4] * inv, o[dh][8 * k2 + 5] * inv); pb.y = cvtpk(o[dh][8 * k2 + 6] * inv, o[dh][8 * k2 + 7] * inv);
            if (WT) { __hip_atomic_store((unsigned long long*)(orow + 32 * dh + 16 * k2 + 4 * hi), ((unsigned long long)pa.y << 32) | pa.x, __ATOMIC_RELAXED, __HIP_MEMORY_SCOPE_AGENT);
                      __hip_atomic_store((unsigned long long*)(orow + 32 * dh + 16 * k2 + 8 + 4 * hi), ((unsigned long long)pb.y << 32) | pb.x, __ATOMIC_RELAXED, __HIP_MEMORY_SCOPE_AGENT); }
            else *(u32x4*)(orow + 32 * dh + 16 * k2 + 8 * hi) = pair_swap(pa, pb);
        }
    if (hi == 0) { const float lv = m + __builtin_amdgcn_logf(lsum);
        if (WT) __hip_atomic_store(lsrow + tl, lv, __ATOMIC_RELAXED, __HIP_MEMORY_SCOPE_AGENT); else lsrow[tl] = lv; }
}

__device__ __forceinline__ void attn_unit(const Args& a, const Ctx& c, int l, int cslot) {
    const bf16* proj = (const bf16*)(a.ws + WS_PROJ); bf16* A3 = (bf16*)(a.ws + WS_A3);
    const bf16* qh = (const bf16*)(a.ws + WS_QH); const bf16* kh = (const bf16*)(a.ws + WS_KH); const bf16* vh = (const bf16*)(a.ws + WS_VH);
    float* ssqc = (float*)(a.ws + WS_SMALL + SO_SSQC);
    const int xcd = c.wg & 7, j = c.wg >> 3, p = xcd * 8 + (j >> 2), blk = j & 3, b = p >> 3, h = p & 7;
    bf16* osc01 = (bf16*)(a.ws + WS_XA + (size_t)xcd * 4 * MiB) + (size_t)j * (2 * 512 * 64); bf16* osc2 = (bf16*)(a.ws + WS_ACTX + (size_t)xcd * 4 * MiB + 256 * 1024) + (size_t)j * (512 * 64);
    float* lsc = (float*)(a.ws + WS_ACTX + (size_t)xcd * 4 * MiB) + (size_t)j * (3 * 512);
    {
        LAS float* ext = (LAS float*)(c.lds + EXT_OFF); const float* relb = a.in[I_RELB];
        for (int x = c.tid; x < 3 * 256; x += NTHREADS) {
            const int cfg = x >> 8, xx = x & 255, rel = 159 - xx;
            ext[x] = (rel >= 0 && rel <= 128) ? relb[(int)T5B[cfg][rel] * 8 + h] * LOG2E : NEG;
        }
        __syncthreads();
        for (int x = c.tid; x < 3 * 768; x += NTHREADS) {
            const int s = 1 + x / 768, y = x % 768;
            ext[s * 768 + y] = ((y & 255) + s < 256) ? ext[y + s] : NEG;
        }
    }
    const int q = c.lane & 31, hi = c.lane >> 5;
    __syncthreads();
    LAS unsigned char* vbuf = c.lds + 98304 + c.wave * 4096;
    const MergeArgs mga{osc01, osc2, lsc, A3 + ((size_t)b * SEQ + 512 * blk) * 1024 + 512 + h * 64, ssqc + ((size_t)b * SEQ + 512 * blk) * 16 + 8 + h};
#pragma unroll 1
    for (int hf = 0; hf < 2; ++hf) {
        const int kb0 = 512 * blk + 256 * hf - 128, iq0 = 512 * blk + 256 * hf + 32 * c.wave;
        stage_kv(kh, vh, b, h, 1, 0, kb0, 384, c.lds, c.lds + 49152, c.wave, c.lane, 0, 8);
        attn_task(qh, kh, vh, b, h, 2, 2 * c.wave + hf, 32 * blk, blk, c.lds, vbuf, osc2, lsc, c.lane);
        bf16x8 qf[4];
        const size_t rowq = ((size_t)(b * 8 + h) * SEQ + iq0 + q) * 64;
#pragma unroll
        for (int d0 = 0; d0 < 4; ++d0) qf[d0] = *(const bf16x8*)(qh + rowq + 16 * d0 + 8 * hi);
        asm volatile("s_waitcnt vmcnt(0)" ::: "memory");
        __syncthreads();
        attn_task_lds<false, false>(proj, b, h, 0, 0, iq0, blk, qf, c.lds, c.lds + 49152, 384 * 64, 32 * c.wave, c.lds, osc01, lsc, c.lane, mga);
        __syncthreads();
    }
#pragma unroll 1
    for (int rd_ = 0; rd_ < ((P2_REP & 2) ? 4 : 2); ++rd_) { const int rd = rd_ & 1;
        const int kb0 = 128 * blk - 128, s = c.wave >> 2, r = 2 * rd + s, iq0 = 128 * blk + 32 * (c.wave & 3);
        bf16x8 qf[4];
        const size_t rowq = ((size_t)(b * 8 + h) * SEQ + 4 * (iq0 + q) + r) * 64;
#pragma unroll
        for (int d0 = 0; d0 < 4; ++d0) qf[d0] = *(const bf16x8*)(qh + rowq + 16 * d0 + 8 * hi);
        stage_kv(kh, vh, b, h, 4, 2 * rd, kb0, 256, c.lds, c.lds + 65536, c.wave, c.lane, 0, 8);
        stage_kv(kh, vh, b, h, 4, 2 * rd + 1, kb0, 256, c.lds + 32768, c.lds + 65536 + 32768, c.wave, c.lane, 0, 8);
        asm volatile("s_waitcnt vmcnt(0)" ::: "memory");
        __syncthreads();
        attn_task_lds<false, true>(proj, b, h, 1, r, iq0, blk, qf, c.lds + s * 32768, c.lds + 65536 + s * 32768, 256 * 64, 32 * (c.wave & 3), c.lds, osc01 + 512 * 64, lsc + 512, c.lane, mga);
        __syncthreads();
    }
    __syncthreads();
}

__device__ __forceinline__ void gmlp_unit(const Args& a, const Ctx& c, int l) {
    const bf16* proj = (const bf16*)(a.ws + WS_PROJ); bf16* A3 = (bf16*)(a.ws + WS_A3); float* ssqc = (float*)(a.ws + WS_SMALL + SO_SSQC);
    const bf16* wsp = (const bf16*)(a.ws + WS_WS) + (size_t)l * 8 * 128 * 128;
    const float* lng = a.in[I_LNG] + l * 512; const float* lnb = a.in[I_LNB] + l * 512; const float* gbs = a.in[I_GBS] + l * 8 * 128;
    const int bn = (c.wg & 7) * 16 + (c.wg >> 4), hf = (c.wg >> 3) & 1, t0 = bn * CHUNK;
    const int gl = c.wave & 3, th = c.wave >> 2, g = 4 * hf + gl, q = c.lane & 31, hi = c.lane >> 5;
    u32x4 raw[16];
#pragma unroll
    for (int i = 0; i < 16; ++i) raw[i] = *(const u32x4*)(proj + (size_t)(t0 + c.wave * 16 + i) * 1024 + 512 + c.lane * 8);
    const f32x4 g0 = *(const f32x4*)(lng + c.lane * 8), g1 = *(const f32x4*)(lng + c.lane * 8 + 4), b0 = *(const f32x4*)(lnb + c.lane * 8), b1 = *(const f32x4*)(lnb + c.lane * 8 + 4);
    bf16x8 wf[2][8]; u32x4 uw[2][2][2]; float bias[2];
#pragma unroll
    for (int tt = 0; tt < 2; ++tt) {
        const int t = 32 * (2 * th + tt) + q;
        const bf16* wrow = wsp + ((size_t)g * 128 + t) * 128 + 8 * hi;
#pragma unroll
        for (int ks = 0; ks < 8; ++ks) wf[tt][ks] = *(const bf16x8*)(wrow + 16 * ks);
#pragma unroll
        for (int eh = 0; eh < 2; ++eh)
#pragma unroll
            for (int k2 = 0; k2 < 2; ++k2) uw[tt][eh][k2] = *(const u32x4*)(proj + ((size_t)t0 + t) * 1024 + g * 64 + 32 * eh + 16 * k2 + 8 * hi);
        bias[tt] = gbs[g * 128 + t];
    }
    {
        const int e8 = c.lane & 7, glw = (c.lane >> 3) & 3;
#pragma unroll
        for (int i = 0; i < 16; ++i) {
            float v[8]; float sm = 0.f, sq = 0.f;
#pragma unroll
            for (int e = 0; e < 4; ++e) { v[2 * e] = __uint_as_float(raw[i][e] << 16); v[2 * e + 1] = __uint_as_float(raw[i][e] & 0xffff0000u); sm += v[2 * e] + v[2 * e + 1]; sq += v[2 * e] * v[2 * e] + v[2 * e + 1] * v[2 * e + 1]; }
            sm = wave_sum(sm); sq = wave_sum(sq);
            const float mu = sm * (1.0f / 512.0f), var = fmaxf(sq * (1.0f / 512.0f) - mu * mu, 0.f), rs = rsqrtf(var + EPS);
            if (hi == hf) {
                const int s = c.wave * 16 + i;
                u32x4 w;
                w.x = cvtpk((v[0] - mu) * rs * g0[0] + b0[0], (v[1] - mu) * rs * g0[1] + b0[1]); w.y = cvtpk((v[2] - mu) * rs * g0[2] + b0[2], (v[3] - mu) * rs * g0[3] + b0[3]);
                w.z = cvtpk((v[4] - mu) * rs * g1[0] + b1[0], (v[5] - mu) * rs * g1[1] + b1[1]); w.w = cvtpk((v[6] - mu) * rs * g1[2] + b1[2], (v[7] - mu) * rs * g1[3] + b1[3]);
                *(LAS u32x4*)(c.lds + glw * 16384 + (e8 >> 2) * 8192 + (s >> 4) * 1024 + (s & 15) * 64 + (e8 & 3) * 16) = w;
            }
        }
    }
    __syncthreads();
    {
        const LAS unsigned char* vr = c.lds + gl * 16384 + ((c.lane >> 4) & 1) * 32 + (c.lane & 3) * 8 + (4 * hi + ((c.lane & 15) >> 2)) * 64;
#pragma unroll
        for (int tt = 0; tt < 2; ++tt) {
            const int tti = 2 * th + tt, t = 32 * tti + q;
            const size_t tg = (size_t)t0 + t;
            f32x16 acc[2];
#pragma unroll
            for (int eh = 0; eh < 2; ++eh)
#pragma unroll
                for (int rr = 0; rr < 16; ++rr) acc[eh][rr] = 0.f;
#pragma unroll
            for (int ks = 0; ks < 8; ++ks) {
                if (ks < 2 * tti + 2) {
#pragma unroll
                    for (int eh = 0; eh < 2; ++eh) {
                        const s16x4 lo = vtr(vr + eh * 8192 + ks * 1024), hh = vtr(vr + eh * 8192 + ks * 1024 + 512);
                        const bf16x8 vf = (bf16x8){lo[0], lo[1], lo[2], lo[3], hh[0], hh[1], hh[2], hh[3]};
                        acc[eh] = __builtin_amdgcn_mfma_f32_32x32x16_bf16(vf, wf[tt][ks], acc[eh], 0, 0, 0);
                    }
                }
            }
            float ss = 0.f;
#pragma unroll
            for (int eh = 0; eh < 2; ++eh)
#pragma unroll
                for (int k2 = 0; k2 < 2; ++k2) {
                    uint2 uu[2], pk[2]; pair_unswap(uw[tt][eh][k2], uu[0], uu[1]);
#pragma unroll
                    for (int i = 0; i < 2; ++i) { const int k4 = 2 * k2 + i; const uint2 uv = uu[i];
                        const float o0 = (acc[eh][4 * k4] + bias[tt]) * __uint_as_float(uv.x << 16), o1 = (acc[eh][4 * k4 + 1] + bias[tt]) * __uint_as_float(uv.x & 0xffff0000u);
                        const float o2 = (acc[eh][4 * k4 + 2] + bias[tt]) * __uint_as_float(uv.y << 16), o3 = (acc[eh][4 * k4 + 3] + bias[tt]) * __uint_as_float(uv.y & 0xffff0000u);
                        pk[i].x = cvtpk(o0, o1); pk[i].y = cvtpk(o2, o3);
                        ss += (o0 * o0 + o1 * o1) + (o2 * o2 + o3 * o3); }
                    *(u32x4*)(A3 + tg * 1024 + g * 64 + 32 * eh + 16 * k2 + 8 * hi) = pair_swap(pk[0], pk[1]);
                }
            ss = halves_sum(ss);
            if (hi == 0) ssqc[tg * 16 + g] = ss;
        }
    }
    __syncthreads();
}
}
__device__ __forceinline__ void phase_p2_fast(const Args& a, const Ctx& c, int l, int cslot) {
    p2::attn_unit(a, c, l, cslot);
    p2::gmlp_unit(a, c, l);
    if ((DUP_MASK >> 10) & 1) p2::gmlp_unit(a, c, l);
}

constexpr int NPL = MERGE45 ? 4 : 5;
constexpr int NPHASE = 1 + NPL * DEPTH + 1;
__device__ __forceinline__ Ctx make_ctx(int tid, LAS unsigned char* lds, int zs) {
    Ctx c; c.lds = lds; c.tid = tid; c.lane = tid & 63; c.wave = __builtin_amdgcn_readfirstlane(tid >> 6);
    c.wg = (int)blockIdx.x + zs; c.nwg = (int)gridDim.x + zs; c.gw = c.wg * NWAVES + c.wave; c.ngw = c.nwg * NWAVES; c.gtid = c.wg * NTHREADS + tid; c.ngt = c.nwg * NTHREADS;
    return c;
}
__global__ void __launch_bounds__(NTHREADS, 2) fwd_kernel(Args a0) {
    extern __shared__ __attribute__((aligned(16))) unsigned char lds_raw[];
    LAS unsigned char* const lds0 = (LAS unsigned char*)lds_raw;
    volatile LAS unsigned* MISC = (volatile LAS unsigned*)(lds0 + LDSCTL_OFF);
    int tid_ = threadIdx.x;
    for (int u = tid_; u < (LDS_BYTES - LDSCTL_OFF) / 4; u += NTHREADS) MISC[u] = 0u;
    __syncthreads();
    const int lo = a0.ph_lo, hi = a0.ph_hi;
    XcdBarrier bar; bar.bar = (unsigned*)(a0.ws + WS_CTL) + CW_BAR; bar.x = 0; bar.st = MISC + 8;
    if (hi - lo > 1) bar = xcd_barrier_post((unsigned*)(a0.ws + WS_CTL) + CW_BAR, MISC + 8, tid_);
    if (tid_ == 0) __hip_atomic_store((unsigned*)(a0.ws + WS_CTL) + CW_XT + blockIdx.x, xb_xcc_id() + 1u, __ATOMIC_RELAXED, __HIP_MEMORY_SCOPE_AGENT);
    int pure = 0;
    int ph = 0;
#define RUN_PHASE(kind, body) do { if (ph >= lo && ph < hi) { for (int rep_ = 0; rep_ < (((DUP_MASK >> (kind)) & 1) ? 2 : 1); ++rep_) { int zs_ = 0; asm volatile("" : "+s"(zs_)); Args a = a0; \
        _Pragma("unroll") for (int i_ = 0; i_ < 21; ++i_) a.in[i_] = a0.in[i_] + zs_; a.out = a0.out + zs_; a.ws = a0.ws + zs_; \
        asm volatile("" : "+v"(tid_)); const Ctx c = make_ctx(tid_, lds0 + zs_, zs_); body; if (ph + 1 < hi || rep_ == 0 && ((DUP_MASK >> (kind)) & 1)) { \
            if (((kind) == 2 || (kind) == 3) && pure && DUP_MASK == 0) group_barrier((unsigned*)(a0.ws + WS_CTL), ((ph - 1) / NPL) * 2 + ((kind) - 2), (int)blockIdx.x + zs_, tid_); else xcd_barrier(bar, tid_); } } } ++ph; } while (0)
    RUN_PHASE(0, { phase_p0a(a, c); phase_p0b(a, c); });
    if (lo == 0 && hi == NPHASE && gridDim.x == 256) {
        if (tid_ < 256) { unsigned* xt = (unsigned*)(a0.ws + WS_CTL) + CW_XT; const unsigned v = xb_ld(xt + tid_), r = xb_ld(xt + (tid_ & 7)); if (v != r || v == 0u) MISC[13] = 1u; }
        __syncthreads();
        pure = __builtin_amdgcn_readfirstlane(MISC[13] == 0u ? 1 : 0);
    }
    for (int l = 0; l < DEPTH; ++l) {
        RUN_PHASE(2, phase_p1_fast(a, c, l));
        RUN_PHASE(3, phase_p2_fast(a, c, l, l + 2 * rep_));
        RUN_PHASE(4, phase_p3_fast(a, c, l, l + 2 * rep_, pure));
#if MERGE45
        RUN_PHASE(6, phase_p45(a, c, l, l + 2 * rep_, pure));
#else
        RUN_PHASE(6, phase_p4_fast(a, c, l));
        RUN_PHASE(7, phase_p5_fast(a, c, l));
#endif
    }
    RUN_PHASE(8, phase_p6(a, c));
#undef RUN_PHASE
}

extern "C" void kernel_launch(void* const* d_in, const int* in_sizes, int n_in, void* d_out, int out_size, void* d_ws, size_t ws_size, hipStream_t stream) {
    static int grid = 0;
    if (grid == 0) {
        if (n_in != 21 || out_size != T * D || ws_size < WS_END) { fprintf(stderr, "kernel_launch: unexpected shapes (n_in %d, out %d, ws %zu)\n", n_in, out_size, ws_size); grid = -1; return; }
        int dev = 0, cus = 0, per_cu = 0;
        if (hipGetDevice(&dev) != hipSuccess || hipDeviceGetAttribute(&cus, hipDeviceAttributeMultiprocessorCount, dev) != hipSuccess) { grid = -1; return; }
        if (hipFuncSetAttribute((const void*)fwd_kernel, hipFuncAttributeMaxDynamicSharedMemorySize, LDS_BYTES) != hipSuccess) { fprintf(stderr, "kernel_launch: hipFuncSetAttribute failed\n"); grid = -1; return; }
        if (hipOccupancyMaxActiveBlocksPerMultiprocessor(&per_cu, (const void*)fwd_kernel, NTHREADS, LDS_BYTES) != hipSuccess || per_cu < 1)
            fprintf(stderr, "kernel_launch: occupancy query reports %d workgroups per CU\n", per_cu);
        (void)hipGetLastError();
        grid = cus;
    }
    if (grid < 0) return;
    if (hipMemsetAsync((char*)d_ws + WS_CTL, 0, CTL_BYTES, stream) != hipSuccess) return;
    Args a{};
    for (int i = 0; i < 21; ++i) a.in[i] = (const float*)d_in[i];
    a.out = (float*)d_out; a.ws = (unsigned char*)d_ws;
#if N_LAUNCH_MODE == 1
    a.ph_lo = 0; a.ph_hi = NPHASE;
    hipLaunchKernelGGL(fwd_kernel, dim3(grid), dim3(NTHREADS), LDS_BYTES, stream, a);
#else
    for (int ph = 0; ph < NPHASE; ++ph) {
        a.ph_lo = ph; a.ph_hi = ph + 1;
        hipLaunchKernelGGL(fwd_kernel, dim3(grid), dim3(NTHREADS), LDS_BYTES, stream, a);
    }
#endif
}
```

```cpp
#include <hip/hip_runtime.h>
#include <cstdio>
#include <cstdint>

constexpr int D = 1024, BATCH = 8, SEQ = 2048, T = BATCH * SEQ, DEPTH = 2;
constexpr int AW = 512, HD = 64, INC = 2560, CHUNK = 128;
constexpr int NE = 16, DE = 512, NBKT = 24, TOKCAP = 16384;
constexpr float EPS = 1e-6f;
constexpr float LOG2E = 1.4426950408889634f;
constexpr float C2 = 0.125f * LOG2E;
#ifndef FAST_P2
#define FAST_P2 1
#endif
#ifndef MERGE45
#define MERGE45 1
#endif
#ifndef EPI_TWICE
#define EPI_TWICE 0
#endif
#ifndef P2_REP
#define P2_REP 0
#endif
#ifndef DUP_MASK
#define DUP_MASK 0
#endif
#ifndef N_LAUNCH_MODE
#define N_LAUNCH_MODE 1
#endif

constexpr size_t MiB = 1u << 20;
constexpr size_t WS_CTL = 0, CTL_BYTES = 131072;
constexpr size_t WS_SMALL = 1 * MiB;
constexpr size_t WS_WIN = 9 * MiB;
constexpr size_t WS_WOUT = 19 * MiB;
constexpr size_t WS_WS = 23 * MiB;
constexpr size_t WS_WGU = 24 * MiB;
constexpr size_t WS_WD = 88 * MiB;
constexpr size_t WS_XA = 120 * MiB;
constexpr size_t WS_X2B = 152 * MiB;
constexpr size_t WS_ACTX = 184 * MiB;
constexpr size_t WS_PROJ = 216 * MiB;
constexpr size_t WS_QH = WS_PROJ + 32 * MiB, WS_KH = WS_PROJ + 48 * MiB, WS_VH = WS_PROJ + 64 * MiB;
constexpr size_t WS_A3 = 296 * MiB;
constexpr size_t WS_END = 328 * MiB;
constexpr size_t WS_ACT = WS_PROJ;
constexpr size_t SO_MODV = 0;
constexpr size_t SO_G1 = 512 * 1024;
constexpr size_t SO_G2 = 576 * 1024;
constexpr size_t SO_BIAS1 = 640 * 1024;
constexpr size_t SO_RBIAS = 800 * 1024;
constexpr size_t SO_BIASGU = 1 * MiB;
constexpr size_t SO_GATES = 2 * MiB;
constexpr size_t SO_TOKL = 2 * MiB + 512 * 1024;
constexpr size_t SO_SSQA = 4 * MiB;
constexpr size_t SO_SSQB = 5 * MiB;
constexpr size_t SO_ROWX = 7 * MiB + 512 * 1024;
constexpr size_t SO_RWT = 7 * MiB;
constexpr size_t SO_SSQC = 6 * MiB;
constexpr int CW_TMO = 0, CW_CNT = 64  , CW_BAR = 1024, CW_RDY = 8192  , CW_MOD = 32  , CW_SIB = 24576  , CW_PNL = 16384  ,
              CW_XT = 28672  , CW_GRP = 29184  ;

constexpr int NWAVES = 8, NTHREADS = 512;
constexpr int LDS_BYTES = 162816;
constexpr int LDSCTL_OFF = 143360;

#define GAS __attribute__((address_space(1)))
#define LAS __attribute__((address_space(3)))
typedef unsigned short bf16;
typedef short bf16x8 __attribute__((ext_vector_type(8)));
typedef float f32x4 __attribute__((ext_vector_type(4)));
typedef unsigned u32x4 __attribute__((ext_vector_type(4)));
#define LDS_WAIT() asm volatile("s_waitcnt lgkmcnt(0)" ::: "memory")

__device__ __forceinline__ float bf2f(bf16 b) { return __uint_as_float((unsigned)b << 16); }
__device__ __forceinline__ unsigned f2bf(float f) { unsigned u = __float_as_uint(f); return (u + 0x7fffu + ((u >> 16) & 1u)) >> 16; }
__device__ __forceinline__ unsigned pk2(float lo, float hi) { unsigned r; asm volatile("v_cvt_pk_bf16_f32 %0, %1, %2" : "=v"(r) : "v"(lo), "v"(hi)); return r; }
__device__ __forceinline__ float wave_sum(float v) {
    v += __builtin_bit_cast(float, __builtin_amdgcn_update_dpp(0, __builtin_bit_cast(int, v), 0xB1, 0xF, 0xF, true));
    v += __builtin_bit_cast(float, __builtin_amdgcn_update_dpp(0, __builtin_bit_cast(int, v), 0x4E, 0xF, 0xF, true));
    v += __builtin_bit_cast(float, __builtin_amdgcn_update_dpp(0, __builtin_bit_cast(int, v), 0x141, 0xF, 0xF, true));
    v += __builtin_bit_cast(float, __builtin_amdgcn_update_dpp(0, __builtin_bit_cast(int, v), 0x140, 0xF, 0xF, true));
    { auto rr = __builtin_amdgcn_permlane16_swap(__float_as_uint(v), __float_as_uint(v), false, false); v = __uint_as_float(rr[0]) + __uint_as_float(rr[1]); }
    { auto rr = __builtin_amdgcn_permlane32_swap(__float_as_uint(v), __float_as_uint(v), false, false); v = __uint_as_float(rr[0]) + __uint_as_float(rr[1]); }
    return v;
}
__device__ __forceinline__ float rows_sum(float v) {
    { auto rr = __builtin_amdgcn_permlane16_swap(__float_as_uint(v), __float_as_uint(v), false, false); v = __uint_as_float(rr[0]) + __uint_as_float(rr[1]); }
    { auto rr = __builtin_amdgcn_permlane32_swap(__float_as_uint(v), __float_as_uint(v), false, false); v = __uint_as_float(rr[0]) + __uint_as_float(rr[1]); }
    return v;
}
__device__ __forceinline__ float rows_max(float v) {
    { auto rr = __builtin_amdgcn_permlane16_swap(__float_as_uint(v), __float_as_uint(v), false, false); v = fmaxf(__uint_as_float(rr[0]), __uint_as_float(rr[1])); }
    { auto rr = __builtin_amdgcn_permlane32_swap(__float_as_uint(v), __float_as_uint(v), false, false); v = fmaxf(__uint_as_float(rr[0]), __uint_as_float(rr[1])); }
    return v;
}
__device__ __forceinline__ float oct_sum(float v) {
    v += __builtin_bit_cast(float, __builtin_amdgcn_update_dpp(0, __builtin_bit_cast(int, v), 0xB1, 0xF, 0xF, true));
    v += __builtin_bit_cast(float, __builtin_amdgcn_update_dpp(0, __builtin_bit_cast(int, v), 0x4E, 0xF, 0xF, true));
    v += __builtin_bit_cast(float, __builtin_amdgcn_update_dpp(0, __builtin_bit_cast(int, v), 0x141, 0xF, 0xF, true));
    return v;
}
__device__ __forceinline__ float gelu_exact(float x) { return 0.5f * x * (1.0f + erff(x * 0.70710678118654752f)); }
__device__ __forceinline__ float silu_f(float x) { return x / (1.0f + __expf(-x)); }

__device__ const unsigned char T5B[3][132] = {
{0,1,2,3,4,5,6,7,8,9,10,11,12,13,14,15,16,16,16,16,16,16,17,17,17,17,17,17,17,17,18,18,18,18,18,18,18,18,18,18,19,19,19,19,19,19,19,19,19,19,19,19,19,19,20,20,20,20,20,20,20,20,20,20,20,20,20,20,20,20,20,20,20,21,21,21,21,21,21,21,21,21,21,21,21,21,21,21,21,21,21,21,21,21,21,21,21,21,21,22,22,22,22,22,22,22,22,22,22,22,22,22,22,22,22,22,22,22,22,22,22,22,22,22,22,22,22,22,22,0,0,0},
{0,4,8,12,16,16,17,17,18,18,19,19,19,19,20,20,20,20,20,21,21,21,21,21,21,22,22,22,22,22,22,22,22,22,23,23,23,23,23,23,23,23,23,23,23,23,24,24,24,24,24,24,24,24,24,24,24,24,24,24,24,24,25,25,25,25,25,25,25,25,25,25,25,25,25,25,25,25,25,25,25,25,25,26,26,26,26,26,26,26,26,26,26,26,26,26,26,26,26,26,26,26,26,26,26,26,26,26,26,26,26,26,26,27,27,27,27,27,27,27,27,27,27,27,27,27,27,27,27,0,0,0},
{0,16,18,19,20,21,21,22,22,23,23,23,24,24,24,24,25,25,25,25,25,26,26,26,26,26,26,26,26,27,27,27,27,27,27,27,27,27,27,28,28,28,28,28,28,28,28,28,28,28,28,28,29,29,29,29,29,29,29,29,29,29,29,29,29,29,29,29,29,29,30,30,30,30,30,30,30,30,30,30,30,30,30,30,30,30,30,30,30,30,30,30,30,30,30,31,31,31,31,31,31,31,31,31,31,31,31,31,31,31,31,31,31,31,31,31,31,31,31,31,31,31,31,31,31,31,31,31,31,0,0,0}};

#define XB_TMO      128
#define XB_XCNT(j)  (256  + 64 * (j))
#define XB_XSUB(j)  (1280 + 64 * (j))
#define XB_XGEN(j)  (2304 + 64 * (j))
#define XB_TOP      3328
#define XB_TOPGEN   3392
#define XCD_BAR_WORDS 3456
#define XB_SPIN_CAP (1u << 18)

__device__ __forceinline__ unsigned xb_ld(unsigned* p)              { return __hip_atomic_load(p, __ATOMIC_RELAXED, __HIP_MEMORY_SCOPE_AGENT); }
__device__ __forceinline__ unsigned xb_add(unsigned* p, unsigned v) { return __hip_atomic_fetch_add(p, v, __ATOMIC_RELAXED, __HIP_MEMORY_SCOPE_AGENT); }
__device__ __forceinline__ unsigned xb_xcc_id() { return (unsigned)__builtin_amdgcn_s_getreg((3 << 11) | 20) & 0xFu; }
#define XB_SPIN(cond, bar) do { unsigned _sp = 0; while (cond) { __builtin_amdgcn_s_sleep(1); \
    if ((++_sp & 255u) == 0u) { if (xb_ld(&(bar)[XB_TMO])) break; if (_sp > XB_SPIN_CAP) { atomicAdd(&(bar)[XB_TMO], 1u); break; } } } } while (0)

struct XcdBarrier {
    unsigned* bar; unsigned x;
    volatile LAS unsigned* st;
};
__device__ __forceinline__ XcdBarrier xcd_barrier_post(unsigned* bar, volatile LAS unsigned* st, int tid) {
    XcdBarrier b; b.bar = bar; b.x = xb_xcc_id(); b.st = st;
    if (tid == 0) (void)xb_add(&bar[XB_XCNT(b.x)], 1u);
    return b;
}
__device__ __forceinline__ void xcd_barrier_complete(unsigned* bar, unsigned x, unsigned& nloc, unsigned& nx) {
    const unsigned G = gridDim.x * gridDim.y * gridDim.z;
    unsigned sum, cnt, mine, sp = 0u;
    for (;;) {
        sum = 0u; cnt = 0u; mine = 0u;
#pragma unroll
        for (unsigned j = 0; j < 16; ++j) { const unsigned c = xb_ld(&bar[XB_XCNT(j)]); sum += c; cnt += (c > 0u) ? 1u : 0u; mine = (j == x) ? c : mine; }
        if (sum == G) break;
        __builtin_amdgcn_s_sleep(1);
        if ((++sp & 255u) == 0u) { if (xb_ld(&bar[XB_TMO])) break; if (sp > XB_SPIN_CAP) { atomicAdd(&bar[XB_TMO], 1u); break; } }
    }
    nloc = mine > 0u ? mine : 1u; nx = cnt > 0u ? cnt : 1u;
}
__device__ __forceinline__ void xcd_barrier(const XcdBarrier& b, int tid) {
    asm volatile("s_waitcnt vmcnt(0)" ::: "memory");
    __syncthreads();
    if (tid == 0) {
        unsigned* bar = b.bar;
        __builtin_amdgcn_s_waitcnt(0);
        unsigned nloc = b.st[0], nx = b.st[1];
        if (nloc == 0u) { xcd_barrier_complete(bar, b.x, nloc, nx); b.st[0] = nloc; b.st[1] = nx; }
        const unsigned old = xb_add(&bar[XB_XSUB(b.x)], 1u);
        const unsigned gen = old / nloc;
        if (old + 1u == (gen + 1u) * nloc) {
            __builtin_amdgcn_fence(__ATOMIC_RELEASE, "agent");
            asm volatile("s_waitcnt vmcnt(0)" ::: "memory");
            const unsigned og = xb_add(&bar[XB_TOP], 1u);
            const unsigned tg = og / nx;
            if (og + 1u == (tg + 1u) * nx) xb_add(&bar[XB_TOPGEN], 1u);
            else XB_SPIN(xb_ld(&bar[XB_TOPGEN]) == tg, bar);
            __builtin_amdgcn_fence(__ATOMIC_ACQUIRE, "agent");
            xb_add(&bar[XB_XGEN(b.x)], 1u);
            asm volatile("s_waitcnt vmcnt(0)" ::: "memory");
        } else {
            XB_SPIN(xb_ld(&bar[XB_XGEN(b.x)]) == gen, bar);
            __builtin_amdgcn_fence(__ATOMIC_ACQUIRE, "agent");
            asm volatile("s_waitcnt vmcnt(0)" ::: "memory");
        }
    }
    __syncthreads();
}

__device__ __forceinline__ void group_barrier(unsigned* ctl, int inst, int wg, int tid) {
    asm volatile("s_waitcnt vmcnt(0)" ::: "memory");
    __syncthreads();
    if (tid == 0) {
        unsigned* w = ctl + CW_GRP + (inst * 8 + (wg & 7)) * 16; unsigned* bar = ctl + CW_BAR;
        __builtin_amdgcn_s_waitcnt(0);
        (void)xb_add(w, 1u);
        XB_SPIN(xb_ld(w) < 32u, bar);
        __builtin_amdgcn_fence(__ATOMIC_ACQUIRE, "agent");
        asm volatile("s_waitcnt vmcnt(0)" ::: "memory");
    }
    __syncthreads();
}

struct Args { const float* in[21]; float* out; unsigned char* ws; int ph_lo, ph_hi; };
enum { I_X = 0, I_C, I_RELB, I_RW, I_RB, I_MODW, I_MODB, I_N1G, I_WIN, I_LNG, I_LNB, I_GWS, I_GBS, I_ONA, I_ONB, I_WOUT, I_N2G, I_WG, I_WU, I_WD, I_FING };

struct Ctx {
    int tid, lane, wave, wg, nwg, gw, ngw, gtid, ngt;
    LAS unsigned char* lds;
};

__device__ __forceinline__ void bucket_experts(int bkt, int& e0, int& e1) {
    const int grp = bkt / 6, pi = bkt % 6;
    const int pa = (pi >= 3) + (pi >= 5);
    const int pb = pi + 1 - (pa == 0 ? 0 : (pa == 1 ? 2 : 3));
    e0 = grp * 4 + pa; e1 = grp * 4 + pb;
}
__device__ __forceinline__ float rstd_from16(const float* ssq, int t) {
    const f32x4* p = (const f32x4*)(ssq + (size_t)t * 16);
    const f32x4 a = p[0], b = p[1], c = p[2], d = p[3];
    const float s = ((a.x + a.y) + (a.z + a.w)) + ((b.x + b.y) + (b.z + b.w)) + ((c.x + c.y) + (c.z + c.w)) + ((d.x + d.y) + (d.z + d.w));
    return rsqrtf(s * (1.0f / 1024.0f) + EPS);
}

__device__ __forceinline__ void tr_item(const float* W, int ldw, int k0, int n0, bf16* WT, int ldt, int drow0, const float* kscale, float nscale, LAS float* scr, int lane) {
    {
        f32x4 v[8];
#pragma unroll
        for (int j = 0; j < 8; ++j) v[j] = __builtin_nontemporal_load((const f32x4*)&W[(size_t)(k0 + 8 * j + (lane >> 3)) * ldw + n0 + (lane & 7) * 4]);
#pragma unroll
        for (int j = 0; j < 8; ++j) { const int kk = 8 * j + (lane >> 3); const float sc = (kscale ? kscale[k0 + kk] : 1.0f) * nscale; LAS float* d = scr + kk * 33 + (lane & 7) * 4;
            d[0] = v[j][0] * sc; d[1] = v[j][1] * sc; d[2] = v[j][2] * sc; d[3] = v[j][3] * sc; }
    }
    LDS_WAIT(); asm volatile("" ::: "memory");
    const int c = lane & 7;
#pragma unroll
    for (int j = 0; j < 4; ++j) {
        const int n = (lane >> 3) + 8 * j; const LAS float* s = scr + (8 * c) * 33 + n;
        u32x4 o; o.x = pk2(s[0 * 33], s[1 * 33]); o.y = pk2(s[2 * 33], s[3 * 33]); o.z = pk2(s[4 * 33], s[5 * 33]); o.w = pk2(s[6 * 33], s[7 * 33]);
        __builtin_nontemporal_store(o, (u32x4*)(WT + (size_t)(drow0 + n) * ldt + k0 + 8 * c));
    }
    LDS_WAIT(); asm volatile("" ::: "memory");
}
__device__ __forceinline__ void conv_wdown(const Args& a, const Ctx& c) {
    LAS float* scr = (LAS float*)(c.lds + c.wave * 8704);
    bf16* wd = (bf16*)(a.ws + WS_WD);
    for (int it = c.gw; it < DEPTH * NE * 256; it += c.ngw) {
        const int le = it >> 8, q = it & 255, kb = q / 32, nb = q % 32;
        tr_item(a.in[I_WD] + (size_t)le * 512 * 1024, 1024, kb * 64, nb * 32, wd + (size_t)le * 1024 * 512, 512, nb * 32, nullptr, 1.0f, scr, c.lane);
    }
}
__device__ __forceinline__ void conv_panel_item(const float* W, int ldw, int n0, bf16* WT, int drow0, float nscale, const float* sh, float* out, int ob, LAS unsigned char* lds, int wave, int lane, int tid, bool nts) {
    LAS float* scr = (LAS float*)(lds + wave * 12800); LAS float* shl = (LAS float*)(lds + wave * 12800 + 8704);
    LAS float* red = (LAS float*)(lds + 8 * 12800);
    const int kbase = wave * 128;
#pragma unroll
    for (int i = 0; i < 16; ++i) { const int id = lane + 64 * i, b = id >> 7, kk = id & 127; shl[id] = sh[b * 6144 + kbase + kk]; }
    const int n = lane & 31, bh = lane >> 5;
    float acc[4] = {0.f, 0.f, 0.f, 0.f};
#pragma unroll 1
    for (int tI = 0; tI < 2; ++tI) {
        const int k0 = kbase + 64 * tI;
        {
            f32x4 v[8];
#pragma unroll
            for (int j = 0; j < 8; ++j) v[j] = __builtin_nontemporal_load((const f32x4*)&W[(size_t)(k0 + 8 * j + (lane >> 3)) * ldw + n0 + (lane & 7) * 4]);
#pragma unroll
            for (int j = 0; j < 8; ++j) { LAS float* d = scr + (8 * j + (lane >> 3)) * 33 + (lane & 7) * 4; d[0] = v[j][0] * nscale; d[1] = v[j][1] * nscale; d[2] = v[j][2] * nscale; d[3] = v[j][3] * nscale; }
        }
        LDS_WAIT(); asm volatile("" ::: "memory");
        const int cc = lane & 7;
#pragma unroll
        for (int j = 0; j < 4; ++j) {
            const int nn = (lane >> 3) + 8 * j; const LAS float* s = scr + (8 * cc) * 33 + nn;
            u32x4 o; o.x = pk2(s[0 * 33], s[1 * 33]); o.y = pk2(s[2 * 33], s[3 * 33]); o.z = pk2(s[4 * 33], s[5 * 33]); o.w = pk2(s[6 * 33], s[7 * 33]);
            if (nts) __builtin_nontemporal_store(o, (u32x4*)(WT + (size_t)(drow0 + nn) * 1024 + k0 + 8 * cc)); else *(u32x4*)(WT + (size_t)(drow0 + nn) * 1024 + k0 + 8 * cc) = o;
        }
#pragma unroll 4
        for (int k4 = 0; k4 < 64; k4 += 4) {
            const float v0 = scr[(k4 + 0) * 33 + n], v1 = scr[(k4 + 1) * 33 + n], v2 = scr[(k4 + 2) * 33 + n], v3 = scr[(k4 + 3) * 33 + n];
#pragma unroll
            for (int i = 0; i < 4; ++i) { const f32x4 s4 = *(const LAS f32x4*)(shl + (4 * bh + i) * 128 + 64 * tI + k4); acc[i] += (s4.x * v0 + s4.y * v1) + (s4.z * v2 + s4.w * v3); }
        }
        LDS_WAIT(); asm volatile("" ::: "memory");
    }
#pragma unroll
    for (int i = 0; i < 4; ++i) red[(wave * 8 + 4 * bh + i) * 32 + n] = acc[i];
    __syncthreads();
    if (tid < 256) { const int b = tid >> 5, nn = tid & 31; float s = 0.f;
#pragma unroll
        for (int w = 0; w < 8; ++w) s += red[(w * 8 + b) * 32 + nn];
        out[(size_t)b * ob + nn] = s; }
    __syncthreads();
}
template <class SH>
__device__ __forceinline__ void bias_item(const float* Wc, int ldw, const SH* sh, int shs, float* out, int ob, float scale, const float* addv, LAS float* red, int tid) {
    const int c4 = tid & 15, kc = tid >> 4;
    f32x4 acc[8];
#pragma unroll
    for (int b = 0; b < 8; ++b) acc[b] = (f32x4){0.f, 0.f, 0.f, 0.f};
#pragma unroll 1
    for (int k0 = kc * 32; k0 < kc * 32 + 32; k0 += 16) {
        f32x4 w[16];
#pragma unroll
        for (int u = 0; u < 16; ++u) w[u] = __builtin_nontemporal_load((const f32x4*)&Wc[(size_t)(k0 + u) * ldw + c4 * 4]);
#pragma unroll
        for (int u = 0; u < 16; ++u)
#pragma unroll
            for (int b = 0; b < 8; ++b) acc[b] = acc[b] + w[u] * (float)sh[b * shs + k0 + u];
    }
#pragma unroll
    for (int b = 0; b < 8; ++b) *(LAS f32x4*)(red + (kc * 8 + b) * 64 + c4 * 4) = acc[b];
    __syncthreads();
    {
        const int b = tid >> 6, nn = tid & 63; float s = 0.f;
#pragma unroll
        for (int k2 = 0; k2 < 32; ++k2) s += red[(k2 * 8 + b) * 64 + nn];
        __hip_atomic_store(out + (size_t)b * ob + nn, s * scale + (addv ? addv[nn] : 0.f), __ATOMIC_RELAXED, __HIP_MEMORY_SCOPE_AGENT);
    }
    __syncthreads();
}
__device__ __forceinline__ void phase_p0a(const Args& a, const Ctx& c) {
    float* modv = (float*)(a.ws + WS_SMALL + SO_MODV);
    if (c.wg < 192) {
        LAS float* cact = (LAS float*)(c.lds + 65536);
        for (int i = c.tid; i < 8 * 1024; i += NTHREADS) cact[i] = silu_f(a.in[I_C][i]);
        __syncthreads();
        const int l = c.wg / 96, j0 = (c.wg % 96) * 64;
        bias_item(a.in[I_MODW] + (size_t)l * 1024 * 6144 + j0, 6144, cact, 1024, modv + (size_t)l * 8 * 6144 + j0, 6144, 1.0f, a.in[I_MODB] + l * 6144 + j0, (LAS float*)c.lds, c.tid);
        asm volatile("s_waitcnt vmcnt(0)" ::: "memory");
        __syncthreads();
        if (c.tid == 0) __hip_atomic_fetch_add((unsigned*)(a.ws + WS_CTL) + CW_MOD, 1u, __ATOMIC_RELAXED, __HIP_MEMORY_SCOPE_AGENT);
    }
    {
        bf16* rwt = (bf16*)(a.ws + WS_SMALL + SO_RWT);
        for (int i = c.gtid; i < 16 * 1024; i += c.ngt) { const int e = i >> 10, kk = i & 1023; rwt[i] = (bf16)f2bf(a.in[I_RW][kk * 16 + e]); }
    }
    LAS float* scr = (LAS float*)(c.lds + c.wave * 8704);
    {
        bf16* wtout = (bf16*)(a.ws + WS_WOUT);
        for (int it = c.gw; it < DEPTH * 512; it += c.ngw) {
            const int l = it >> 9, q = it & 511, kb = q / 32, nb = q % 32, k0 = kb * 64;
            const float* ks = (k0 < 512) ? (a.in[I_ONA] + l * 512) : (a.in[I_ONB] + l * 512 - 512);
            tr_item(a.in[I_WOUT] + (size_t)l * 1024 * 1024, 1024, k0, nb * 32, wtout + (size_t)l * 1024 * 1024, 1024, nb * 32, ks, 1.0f, scr, c.lane);
        }
    }
    {
        bf16* ws = (bf16*)(a.ws + WS_WS); const float* g = a.in[I_GWS];
        for (int i = c.gtid; i < DEPTH * 8 * 128 * 128; i += c.ngt) {
            const int col = i & 127, t = (i >> 7) & 127, ks = col >> 4, hh = (col >> 3) & 1, jj = col & 7, s = 16 * ks + 8 * (jj >> 2) + 4 * hh + (jj & 3);
            ws[i] = (bf16)f2bf(s <= t ? g[(i & ~127) + s] : 0.f);
        }
    }
    conv_wdown(a, c);
}

__device__ __forceinline__ void phase_p0b(const Args& a, const Ctx& c) {
    {
        unsigned* w = (unsigned*)(a.ws + WS_CTL) + CW_MOD; unsigned* tmo = (unsigned*)(a.ws + WS_CTL) + CW_TMO;
        if (c.tid < 64) {
            unsigned sp = 0;
            while ((unsigned)__builtin_amdgcn_readfirstlane(__hip_atomic_load(w, __ATOMIC_RELAXED, __HIP_MEMORY_SCOPE_AGENT)) < 192u) {
                __builtin_amdgcn_s_sleep(2);
                if ((++sp & 255u) == 0u) { if (__builtin_amdgcn_readfirstlane(__hip_atomic_load(tmo, __ATOMIC_RELAXED, __HIP_MEMORY_SCOPE_AGENT)) != 0u) break;
                    if (sp > (1u << 20)) { if (c.lane == 0) __hip_atomic_store(tmo, 0x11u, __ATOMIC_RELAXED, __HIP_MEMORY_SCOPE_AGENT); break; } }
            }
            __builtin_amdgcn_fence(__ATOMIC_ACQUIRE, "agent");
            asm volatile("s_waitcnt vmcnt(0)" ::: "memory");
        }
        __syncthreads();
    }
    const float* modv = (const float*)(a.ws + WS_SMALL + SO_MODV);
    float* G1 = (float*)(a.ws + WS_SMALL + SO_G1); float* G2 = (float*)(a.ws + WS_SMALL + SO_G2);
    for (int i = c.gtid; i < DEPTH * BATCH * 1024; i += c.ngt) {
        const int k = i & 1023, lb = i >> 10, l = lb / BATCH;
        G1[i] = a.in[I_N1G][l * 1024 + k] * (1.0f + modv[(size_t)lb * 6144 + 1024 + k]);
        G2[i] = a.in[I_N2G][l * 1024 + k] * (1.0f + modv[(size_t)lb * 6144 + 4096 + k]);
    }
    {
        float* rb = (float*)(a.ws + WS_SMALL + SO_RBIAS);
        for (int i = c.gw; i < DEPTH * BATCH * 16; i += c.ngw) {
            const int e = i & 15, lb = i >> 4; const float* sh = modv + (size_t)lb * 6144 + 3072; float acc = 0.f;
#pragma unroll
            for (int j = 0; j < 16; ++j) { const int kk = c.lane + 64 * j; acc += sh[kk] * a.in[I_RW][kk * 16 + e]; }
            acc = wave_sum(acc);
            if (c.lane == 0) rb[i] = acc;
        }
    }
    {
        float* bias1 = (float*)(a.ws + WS_SMALL + SO_BIAS1); float* biasgu = (float*)(a.ws + WS_SMALL + SO_BIASGU);
        bf16* wtin = (bf16*)(a.ws + WS_WIN); bf16* wgu = (bf16*)(a.ws + WS_WGU);
        for (int it = c.wg; it < 160 + 1024; it += c.nwg) {
            if (it < 160) {
                const int l = it / 80, n0 = (it % 80) * 32; const float sc = (n0 >= 1024 && n0 < 1536) ? C2 : 1.0f;
                conv_panel_item(a.in[I_WIN] + (size_t)l * 1024 * INC, INC, n0, wtin + (size_t)l * INC * 1024, n0, sc, modv + (size_t)l * 8 * 6144, bias1 + (size_t)l * 8 * INC + n0, INC, c.lds, c.wave, c.lane, c.tid, l != 0);
            } else {
                const int r = it - 160, le = r >> 5, q = r & 31, half = q >> 4, nb = q & 15, n0 = nb * 32, l = le >> 4, e = le & 15;
                const float* W = (half ? a.in[I_WU] : a.in[I_WG]) + (size_t)le * 1024 * 512;
                const int drow0 = (n0 / 128) * 256 + (n0 % 128) + half * 128;
                conv_panel_item(W, 512, n0, wgu + (size_t)le * 1024 * 1024, drow0, 1.0f, modv + (size_t)l * 8 * 6144 + 3072, biasgu + ((size_t)l * 8 * 16 + e) * 1024 + drow0, 16 * 1024, c.lds, c.wave, c.lane, c.tid, true);
            }
        }
    }
    {
        bf16* A1 = (bf16*)(a.ws + WS_ACTX); float* ssq = (float*)(a.ws + WS_SMALL + SO_SSQA);
        const float* x = a.in[I_X];
        for (int t = c.gw; t < T; t += c.ngw) {
            const int b = t / SEQ; float s = 0.f;
            const f32x4* xr = (const f32x4*)(x + (size_t)t * 1024);
#pragma unroll
            for (int j = 0; j < 4; ++j) {
                const int kk = (c.lane + 64 * j) * 4; const f32x4 v = __builtin_nontemporal_load(&xr[c.lane + 64 * j]);
                s += (v.x * v.x + v.y * v.y) + (v.z * v.z + v.w * v.w);
                const f32x4 ng = *(const f32x4*)(a.in[I_N1G] + kk), sc = *(const f32x4*)(modv + (size_t)b * 6144 + 1024 + kk);
                uint2 o; o.x = pk2(v.x * ng.x * (1.0f + sc.x), v.y * ng.y * (1.0f + sc.y)); o.y = pk2(v.z * ng.z * (1.0f + sc.z), v.w * ng.w * (1.0f + sc.w));
                *(uint2*)(A1 + (size_t)t * 1024 + kk) = o;
            }
            s = wave_sum(s);
            if (c.lane < 16) ssq[(size_t)t * 16 + c.lane] = (c.lane == 0) ? s : 0.f;
            if (c.lane == 0) ((int*)(a.ws + WS_SMALL + SO_ROWX))[t] = t;
        }
    }
}

__device__ __forceinline__ void route_tokens(const Args& a, const Ctx& c, int l, int cslot, int tbase, int nw) {
    const bf16* A2 = (const bf16*)(a.ws + WS_ACTX); const bf16* rwt = (const bf16*)(a.ws + WS_SMALL + SO_RWT);
    const float* ssq = (const float*)(a.ws + WS_SMALL + SO_SSQB); const float* rbias = (const float*)(a.ws + WS_SMALL + SO_RBIAS) + l * 8 * 16;
    float* gates = (float*)(a.ws + WS_SMALL + SO_GATES); int* tokl = (int*)(a.ws + WS_SMALL + SO_TOKL);
    unsigned* cnt = (unsigned*)(a.ws + WS_CTL) + CW_CNT + cslot * 32; const float* rb = a.in[I_RB];
    const int fr = c.lane & 15, fq = c.lane >> 4;
    LAS unsigned* hist = (LAS unsigned*)(c.lds + 131072 + 1024); LAS unsigned* base = (LAS unsigned*)(c.lds + 131072 + 1024 + 128);
    {
        if (c.tid < 32) hist[c.tid] = 0u;
        for (int i0 = c.tid; i0 < nw * 16 * 128; i0 += 8 * NTHREADS) {
            u32x4 rr[8];
#pragma unroll
            for (int j = 0; j < 8; ++j) { const int i = i0 + j * NTHREADS, row = i >> 7, ch = i & 127; rr[j] = *(const u32x4*)(A2 + (size_t)(tbase + row) * 1024 + ch * 8); }
#pragma unroll
            for (int j = 0; j < 8; ++j) { const int i = i0 + j * NTHREADS, row = i >> 7, ch = i & 127; *(LAS u32x4*)(c.lds + row * 2048 + ((ch ^ (row & 15)) << 4)) = rr[j]; }
        }
        __syncthreads();
        const bool act = c.wave < nw;
        const int rloc = (act ? c.wave : 0) * 16 + fr, t = tbase + rloc, b = t >> 11;
        const LAS unsigned char* arow = c.lds + rloc * 2048; const bf16* wrow = rwt + fr * 1024 + 8 * fq;
        f32x4 acc = {0.f, 0.f, 0.f, 0.f};
#pragma unroll 16
        for (int k0 = 0; k0 < 1024; k0 += 32) acc = __builtin_amdgcn_mfma_f32_16x16x32_bf16(*(const bf16x8*)(wrow + k0), *(const LAS bf16x8*)(arow + ((((k0 >> 3) + fq) ^ (rloc & 15)) << 4)), acc, 0, 0, 0);
        const float rs = rstd_from16(ssq, t);
        float lg[4], p[4], sel[4];
#pragma unroll
        for (int j = 0; j < 4; ++j) lg[j] = rs * acc[j] + rbias[b * 16 + 4 * fq + j];
        float mx = fmaxf(fmaxf(lg[0], lg[1]), fmaxf(lg[2], lg[3]));
        mx = rows_max(mx);
        float ps = 0.f;
#pragma unroll
        for (int j = 0; j < 4; ++j) { p[j] = __expf(lg[j] - mx); ps += p[j]; }
        ps = rows_sum(ps);
        const float inv = 1.0f / ps;
#pragma unroll
        for (int j = 0; j < 4; ++j) { p[j] *= inv; sel[j] = p[j] + rb[4 * fq + j]; }
        float m1 = -INFINITY, m2 = -INFINITY;
#pragma unroll
        for (int j = 0; j < 4; ++j) { const float v = sel[j]; if (v > m1) { m2 = m1; m1 = v; } else if (v > m2) { m2 = v; } }
        const float gs = m1 + m2;
        int best = 0; float bests = __shfl(gs, fr);
#pragma unroll
        for (int gg = 1; gg < 4; ++gg) { const float o = __shfl(gs, fr + 16 * gg); if (o > bests) { bests = o; best = gg; } }
        int bkt = 0; unsigned rank = 0u; float ga = 0.f, gb = 0.f;
        const bool win = act && (fq == best);
        if (win) {
            int i1 = 0; float v1 = sel[0];
            if (sel[1] > v1) { v1 = sel[1]; i1 = 1; } if (sel[2] > v1) { v1 = sel[2]; i1 = 2; } if (sel[3] > v1) { v1 = sel[3]; i1 = 3; }
            int i2 = -1; float v2 = -INFINITY;
            if (i1 != 0 && sel[0] > v2) { v2 = sel[0]; i2 = 0; } if (i1 != 1 && sel[1] > v2) { v2 = sel[1]; i2 = 1; } if (i1 != 2 && sel[2] > v2) { v2 = sel[2]; i2 = 2; } if (i1 != 3 && sel[3] > v2) { v2 = sel[3]; i2 = 3; }
            const int ea = min(i1, i2), eb = max(i1, i2);
            const float pa = (ea == 0) ? p[0] : (ea == 1) ? p[1] : (ea == 2) ? p[2] : p[3];
            const float pb = (eb == 0) ? p[0] : (eb == 1) ? p[1] : (eb == 2) ? p[2] : p[3];
            const int pi = (ea == 0) ? (eb - 1) : (ea == 1) ? (eb + 1) : 5;
            bkt = best * 6 + pi; ga = pa / (pa + pb); gb = pb / (pa + pb);
            rank = atomicAdd((unsigned*)(hist + bkt), 1u);
        }
        __syncthreads();
        if (c.tid < NBKT) { const unsigned n = hist[c.tid]; base[c.tid] = n ? atomicAdd(&cnt[c.tid], n) : 0u; }
        __syncthreads();
        if (win) {
            const unsigned pos = base[bkt] + rank;
            tokl[bkt * TOKCAP + (int)pos] = t;
            gates[(size_t)t * 2] = ga; gates[(size_t)t * 2 + 1] = gb;
        }
        __syncthreads();
    }
}

__device__ __forceinline__ void phase_p6(const Args& a, const Ctx& c) {
    const float* ssq = (const float*)(a.ws + WS_SMALL + SO_SSQA); const float* fg = a.in[I_FING];
    const int* rowx = (const int*)(a.ws + WS_SMALL + SO_ROWX); const bf16* x2b = (const bf16*)(a.ws + WS_X2B);
    for (int t = c.gw; t < T; t += c.ngw) {
        const int r = rowx[t]; const float rs = rstd_from16(ssq, t);
        const uint2* xr = (const uint2*)(x2b + (size_t)r * 1024); f32x4* orow = (f32x4*)(a.out + (size_t)t * 1024);
#pragma unroll
        for (int j = 0; j < 4; ++j) {
            typedef unsigned u32x2 __attribute__((ext_vector_type(2)));
            const u32x2 rw = __builtin_nontemporal_load((const u32x2*)&xr[c.lane + 64 * j]); uint2 raw; raw.x = rw.x; raw.y = rw.y; const f32x4 g = ((const f32x4*)fg)[c.lane + 64 * j];
            f32x4 v; v.x = __uint_as_float(raw.x << 16) * rs * g.x; v.y = __uint_as_float(raw.x & 0xffff0000u) * rs * g.y; v.z = __uint_as_float(raw.y << 16) * rs * g.z; v.w = __uint_as_float(raw.y & 0xffff0000u) * rs * g.w;
            __builtin_nontemporal_store(v, &orow[c.lane + 64 * j]);
        }
    }
}

namespace mm {
constexpr int BM = 256, BK = 64, HALF = 128, HTB = HALF * BK * 2, STAGE_BYTES = 8 * HTB;
__device__ __forceinline__ int lds_byte(int r, int c) { const int st = (r >> 4) * 2 + (c >> 5), rr = r & 15, cc = c & 31, ob = rr * 64 + cc * 2; return st * 1024 + (ob ^ (((ob >> 9) & 1) << 5)); }
__device__ __forceinline__ void stage_rc(int b, int& R, int& C) { const int st = b / 1024, sb = b % 1024, swz = sb ^ (((sb >> 9) & 1) << 5); R = (st >> 1) * 16 + swz / 64; C = (st & 1) * 32 + (swz % 64) / 2; }
__device__ __forceinline__ int perm32(int rho) { const int n = rho >> 4, i = rho & 15; return 8 * (i >> 2) + 4 * n + (i & 3); }
__device__ __forceinline__ int xcd_remap(int L, int nU) { const int q = nU / 8, r = nU % 8, xcd = L % 8, off = L / 8; return (xcd < r ? xcd * (q + 1) : r * (q + 1) + (xcd - r) * q) + off; }

constexpr int SIDE_OFF = 146432;
constexpr int TAB_OFF = 131072;
struct MUnit { const char* A; const char* B; int first, last; int i0, i1, i2, i3, i4, i5; };

__device__ __forceinline__ unsigned cvt_pk_bf16(float lo, float hi) { unsigned r; asm volatile("v_cvt_pk_bf16_f32 %0, %1, %2" : "=v"(r) : "v"(lo), "v"(hi)); return r; }
typedef float f32x2 __attribute__((ext_vector_type(2)));
__device__ __forceinline__ f32x2 gelu_pk(f32x2 v) {
    f32x2 c; c.x = __builtin_amdgcn_fmed3f(v.x, -4.25f, 4.25f); c.y = __builtin_amdgcn_fmed3f(v.y, -4.25f, 4.25f);
    const f32x2 u = c * c;
    f32x2 q = u * (-8.460361597e-10f) + 7.570799355e-08f;
    q = q * u + (-2.938792968e-06f); q = q * u + 6.552695497e-05f; q = q * u + (-9.404465092e-04f); q = q * u + 9.257818770e-03f; q = q * u + (-6.545349156e-02f); q = q * u + 3.984200383e-01f;
    const f32x2 ph = c * q + 0.5f;
    return v * ph;
}

template <class Epi, class Sched, bool GATHER>
__device__ __forceinline__ void mm_phase(LAS unsigned char* lds, const Sched& S, const Epi& E, const int tid) {
    const int wid = __builtin_amdgcn_readfirstlane(tid >> 6), lane = tid & 63, wr = wid >> 2, wc = wid & 3, fr = lane & 15, fq = lane >> 4;
    const int nt = S.nt; const unsigned lda = S.lda, ldb = S.ldb;
    int Rr[2], Cc;
    unsigned voffA[2], voffB[2];
#pragma unroll
    for (int i = 0; i < 2; ++i) { int R, C; stage_rc(tid * 16 + i * 8192, R, C); const int Rb = Epi::PERM ? ((R & ~31) + perm32(R & 31)) : R;
        Rr[i] = R; Cc = C; voffA[i] = (unsigned)R * lda + (unsigned)C * 2u; voffB[i] = (unsigned)Rb * ldb + (unsigned)C * 2u; }
    const size_t kstep = (size_t)(BK * 2);
    const size_t hstepA = (size_t)HALF * lda, hstepB = (size_t)HALF * ldb;
    const unsigned ldsw = (unsigned)wid * 1024u;
    const int aoff = lds_byte(wr * 64 + fr, fq * 8), boff = lds_byte(wc * 32 + fr, fq * 8);
#define MM_SA(b, h) (((b) * 2 + (h)) * HTB)
#define MM_SB(b, h) ((4 + (b) * 2 + (h)) * HTB)
#define MM_STAGE_B(bufoff, gbase) do { _Pragma("unroll") for (int _i = 0; _i < 2; ++_i) \
        __builtin_amdgcn_global_load_lds((const unsigned*)((const char*)(gbase) + voffB[_i]), (LAS unsigned*)(lds + (bufoff) + ldsw + _i * 8192), 16, 0, 0); } while (0)
#define MM_STAGE_A(bufoff, nx, h, koff) do { \
        const char* gb_ = GATHER ? (cA + (koff)) : (((nx) ? nA : cA) + (size_t)(h) * hstepA + (koff)); \
        _Pragma("unroll") for (int _i = 0; _i < 2; ++_i) { \
            unsigned vo_ = GATHER ? vAc[h][_i] : voffA[_i]; \
            if (GATHER) { if (nx) vo_ = S.gather1(nslot, (h) * 128 + Rr[_i], Cc, lds); } \
            __builtin_amdgcn_global_load_lds((const unsigned*)(gb_ + vo_), (LAS unsigned*)(lds + (bufoff) + ldsw + _i * 8192), 16, 0, 0); } } while (0)
#define MM_LDA(dst, b, h) do { _Pragma("unroll") for (int m = 0; m < 4; ++m) _Pragma("unroll") for (int k = 0; k < 2; ++k) dst[m][k] = *(const LAS bf16x8*)(lds + MM_SA(b, h) + aoff + m * 2048 + k * 1024); } while (0)
#define MM_LDB(dst, b, h) do { _Pragma("unroll") for (int n = 0; n < 2; ++n) _Pragma("unroll") for (int k = 0; k < 2; ++k) dst[n][k] = *(const LAS bf16x8*)(lds + MM_SB(b, h) + boff + n * 2048 + k * 1024); } while (0)
#define MM_MMA(ai, bj, At, Bt) do { __builtin_amdgcn_s_setprio(1); _Pragma("unroll") for (int m = 0; m < 4; ++m) _Pragma("unroll") for (int n = 0; n < 2; ++n) _Pragma("unroll") for (int k = 0; k < 2; ++k) \
        acc[ai][bj][m][n] = __builtin_amdgcn_mfma_f32_16x16x32_bf16(Bt[n][k], At[m][k], acc[ai][bj][m][n], 0, 0, 0); __builtin_amdgcn_s_setprio(0); } while (0)
#define MM_WAIT_V(n) asm volatile("s_waitcnt vmcnt(" #n ")" ::: "memory")
#define MM_WAIT_L(n) asm volatile("s_waitcnt lgkmcnt(" #n ")" ::: "memory")
#define MM_BAR __builtin_amdgcn_s_barrier()
#define MM_SCHED __builtin_amdgcn_sched_barrier(0)
#define MM_ZERO() do { _Pragma("unroll") for (int a_ = 0; a_ < 2; ++a_) _Pragma("unroll") for (int b_ = 0; b_ < 2; ++b_) _Pragma("unroll") for (int m_ = 0; m_ < 4; ++m_) _Pragma("unroll") for (int n_ = 0; n_ < 2; ++n_) \
        acc[a_][b_][m_][n_] = (f32x4){0.f, 0.f, 0.f, 0.f}; } while (0)
    MUnit cur, nxt; int ui = 0;
    if (!S.next(0, cur)) return;
    f32x4 acc[2][2][4][2];
    MM_ZERO();
    bf16x8 At[4][2], B0[2][2], B1[2][2];
    unsigned vAc[2][2]; int nslot = 0;
    if constexpr (GATHER) { S.gather(0, Rr, Cc, vAc, lds); }
    else {
#pragma unroll
        for (int h = 0; h < 2; ++h)
#pragma unroll
            for (int i = 0; i < 2; ++i) vAc[h][i] = 0u;
    }
    const char* cA = cur.A; const char* cB = cur.B;
    const char* nA = cA;
    MM_STAGE_B(MM_SB(0, 0), cB); MM_STAGE_B(MM_SB(0, 1), cB + hstepB); MM_STAGE_A(MM_SA(0, 0), false, 0, 0); MM_STAGE_A(MM_SA(0, 1), false, 1, 0);
    if (wr == 1) MM_BAR;
    MM_WAIT_V(2); MM_BAR;
    MM_STAGE_B(MM_SB(1, 0), cB + kstep); MM_STAGE_A(MM_SA(1, 0), false, 0, kstep); MM_STAGE_B(MM_SB(1, 1), cB + hstepB + kstep);
    MM_WAIT_V(6); MM_BAR;
    for (;;) {
        const bool has_next = S.next(ui + 1, nxt);
        nA = has_next ? nxt.A : cA; const char* nB = has_next ? nxt.B : cB;
        nslot = has_next ? ui + 1 : ui;
        for (int t = 0; t < nt; t += 2) {
            const bool last = (t == nt - 2);
            const size_t k1 = (size_t)(t + 1) * kstep;
            const size_t k2 = last ? 0 : (size_t)(t + 2) * kstep;
            const size_t k3 = k2 + kstep;
            const char* b2 = (last ? nB : cB) + k2; const char* b3 = b2 + kstep;
            MM_LDB(B0, 0, 0); MM_LDB(B1, 0, 1); MM_SCHED; MM_LDA(At, 0, 0); MM_STAGE_A(MM_SA(1, 1), false, 1, k1);
            MM_WAIT_V(8); MM_WAIT_L(0); MM_BAR; MM_MMA(0, 0, At, B0); MM_MMA(0, 1, At, B1); MM_BAR; MM_SCHED;
            MM_LDA(At, 0, 1); MM_STAGE_B(MM_SB(0, 0), b2); MM_STAGE_B(MM_SB(0, 1), b2 + hstepB); MM_STAGE_A(MM_SA(0, 0), last, 0, k2);
            MM_WAIT_V(8); MM_WAIT_L(0); MM_BAR; MM_MMA(1, 0, At, B0); MM_MMA(1, 1, At, B1); MM_BAR; MM_SCHED;
            MM_LDB(B0, 1, 0); MM_LDB(B1, 1, 1); MM_SCHED; MM_LDA(At, 1, 0); MM_STAGE_A(MM_SA(0, 1), last, 1, k2);
            MM_WAIT_V(8); MM_WAIT_L(0); MM_BAR; MM_MMA(0, 0, At, B0); MM_MMA(0, 1, At, B1); MM_BAR; MM_SCHED;
            MM_LDA(At, 1, 1); MM_STAGE_B(MM_SB(1, 0), b3); MM_STAGE_B(MM_SB(1, 1), b3 + hstepB); MM_STAGE_A(MM_SA(1, 0), last, 0, k3);
            MM_WAIT_V(8); MM_WAIT_L(0); MM_BAR; MM_MMA(1, 0, At, B0); MM_MMA(1, 1, At, B1); MM_BAR; MM_SCHED;
        }
        const bool epi = cur.last != 0;
        int fr_ = fr, fq_ = fq, wr_ = wr, wc_ = wc; asm volatile("" : "+v"(fr_), "+v"(fq_), "+s"(wr_), "+s"(wc_));
        if constexpr (Epi::HAS_MID) E.mid(acc, ui, epi, wr_, fr_, lds);
        if (epi) { if (wr == 0) MM_BAR; E(acc, cur, ui, wr_, wc_, fr_, fq_, lds);
#if EPI_TWICE
            E(acc, cur, ui, wr_, wc_, fr_, fq_, lds);
#endif
        }
        if (!has_next) break;
        if (nxt.first) MM_ZERO();
        cur = nxt; cA = nA; cB = nB; ++ui;
        if constexpr (GATHER) { S.gather(ui, Rr, Cc, vAc, lds); }
        if (epi) { if (wr == 1) MM_BAR; }
    }
    MM_WAIT_V(0);
    MM_BAR;
#undef MM_SA
#undef MM_SB
#undef MM_STAGE_A
#undef MM_STAGE_B
#undef MM_LDA
#undef MM_LDB
#undef MM_MMA
#undef MM_WAIT_V
#undef MM_WAIT_L
#undef MM_BAR
#undef MM_SCHED
#undef MM_ZERO
}

struct SchedDense {
    const char* A; const char* B; int nM, nN, nU, G, c, nt; unsigned lda, ldb;
    __device__ __forceinline__ bool next(int i, MUnit& u) const {
        const int L = i * G + c; if (L >= nU) return false;
        const int wgid = xcd_remap(L, nU);
        const int nig = 8 * nN, gid = wgid / nig, fm = gid * 8, gsz = (nM - fm) < 8 ? (nM - fm) : 8;
        const int pm = fm + ((wgid % nig) % gsz), pn = (wgid % nig) / gsz;
        u.A = A + (size_t)pm * 256 * lda; u.B = B + (size_t)pn * 256 * ldb; u.first = 1; u.last = 1; u.i0 = pm; u.i1 = pn; u.i2 = 0; u.i3 = 0; u.i4 = 0; u.i5 = 0;
        return true;
    }
    __device__ __forceinline__ void gather(int, const int (&)[2], int, unsigned (&)[2][2], LAS unsigned char*) const {}
    __device__ __forceinline__ unsigned gather1(int, int, int, LAS unsigned char*) const { return 0u; }
};
struct SchedP1 {
    const char* A; const char* B; int nM, nN, nU, G, c, nt; unsigned lda, ldb;
    __device__ __forceinline__ bool next(int i, MUnit& u) const {
        const int L = i * G + c; if (L >= nU) return false;
        const int wgid = xcd_remap(L, nU);
        const int nig = 8 * nN, gid = wgid / nig, fm = gid * 8, gsz = (nM - fm) < 8 ? (nM - fm) : 8;
        const int pm = fm + ((wgid % nig) % gsz), pn = (wgid % nig) / gsz;
        u.A = A; u.B = B + (size_t)pn * 256 * ldb; u.first = 1; u.last = 1; u.i0 = pm; u.i1 = pn; u.i2 = 0; u.i3 = 0; u.i4 = 0; u.i5 = 0;
        return true;
    }
    __device__ __forceinline__ void gather(int slot, const int (&Rr)[2], int Cc, unsigned (&v)[2][2], LAS unsigned char* lds) const {
        const LAS int* tk = (const LAS int*)(lds + TAB_OFF + slot * 3072);
#pragma unroll
        for (int h = 0; h < 2; ++h)
#pragma unroll
            for (int i = 0; i < 2; ++i) v[h][i] = (unsigned)tk[h * 128 + Rr[i]] * 2048u + (unsigned)Cc * 2u;
    }
    __device__ __forceinline__ unsigned gather1(int slot, int row, int Cc, LAS unsigned char* lds) const {
        return (unsigned)((const LAS int*)(lds + TAB_OFF + slot * 3072))[row] * 2048u + (unsigned)Cc * 2u;
    }
};
struct SchedP3 {
    const char* A; const char* B; int nM, nN, nU, G, c, nt; unsigned lda, ldb;
    __device__ __forceinline__ bool next(int i, MUnit& u) const {
        const int L = (i >> 1) * G + c, sub = i & 1; if (L >= nU) return false;
        const int wgid = xcd_remap(L, nU);
        const int nig = 8 * nN, gid = wgid / nig, fm = gid * 8, gsz = (nM - fm) < 8 ? (nM - fm) : 8;
        const int pm = fm + ((wgid % nig) % gsz), pn = (wgid % nig) / gsz;
        u.A = A + (size_t)pm * 256 * lda + sub * 1024; u.B = B + (size_t)pn * 256 * ldb + sub * 1024; u.first = (sub == 0); u.last = (sub == 1); u.i0 = pm; u.i1 = pn; u.i2 = 0; u.i3 = 0; u.i4 = 0; u.i5 = 0;
        return true;
    }
    __device__ __forceinline__ void gather(int, const int (&)[2], int, unsigned (&)[2][2], LAS unsigned char*) const {}
    __device__ __forceinline__ unsigned gather1(int, int, int, LAS unsigned char*) const { return 0u; }
};
struct SchedP4 {
    const int* tokl; const unsigned* cnt; const char* A2; const char* Wgu; LAS const int* pre; int nU, G, c, nt; unsigned lda, ldb;
    __device__ __forceinline__ bool next(int i, MUnit& u) const {
        const int L = i * G + c; if (L >= nU) return false;
        const int id = xcd_remap(L, nU), tile_id = id >> 3, pn = id & 7;
        int bkt = 0;
        for (int b = 1; b < NBKT; ++b) if (pre[b] <= tile_id) bkt = b;
        const int rt = tile_id - pre[bkt]; int e0, e1; bucket_experts(bkt, e0, e1);
        const int slot = pn >> 2, tile = pn & 3, e = slot ? e1 : e0;
        u.A = A2; u.B = Wgu + ((size_t)e * 1024 + tile * 256) * 2048; u.first = 1; u.last = 1;
        u.i0 = bkt; u.i1 = rt; u.i2 = pn; u.i3 = pre[32 + bkt]; u.i4 = pre[bkt] * 256; u.i5 = e;
        return true;
    }
    __device__ __forceinline__ void gather(int slot, const int (&Rr)[2], int Cc, unsigned (&v)[2][2], LAS unsigned char* lds) const {
        const LAS int* tk = (const LAS int*)(lds + TAB_OFF + slot * 3072);
#pragma unroll
        for (int h = 0; h < 2; ++h)
#pragma unroll
            for (int i = 0; i < 2; ++i) v[h][i] = (unsigned)tk[h * 128 + Rr[i]] * 2048u + (unsigned)Cc * 2u;
    }
    __device__ __forceinline__ unsigned gather1(int slot, int row, int Cc, LAS unsigned char* lds) const {
        return (unsigned)((const LAS int*)(lds + TAB_OFF + slot * 3072))[row] * 2048u + (unsigned)Cc * 2u;
    }
};
struct SchedP5 {
    const unsigned* cnt; const char* act; const char* Wd; LAS const int* pre; int nU, G, c, nt; unsigned lda, ldb;
    __device__ __forceinline__ bool next(int i, MUnit& u) const {
        const int L = (i >> 1) * G + c, sub = i & 1; if (L >= nU) return false;
        const int id = xcd_remap(L, nU), tile_id = id >> 2, pn = id & 3;
        int bkt = 0;
        for (int b = 1; b < NBKT; ++b) if (pre[b] <= tile_id) bkt = b;
        const int rt = tile_id - pre[bkt]; int e0, e1; bucket_experts(bkt, e0, e1);
        const int e = sub ? e1 : e0, off = pre[bkt] * 256;
        u.A = act + (size_t)(off + rt * 256) * 2048 + sub * 1024; u.B = Wd + ((size_t)e * 1024 + pn * 256) * 1024; u.first = (sub == 0); u.last = (sub == 1);
        u.i0 = bkt; u.i1 = rt; u.i2 = pn; u.i3 = pre[32 + bkt]; u.i4 = pre[64 + bkt]; u.i5 = (i >> 1) * 3072;
        return true;
    }
    __device__ __forceinline__ void gather(int, const int (&)[2], int, unsigned (&)[2][2], LAS unsigned char*) const {}
    __device__ __forceinline__ unsigned gather1(int, int, int, LAS unsigned char*) const { return 0u; }
};

struct EpiP1 {
    static constexpr bool PERM = true, HAS_MID = false;
    bf16* proj; const float* ssq; const float* bias1;
    __device__ __forceinline__ void operator()(const f32x4 (&acc)[2][2][4][2], const MUnit& u, int slot, int wr, int wc, int fr, int fq, LAS unsigned char* lds) const {
        const int pm = u.i0, pn = u.i1, b = pm >> 3;
        const int row0 = pm * 256 + wr * 64 + fr, col0 = pn * 256 + wc * 32 + 8 * fq;
        const LAS float* rtab = (const LAS float*)(lds + TAB_OFF + slot * 3072 + 1024);
        f32x4 bv[2][2];
#pragma unroll
        for (int bj = 0; bj < 2; ++bj)
#pragma unroll
            for (int n = 0; n < 2; ++n) bv[bj][n] = *(const f32x4*)(bias1 + b * INC + col0 + bj * 128 + 4 * n);
        const bool act = pn < 4;
#pragma unroll
        for (int ai = 0; ai < 2; ++ai)
#pragma unroll
            for (int m = 0; m < 4; ++m) {
                const int row = row0 + ai * 128 + m * 16; const float rs = rtab[wr * 64 + fr + ai * 128 + m * 16];
                const int tq = row & 2047;
#pragma unroll
                for (int bj = 0; bj < 2; ++bj) {
                    f32x4 v0 = acc[ai][bj][m][0] * rs + bv[bj][0], v1 = acc[ai][bj][m][1] * rs + bv[bj][1];
                    if (act) { const f32x2 p = gelu_pk((f32x2){v0[0], v0[1]}), q = gelu_pk((f32x2){v0[2], v0[3]}), r = gelu_pk((f32x2){v1[0], v1[1]}), s = gelu_pk((f32x2){v1[2], v1[3]});
                        v0 = (f32x4){p.x, p.y, q.x, q.y}; v1 = (f32x4){r.x, r.y, s.x, s.y}; }
                    u32x4 w; w.x = cvt_pk_bf16(v0[0], v0[1]); w.y = cvt_pk_bf16(v0[2], v0[3]); w.z = cvt_pk_bf16(v1[0], v1[1]); w.w = cvt_pk_bf16(v1[2], v1[3]);
                    if (act) *(u32x4*)(proj + (size_t)row * 1024 + col0 + bj * 128) = w;
                    else { const int c512 = ((pn - 4) & 1) * 256 + bj * 128 + wc * 32 + 8 * fq, which = (pn - 4) >> 1;
                        *(u32x4*)(proj + (size_t)(32 + 16 * which) * (MiB / 2) + ((size_t)((b * 8 + (c512 >> 6)) * 2048 + tq)) * 64 + (c512 & 63)) = w; }
                }
            }
    }
};
template <bool L0, bool WT>
struct EpiP3 {
    static constexpr bool PERM = true, HAS_MID = true;
    const float* xin;        const bf16* x2b;
    bf16* x1; bf16* A2; float* ssq; const float* g1;     const float* G2;
    __device__ __forceinline__ void mid(f32x4 (&acc)[2][2][4][2], int ui, bool epi, int wr, int fr, LAS unsigned char* lds) const {
        const LAS float* rho = (const LAS float*)(lds + TAB_OFF + (ui >> 1) * 3072 + 1024);
#pragma unroll
        for (int ai = 0; ai < 2; ++ai)
#pragma unroll
            for (int m = 0; m < 4; ++m) { const float r0 = rho[ai * 128 + wr * 64 + m * 16 + fr]; const float r = epi ? 1.0f : r0;
#pragma unroll
                for (int bj = 0; bj < 2; ++bj)
#pragma unroll
                    for (int n = 0; n < 2; ++n) acc[ai][bj][m][n] = acc[ai][bj][m][n] * r; }
    }
    __device__ __forceinline__ void operator()(const f32x4 (&acc)[2][2][4][2], const MUnit& u, int ui, int wr, int wc, int fr, int fq, LAS unsigned char* lds) const {
        const int pm = u.i0, pn = u.i1, b = pm >> 3;
        const int row0 = pm * 256 + wr * 64 + fr, col0 = pn * 256 + wc * 32 + 8 * fq;
        const LAS float* rbt = (const LAS float*)(lds + TAB_OFF + (ui >> 1) * 3072 + 2048); const LAS int* rxt = (const LAS int*)(lds + TAB_OFF + (ui >> 1) * 3072);
        f32x4 gv[2][2], Gv[2][2];
#pragma unroll
        for (int bj = 0; bj < 2; ++bj)
#pragma unroll
            for (int n = 0; n < 2; ++n) { gv[bj][n] = *(const f32x4*)(g1 + b * 6144 + col0 + bj * 128 + 4 * n); Gv[bj][n] = *(const f32x4*)(G2 + b * 1024 + col0 + bj * 128 + 4 * n); }
        constexpr int AH = L0 ? 2 : 4;
        f32x4 PF[L0 ? AH : 1][2][2]; u32x4 RW[L0 ? 1 : AH][2];
#define P3_LOAD(ai_, m_) do { const int rl_ = (ai_) * 128 + wr * 64 + (m_) * 16 + fr; _Pragma("unroll") for (int bj = 0; bj < 2; ++bj) { \
            if (L0) { const float* xp = xin + (size_t)(pm * 256 + rl_) * 1024 + col0 + bj * 128; PF[L0 ? ((m_) % AH) : 0][bj][0] = __builtin_nontemporal_load((const f32x4*)xp); PF[L0 ? ((m_) % AH) : 0][bj][1] = __builtin_nontemporal_load((const f32x4*)(xp + 4)); } \
            else RW[L0 ? 0 : ((m_) % AH)][bj] = *(const u32x4*)(x2b + (size_t)rxt[rl_] * 1024 + col0 + bj * 128); } } while (0)
#pragma unroll
        for (int m = 0; m < AH; ++m) P3_LOAD(0, m);
#pragma unroll
        for (int ai = 0; ai < 2; ++ai)
#pragma unroll
            for (int m = 0; m < 4; ++m) {
                const int rl = ai * 128 + wr * 64 + m * 16 + fr, row = pm * 256 + rl; float ss = 0.f; const float rb = rbt[rl];
                f32x4 pp[2][2];
#pragma unroll
                for (int bj = 0; bj < 2; ++bj) {
                    if (L0) { pp[bj][0] = PF[L0 ? (m % AH) : 0][bj][0]; pp[bj][1] = PF[L0 ? (m % AH) : 0][bj][1]; }
                    else { const u32x4 raw = RW[L0 ? 0 : (m % AH)][bj];
                        pp[bj][0] = (f32x4){__uint_as_float(raw.x << 16), __uint_as_float(raw.x & 0xffff0000u), __uint_as_float(raw.y << 16), __uint_as_float(raw.y & 0xffff0000u)};
                        pp[bj][1] = (f32x4){__uint_as_float(raw.z << 16), __uint_as_float(raw.z & 0xffff0000u), __uint_as_float(raw.w << 16), __uint_as_float(raw.w & 0xffff0000u)}; }
                }
                { constexpr int dummy_ = 0; (void)dummy_; const int it_ = ai * 4 + m + AH; if (it_ < 8) P3_LOAD(it_ >> 2, it_ & 3); }
#pragma unroll
                for (int bj = 0; bj < 2; ++bj) {
                    const f32x4 p0 = pp[bj][0], p1 = pp[bj][1];
                    const f32x4 v0 = p0 + gv[bj][0] * (acc[ai][bj][m][0] * rb), v1 = p1 + gv[bj][1] * (acc[ai][bj][m][1] * rb);
                    ss += ((v0[0] * v0[0] + v0[1] * v0[1]) + (v0[2] * v0[2] + v0[3] * v0[3])) + ((v1[0] * v1[0] + v1[1] * v1[1]) + (v1[2] * v1[2] + v1[3] * v1[3]));
                    const size_t o = (size_t)row * 1024 + col0 + bj * 128;
                    u32x4 w; w.x = cvt_pk_bf16(v0[0], v0[1]); w.y = cvt_pk_bf16(v0[2], v0[3]); w.z = cvt_pk_bf16(v1[0], v1[1]); w.w = cvt_pk_bf16(v1[2], v1[3]);
                    *(u32x4*)(x1 + o) = w;
                    const f32x4 a0 = v0 * Gv[bj][0], a1 = v1 * Gv[bj][1];
                    u32x4 z; z.x = cvt_pk_bf16(a0[0], a0[1]); z.y = cvt_pk_bf16(a0[2], a0[3]); z.z = cvt_pk_bf16(a1[0], a1[1]); z.w = cvt_pk_bf16(a1[2], a1[3]);
                    if constexpr (WT) { const __amdgpu_buffer_rsrc_t rs2 = __builtin_amdgcn_make_buffer_rsrc((void*)A2, (short)0, 0x2000000, 0x00020000);
                      __builtin_amdgcn_raw_buffer_store_b128(z, rs2, (int)((unsigned)o * 2u), 0, 16); }
                    else *(u32x4*)(A2 + o) = z;
                }
                ss = rows_sum(ss);
                if (fq == 0) { if constexpr (WT) __hip_atomic_store(ssq + (size_t)row * 16 + pn * 4 + wc, ss, __ATOMIC_RELAXED, __HIP_MEMORY_SCOPE_AGENT); else ssq[(size_t)row * 16 + pn * 4 + wc] = ss; }
            }
#undef P3_LOAD
    }
};
struct EpiP4 {
    static constexpr bool PERM = true, HAS_MID = false;
    bf16* act; const int* tokl; const float* ssq; const float* biasgu;     const float* gates; int wt;
    __device__ __forceinline__ void side(const MUnit& u, int wid, int lane, LAS unsigned char* lds) const {
        const float* src = biasgu + ((size_t)wid * 16 + u.i5) * 1024 + (u.i2 & 3) * 256 + ((lane ^ wid) << 2);
        __builtin_amdgcn_global_load_lds((const unsigned*)src, (LAS unsigned*)(lds + SIDE_OFF + wid * 1024), 16, 0, 0);
    }
    __device__ __forceinline__ void operator()(const f32x4 (&acc)[2][2][4][2], const MUnit& u, int uslot, int wr, int wc, int fr, int fq, LAS unsigned char* lds) const {
        const int rt = u.i1, pn = u.i2, off = u.i4, e = u.i5, slot = pn >> 2, tile = pn & 3;
        const LAS int* ttab = (const LAS int*)(lds + TAB_OFF + uslot * 3072); const LAS float* rtab = (const LAS float*)(lds + TAB_OFF + uslot * 3072 + 1024); const LAS float* gtab = (const LAS float*)(lds + TAB_OFF + uslot * 3072 + 2048);
        const LAS unsigned char* sb = lds + SIDE_OFF; const int ch = wc * 8 + 2 * fq;
#pragma unroll
        for (int ai = 0; ai < 2; ++ai)
#pragma unroll
            for (int m = 0; m < 4; ++m) {
                const int rl = ai * 128 + wr * 64 + m * 16 + fr, r = rt * 256 + rl;
                const int t = ttab[rl]; const int b = t >> 11;
                const float rs = rtab[rl]; const float g = gtab[rl];
                unsigned wv[4];
#pragma unroll
                for (int nn = 0; nn < 2; ++nn) {
                    const f32x4 bg = *(const LAS f32x4*)(sb + b * 1024 + (((ch + nn) ^ b) << 4)), bu = *(const LAS f32x4*)(sb + b * 1024 + (((32 + ch + nn) ^ b) << 4));
                    const f32x4 hg = acc[ai][0][m][nn] * rs + bg, hu = acc[ai][1][m][nn] * rs + bu;
                    float o[4];
#pragma unroll
                    for (int j = 0; j < 4; ++j) o[j] = hg[j] * __builtin_amdgcn_rcpf(1.0f + __expf(-hg[j])) * hu[j] * g;
                    wv[2 * nn] = cvt_pk_bf16(o[0], o[1]); wv[2 * nn + 1] = cvt_pk_bf16(o[2], o[3]);
                }
                u32x4 w; w.x = wv[0]; w.y = wv[1]; w.z = wv[2]; w.w = wv[3];
                if (wt) { const __amdgpu_buffer_rsrc_t rs = __builtin_amdgcn_make_buffer_rsrc((void*)act, (short)0, 0x3000000, 0x00020000);
                    __builtin_amdgcn_raw_buffer_store_b128(w, rs, (int)(((unsigned)(off + r) * 1024u + (unsigned)(slot * 512 + tile * 128 + wc * 32 + 8 * fq)) * 2u), 0, 16); }
                else *(u32x4*)(act + (size_t)(off + r) * 1024 + slot * 512 + tile * 128 + wc * 32 + 8 * fq) = w;
                ;
            }
    }
};
struct EpiP5 {
    static constexpr bool PERM = true, HAS_MID = false;
    const bf16* x1; bf16* x2b; bf16* A1; float* ssq; const float* g2;     const float* G1n; int haveNext;
    __device__ __forceinline__ void side(const MUnit& u, int wid, int lane, LAS unsigned char* lds) const {
        const int co = u.i2 * 256 + ((lane ^ wid) << 2);
        __builtin_amdgcn_global_load_lds((const unsigned*)(g2 + wid * 6144 + co), (LAS unsigned*)(lds + SIDE_OFF + wid * 1024), 16, 0, 0);
        if (haveNext) __builtin_amdgcn_global_load_lds((const unsigned*)(G1n + wid * 1024 + co), (LAS unsigned*)(lds + SIDE_OFF + 8192 + wid * 1024), 16, 0, 0);
    }
    __device__ __forceinline__ void operator()(const f32x4 (&acc)[2][2][4][2], const MUnit& u, int ui, int wr, int wc, int fr, int fq, LAS unsigned char* lds) const {
        const int rt = u.i1, pn = u.i2, n = u.i3, xoff = u.i4;
        const int col0 = pn * 256 + wc * 32 + 8 * fq;
        const LAS int* ttab = (const LAS int*)(lds + TAB_OFF + u.i5);
        const LAS unsigned char* sb = lds + SIDE_OFF; const int ch = wc * 8 + 2 * fq;
        u32x4 raw[4][2];
#pragma unroll
        for (int m = 0; m < 4; ++m) { const int t = ttab[wr * 64 + m * 16 + fr];
#pragma unroll
            for (int bj = 0; bj < 2; ++bj) raw[m][bj] = *(const u32x4*)(x1 + (size_t)t * 1024 + col0 + bj * 128); }
#pragma unroll
        for (int ai = 0; ai < 2; ++ai)
#pragma unroll
            for (int m = 0; m < 4; ++m) {
                const int rl = ai * 128 + wr * 64 + m * 16 + fr, r = rt * 256 + rl; const bool valid = r < n;
                const int t = ttab[rl]; const int b = t >> 11; float ss = 0.f;
                const size_t orow = (size_t)(xoff + r);
                u32x4 w[2], z[2];
                const u32x4 rw0 = raw[m][0], rw1 = raw[m][1];
                if (ai == 0) { const int tn = ttab[128 + wr * 64 + m * 16 + fr];
#pragma unroll
                    for (int bj = 0; bj < 2; ++bj) raw[m][bj] = *(const u32x4*)(x1 + (size_t)tn * 1024 + col0 + bj * 128); }
#pragma unroll
                for (int bj = 0; bj < 2; ++bj) {
                    const int c0 = ch + 32 * bj;
                    const f32x4 ga = *(const LAS f32x4*)(sb + b * 1024 + ((c0 ^ b) << 4)), gb = *(const LAS f32x4*)(sb + b * 1024 + (((c0 + 1) ^ b) << 4));
                    const u32x4 rw = bj ? rw1 : rw0;
                    const f32x4 p0 = (f32x4){__uint_as_float(rw.x << 16), __uint_as_float(rw.x & 0xffff0000u), __uint_as_float(rw.y << 16), __uint_as_float(rw.y & 0xffff0000u)};
                    const f32x4 p1 = (f32x4){__uint_as_float(rw.z << 16), __uint_as_float(rw.z & 0xffff0000u), __uint_as_float(rw.w << 16), __uint_as_float(rw.w & 0xffff0000u)};
                    const f32x4 v0 = p0 + ga * acc[ai][bj][m][0], v1 = p1 + gb * acc[ai][bj][m][1];
                    ss += ((v0[0] * v0[0] + v0[1] * v0[1]) + (v0[2] * v0[2] + v0[3] * v0[3])) + ((v1[0] * v1[0] + v1[1] * v1[1]) + (v1[2] * v1[2] + v1[3] * v1[3]));
                    w[bj].x = cvt_pk_bf16(v0[0], v0[1]); w[bj].y = cvt_pk_bf16(v0[2], v0[3]); w[bj].z = cvt_pk_bf16(v1[0], v1[1]); w[bj].w = cvt_pk_bf16(v1[2], v1[3]);
                    if (haveNext) { const f32x4 Ga = *(const LAS f32x4*)(sb + 8192 + b * 1024 + ((c0 ^ b) << 4)), Gb = *(const LAS f32x4*)(sb + 8192 + b * 1024 + (((c0 + 1) ^ b) << 4));
                        const f32x4 a0 = v0 * Ga, a1 = v1 * Gb;
                        z[bj].x = cvt_pk_bf16(a0[0], a0[1]); z[bj].y = cvt_pk_bf16(a0[2], a0[3]); z[bj].z = cvt_pk_bf16(a1[0], a1[1]); z[bj].w = cvt_pk_bf16(a1[2], a1[3]); }
                }
                ss = rows_sum(ss);
                if (valid) {
#pragma unroll
                    for (int bj = 0; bj < 2; ++bj) {
                        *(u32x4*)(x2b + orow * 1024 + col0 + bj * 128) = w[bj];
                        if (haveNext) *(u32x4*)(A1 + (size_t)t * 1024 + col0 + bj * 128) = z[bj];
                    }
                    if (fq == 0) ssq[(size_t)t * 16 + pn * 4 + wc] = ss;
                }
            }
    }
};

struct MUnit45 : MUnit { int kind, nt, slot, tile; unsigned ldb; };
struct Sched45 {
    const char* A2; const char* Wgu; const char* act; const char* Wd; LAS const int* pre; int t0, ntl, rank, n4;
    __device__ __forceinline__ bool next(int i, MUnit45& u) const {
        if (i < n4) {
            const int en = rank + 32 * i, tile_id = t0 + (en >> 3), pn = en & 7;
            int bkt = 0;
            for (int b = 1; b < NBKT; ++b) if (pre[b] <= tile_id) bkt = b;
            bkt = __builtin_amdgcn_readfirstlane(bkt);
            const int pb_ = __builtin_amdgcn_readfirstlane(pre[bkt]);
            const int rt = tile_id - pb_; int e0, e1; bucket_experts(bkt, e0, e1);
            const int slot = pn >> 2, tile = pn & 3, e = slot ? e1 : e0;
            u.A = A2; u.B = Wgu + ((size_t)e * 1024 + tile * 256) * 2048; u.first = 1; u.last = 1;
            u.i0 = bkt; u.i1 = rt; u.i2 = pn; u.i3 = __builtin_amdgcn_readfirstlane(pre[32 + bkt]); u.i4 = pb_ * 256; u.i5 = e;
            u.kind = 0; u.nt = 16; u.slot = i; u.tile = tile_id; u.ldb = 2048u;
            return true;
        }
        const int j = i - n4, k5 = j >> 1, sub = j & 1, en = rank + 32 * (n4 + k5) - 8 * ntl; if (en >= 4 * ntl) return false;
        const int tile_id = t0 + (en >> 2), pn = en & 3;
        int bkt = 0;
        for (int b = 1; b < NBKT; ++b) if (pre[b] <= tile_id) bkt = b;
        bkt = __builtin_amdgcn_readfirstlane(bkt);
        const int pb_ = __builtin_amdgcn_readfirstlane(pre[bkt]);
        const int rt = tile_id - pb_; int e0, e1; bucket_experts(bkt, e0, e1);
        const int e = sub ? e1 : e0, off = pb_ * 256;
        u.A = act + (size_t)(off + rt * 256) * 2048 + sub * 1024; u.B = Wd + ((size_t)e * 1024 + pn * 256) * 1024; u.first = (sub == 0); u.last = (sub == 1);
        u.i0 = bkt; u.i1 = rt; u.i2 = pn; u.i3 = __builtin_amdgcn_readfirstlane(pre[32 + bkt]); u.i4 = __builtin_amdgcn_readfirstlane(pre[64 + bkt]); u.i5 = 9216 + k5 * 1024;
        u.kind = 1; u.nt = 8; u.slot = k5; u.tile = tile_id; u.ldb = 1024u;
        return true;
    }
    __device__ __forceinline__ unsigned aoff(const MUnit45& u, int row, int Cc, LAS unsigned char* lds) const {
        if (u.kind == 0) return (unsigned)((const LAS int*)(lds + TAB_OFF + u.slot * 3072))[row] * 2048u + (unsigned)Cc * 2u;
        return (unsigned)row * 2048u + (unsigned)Cc * 2u;
    }
};
template <class Epi4, class Epi5>
__device__ __forceinline__ void mm_phase45(LAS unsigned char* lds, const Sched45& S, const Epi4& E4, const Epi5& E5, const int tid, unsigned* ready, unsigned* tmo) {
    const int wid = __builtin_amdgcn_readfirstlane(tid >> 6), lane = tid & 63, wr = wid >> 2, wc = wid & 3, fr = lane & 15, fq = lane >> 4;
    int Rr[2], RbV[2], Cc;
#pragma unroll
    for (int i = 0; i < 2; ++i) { int R, C; stage_rc(tid * 16 + i * 8192, R, C); Rr[i] = R; RbV[i] = (R & ~31) + perm32(R & 31); Cc = C; }
    const size_t kstep = (size_t)(BK * 2);
    const unsigned ldsw = (unsigned)wid * 1024u;
    const int aoff = lds_byte(wr * 64 + fr, fq * 8), boff = lds_byte(wc * 32 + fr, fq * 8);
#define MM_SA(b, h) (((b) * 2 + (h)) * HTB)
#define MM_SB(b, h) ((4 + (b) * 2 + (h)) * HTB)
#define MM_STAGE_B(bufoff, nx, hb, koff) do { \
        const unsigned ldb_ = (nx) ? pf.ldb : cur.ldb; const char* gb_ = ((nx) ? pf.B : cur.B) + (size_t)(hb) * 128u * ldb_ + (koff); \
        _Pragma("unroll") for (int _i = 0; _i < 2; ++_i) { \
            const unsigned vo_ = (unsigned)RbV[_i] * ldb_ + (unsigned)Cc * 2u; \
            __builtin_amdgcn_global_load_lds((const unsigned*)(gb_ + vo_), (LAS unsigned*)(lds + (bufoff) + ldsw + _i * 8192), 16, 0, 0); } } while (0)
#define MM_STAGE_A(bufoff, nx, h, koff) do { \
        const char* gb_ = ((nx) ? pf.A : cur.A) + (koff); \
        _Pragma("unroll") for (int _i = 0; _i < 2; ++_i) { \
            unsigned vo_ = vAc[h][_i]; \
            if (nx) vo_ = S.aoff(pf, (h) * 128 + Rr[_i], Cc, lds); \
            __builtin_amdgcn_global_load_lds((const unsigned*)(gb_ + vo_), (LAS unsigned*)(lds + (bufoff) + ldsw + _i * 8192), 16, 0, 0); } } while (0)
#define MM_LDA(dst, b, h) do { _Pragma("unroll") for (int m = 0; m < 4; ++m) _Pragma("unroll") for (int k = 0; k < 2; ++k) dst[m][k] = *(const LAS bf16x8*)(lds + MM_SA(b, h) + aoff + m * 2048 + k * 1024); } while (0)
#define MM_LDB(dst, b, h) do { _Pragma("unroll") for (int n = 0; n < 2; ++n) _Pragma("unroll") for (int k = 0; k < 2; ++k) dst[n][k] = *(const LAS bf16x8*)(lds + MM_SB(b, h) + boff + n * 2048 + k * 1024); } while (0)
#define MM_MMA(ai, bj, At, Bt) do { __builtin_amdgcn_s_setprio(1); _Pragma("unroll") for (int m = 0; m < 4; ++m) _Pragma("unroll") for (int n = 0; n < 2; ++n) _Pragma("unroll") for (int k = 0; k < 2; ++k) \
        acc[ai][bj][m][n] = __builtin_amdgcn_mfma_f32_16x16x32_bf16(Bt[n][k], At[m][k], acc[ai][bj][m][n], 0, 0, 0); __builtin_amdgcn_s_setprio(0); } while (0)
#define MM_WAIT_V(n) asm volatile("s_waitcnt vmcnt(" #n ")" ::: "memory")
#define MM_WAIT_L(n) asm volatile("s_waitcnt lgkmcnt(" #n ")" ::: "memory")
#define MM_BAR __builtin_amdgcn_s_barrier()
#define MM_SCHED __builtin_amdgcn_sched_barrier(0)
#define MM_ZERO() do { _Pragma("unroll") for (int a_ = 0; a_ < 2; ++a_) _Pragma("unroll") for (int b_ = 0; b_ < 2; ++b_) _Pragma("unroll") for (int m_ = 0; m_ < 4; ++m_) _Pragma("unroll") for (int n_ = 0; n_ < 2; ++n_) \
        acc[a_][b_][m_][n_] = (f32x4){0.f, 0.f, 0.f, 0.f}; } while (0)
    MUnit45 cur, nxt, pf; int ui = 0;
    if (!S.next(0, cur)) return;
    nxt = cur; pf = cur;
    f32x4 acc[2][2][4][2];
    MM_ZERO();
    bf16x8 At[4][2], B0[2][2], B1[2][2];
    unsigned vAc[2][2];
#pragma unroll
    for (int h = 0; h < 2; ++h)
#pragma unroll
        for (int i = 0; i < 2; ++i) vAc[h][i] = S.aoff(cur, h * 128 + Rr[i], Cc, lds);
    MM_STAGE_B(MM_SB(0, 0), false, 0, 0); MM_STAGE_B(MM_SB(0, 1), false, 1, 0); MM_STAGE_A(MM_SA(0, 0), false, 0, 0); MM_STAGE_A(MM_SA(0, 1), false, 1, 0);
    if (wr == 1) MM_BAR;
    MM_WAIT_V(2); MM_BAR;
    MM_STAGE_B(MM_SB(1, 0), false, 0, kstep); MM_STAGE_A(MM_SA(1, 0), false, 0, kstep); MM_STAGE_B(MM_SB(1, 1), false, 1, kstep);
    MM_WAIT_V(6); MM_BAR;
    for (;;) {
        const bool has_next = S.next(ui + 1, nxt);
        const bool need_wait = has_next && nxt.kind == 1 && nxt.first;
        const bool defer = need_wait && cur.kind == 0;
        pf = (has_next && !defer) ? nxt : cur;
        const int nt = cur.nt;
        for (int t = 0; t < nt; t += 2) {
            const bool last = (t == nt - 2);
            const size_t k1 = (size_t)(t + 1) * kstep;
            const size_t k2 = last ? 0 : (size_t)(t + 2) * kstep;
            const size_t k3 = k2 + kstep;
            if (t == 2 && cur.last) { int ln_ = lane, wd_ = wid; asm volatile("" : "+v"(ln_), "+s"(wd_)); if (cur.kind == 0) E4.side(cur, wd_, ln_, lds); else E5.side(cur, wd_, ln_, lds); }
            if (last && need_wait && !defer) {
                if (tid < 64) {
                    unsigned* w = ready + 16 * nxt.tile; unsigned sp = 0;
                    while ((unsigned)__builtin_amdgcn_readfirstlane(__hip_atomic_load(w, __ATOMIC_RELAXED, __HIP_MEMORY_SCOPE_AGENT)) < 64u) {
                        __builtin_amdgcn_s_sleep(2);
                        if ((++sp & 255u) == 0u) { if (__builtin_amdgcn_readfirstlane(__hip_atomic_load(tmo, __ATOMIC_RELAXED, __HIP_MEMORY_SCOPE_AGENT)) != 0u) break;
                            if (sp > (1u << 20)) { if (lane == 0) __hip_atomic_store(tmo, 0x45u, __ATOMIC_RELAXED, __HIP_MEMORY_SCOPE_AGENT); break; } }
                    }
                    __builtin_amdgcn_fence(__ATOMIC_ACQUIRE, "agent");
                    asm volatile("s_waitcnt vmcnt(0)" ::: "memory");
                }
                asm volatile("" ::: "memory"); MM_BAR; asm volatile("" ::: "memory");
            }
            MM_LDB(B0, 0, 0); MM_LDB(B1, 0, 1); MM_SCHED; MM_LDA(At, 0, 0); MM_STAGE_A(MM_SA(1, 1), false, 1, k1);
            MM_WAIT_V(8); MM_WAIT_L(0); MM_BAR; MM_MMA(0, 0, At, B0); MM_MMA(0, 1, At, B1); MM_BAR; MM_SCHED;
            MM_LDA(At, 0, 1); MM_STAGE_B(MM_SB(0, 0), last, 0, k2); MM_STAGE_B(MM_SB(0, 1), last, 1, k2); MM_STAGE_A(MM_SA(0, 0), last, 0, k2);
            MM_WAIT_V(8); MM_WAIT_L(0); MM_BAR; MM_MMA(1, 0, At, B0); MM_MMA(1, 1, At, B1); MM_BAR; MM_SCHED;
            MM_LDB(B0, 1, 0); MM_LDB(B1, 1, 1); MM_SCHED; MM_LDA(At, 1, 0); MM_STAGE_A(MM_SA(0, 1), last, 1, k2);
            MM_WAIT_V(8); MM_WAIT_L(0); MM_BAR; MM_MMA(0, 0, At, B0); MM_MMA(0, 1, At, B1); MM_BAR; MM_SCHED;
            MM_LDA(At, 1, 1); MM_STAGE_B(MM_SB(1, 0), last, 0, k3); MM_STAGE_B(MM_SB(1, 1), last, 1, k3); MM_STAGE_A(MM_SA(1, 0), last, 0, k3);
            MM_WAIT_V(8); MM_WAIT_L(0); MM_BAR; MM_MMA(1, 0, At, B0); MM_MMA(1, 1, At, B1); MM_BAR; MM_SCHED;
        }
        const bool epi = cur.last != 0;
        int fr_ = fr, fq_ = fq, wr_ = wr, wc_ = wc; asm volatile("" : "+v"(fr_), "+v"(fq_), "+s"(wr_), "+s"(wc_));
        if (epi) {
            if (wr == 0) MM_BAR;
            if (cur.kind == 0) {
                E4(acc, cur, cur.slot, wr_, wc_, fr_, fq_, lds);
                asm volatile("s_waitcnt vmcnt(0)" ::: "memory");
                if (lane == 0) __hip_atomic_fetch_add(ready + 16 * cur.tile, 1u, __ATOMIC_RELAXED, __HIP_MEMORY_SCOPE_AGENT);
            } else E5(acc, cur, ui, wr_, wc_, fr_, fq_, lds);
        }
        if (!has_next) break;
        if (nxt.first) MM_ZERO();
        cur = nxt; ++ui;
#pragma unroll
        for (int h = 0; h < 2; ++h)
#pragma unroll
            for (int i = 0; i < 2; ++i) vAc[h][i] = S.aoff(cur, h * 128 + Rr[i], Cc, lds);
        if (defer) {
            MM_WAIT_V(0);
            if (tid < 64) {
                unsigned* w = ready + 16 * cur.tile; unsigned sp = 0;
                while ((unsigned)__builtin_amdgcn_readfirstlane(__hip_atomic_load(w, __ATOMIC_RELAXED, __HIP_MEMORY_SCOPE_AGENT)) < 64u) {
                    __builtin_amdgcn_s_sleep(2);
                    if ((++sp & 255u) == 0u) { if (__builtin_amdgcn_readfirstlane(__hip_atomic_load(tmo, __ATOMIC_RELAXED, __HIP_MEMORY_SCOPE_AGENT)) != 0u) break;
                        if (sp > (1u << 20)) { if (lane == 0) __hip_atomic_store(tmo, 0x46u, __ATOMIC_RELAXED, __HIP_MEMORY_SCOPE_AGENT); break; } }
                }
                __builtin_amdgcn_fence(__ATOMIC_ACQUIRE, "agent");
                asm volatile("s_waitcnt vmcnt(0)" ::: "memory");
            }
            asm volatile("" ::: "memory"); MM_BAR; asm volatile("" ::: "memory");
            MM_STAGE_B(MM_SB(0, 0), false, 0, 0); MM_STAGE_B(MM_SB(0, 1), false, 1, 0); MM_STAGE_A(MM_SA(0, 0), false, 0, 0); MM_STAGE_A(MM_SA(0, 1), false, 1, 0);
            if (wr == 1) MM_BAR;
            MM_WAIT_V(2); MM_BAR;
            MM_STAGE_B(MM_SB(1, 0), false, 0, kstep); MM_STAGE_A(MM_SA(1, 0), false, 0, kstep); MM_STAGE_B(MM_SB(1, 1), false, 1, kstep);
            MM_WAIT_V(6); MM_BAR;
        } else if (epi) { if (wr == 1) MM_BAR; }
    }
    MM_WAIT_V(0);
    MM_BAR;
#undef MM_SA
#undef MM_SB
#undef MM_STAGE_A
#undef MM_STAGE_B
#undef MM_LDA
#undef MM_LDB
#undef MM_MMA
#undef MM_WAIT_V
#undef MM_WAIT_L
#undef MM_BAR
#undef MM_SCHED
#undef MM_ZERO
}
}

__device__ __forceinline__ int build_tile_prefix(const unsigned* cnt, LAS int* pre, int tid) {
    if (tid == 0) { int s = 0, x = 0; for (int b = 0; b < NBKT; ++b) { const unsigned n = cnt[b]; pre[b] = s; pre[32 + b] = (int)n; pre[64 + b] = x; s += (int)((n + 255u) >> 8); x += (int)n; } pre[NBKT] = s; }
    __syncthreads();
    return pre[NBKT];
}
__device__ __forceinline__ void phase_p1_fast(const Args& a, const Ctx& c, int l) {
    mm::SchedP1 S; S.A = (const char*)(a.ws + (l == 0 ? WS_ACTX : WS_A3)); S.B = (const char*)(a.ws + WS_WIN) + (size_t)l * INC * 1024 * 2;
    S.nM = 64; S.nN = 10; S.nU = 640; S.G = c.nwg; S.c = c.wg; S.nt = 16; S.lda = 2048; S.ldb = 2048;
    mm::EpiP1 E{(bf16*)(a.ws + WS_PROJ), (const float*)(a.ws + WS_SMALL + SO_SSQA), (const float*)(a.ws + WS_SMALL + SO_BIAS1) + (size_t)l * 8 * INC};
    {
        const int* rowx = (const int*)(a.ws + WS_SMALL + SO_ROWX);
        mm::MUnit u;
        for (int i = 0; i < 3 && S.next(i, u); ++i) {
            if (c.tid < 256) { const int r = u.i0 * 256 + c.tid;
                ((LAS int*)(c.lds + mm::TAB_OFF + i * 3072))[c.tid] = r;
                ((LAS float*)(c.lds + mm::TAB_OFF + i * 3072 + 1024))[c.tid] = rstd_from16(E.ssq, r); }
        }
        __syncthreads();
    }
    mm::mm_phase<mm::EpiP1, mm::SchedP1, true>(c.lds, S, E, c.tid);
}
template <bool L0, bool WT>
__device__ __forceinline__ void phase_p3_impl(const Args& a, const Ctx& c, int l, int cslot) {
    mm::SchedP3 S; S.A = (const char*)(a.ws + WS_A3); S.B = (const char*)(a.ws + WS_WOUT) + (size_t)l * 1024 * 1024 * 2;
    S.nM = 64; S.nN = 4; S.nU = 256; S.G = c.nwg; S.c = c.wg; S.nt = 8; S.lda = 2048; S.ldb = 2048;
    mm::EpiP3<L0, WT> E{a.in[I_X], (const bf16*)(a.ws + WS_X2B), (bf16*)(a.ws + WS_XA), (bf16*)(a.ws + WS_ACTX), (float*)(a.ws + WS_SMALL + SO_SSQB),
                    (const float*)(a.ws + WS_SMALL + SO_MODV) + (size_t)l * 8 * 6144 + 2048, (const float*)(a.ws + WS_SMALL + SO_G2) + (size_t)l * 8 * 1024};
    {
        const float* ssqc = (const float*)(a.ws + WS_SMALL + SO_SSQC); const int* rowx = (const int*)(a.ws + WS_SMALL + SO_ROWX);
        mm::MUnit u;
        for (int i = 0; i < 3 && S.next(2 * i, u); ++i) {
            if (c.tid < 256) {
                const f32x4* p = (const f32x4*)(ssqc + (size_t)(u.i0 * 256 + c.tid) * 16);
                const f32x4 a0 = p[0], a1 = p[1], b0 = p[2], b1 = p[3];
                const float sa = ((a0.x + a0.y) + (a0.z + a0.w)) + ((a1.x + a1.y) + (a1.z + a1.w)), sb = ((b0.x + b0.y) + (b0.z + b0.w)) + ((b1.x + b1.y) + (b1.z + b1.w));
                const float ra = rsqrtf(sa * (1.0f / 512.0f) + EPS), rb = rsqrtf(sb * (1.0f / 512.0f) + EPS);
                ((LAS int*)(c.lds + mm::TAB_OFF + i * 3072))[c.tid] = rowx[u.i0 * 256 + c.tid];
                ((LAS float*)(c.lds + mm::TAB_OFF + i * 3072 + 1024))[c.tid] = ra / rb;
                ((LAS float*)(c.lds + mm::TAB_OFF + i * 3072 + 2048))[c.tid] = rb;
            }
        }
        __syncthreads();
    }
    mm::mm_phase<mm::EpiP3<L0, WT>, mm::SchedP3, false>(c.lds, S, E, c.tid);
    mm::MUnit u0;
    if (S.next(0, u0)) {
        unsigned* pnl = (unsigned*)(a.ws + WS_CTL) + CW_PNL + (cslot * 64 + u0.i0) * 16; unsigned* tmo = (unsigned*)(a.ws + WS_CTL) + CW_TMO;
        asm volatile("s_waitcnt vmcnt(0)" ::: "memory");
        __syncthreads();
        if (c.tid == 0) __hip_atomic_fetch_add(pnl, 1u, __ATOMIC_RELAXED, __HIP_MEMORY_SCOPE_AGENT);
        if (c.tid < 64) {
            unsigned sp = 0;
            while ((unsigned)__builtin_amdgcn_readfirstlane(__hip_atomic_load(pnl, __ATOMIC_RELAXED, __HIP_MEMORY_SCOPE_AGENT)) < 4u) {
                __builtin_amdgcn_s_sleep(2);
                if ((++sp & 255u) == 0u) { if (__builtin_amdgcn_readfirstlane(__hip_atomic_load(tmo, __ATOMIC_RELAXED, __HIP_MEMORY_SCOPE_AGENT)) != 0u) break;
                    if (sp > (1u << 20)) { if (c.lane == 0) __hip_atomic_store(tmo, 0x33u, __ATOMIC_RELAXED, __HIP_MEMORY_SCOPE_AGENT); break; } }
            }
            __builtin_amdgcn_fence(__ATOMIC_ACQUIRE, "agent");
            asm volatile("s_waitcnt vmcnt(0)" ::: "memory");
        }
        __syncthreads();
        route_tokens(a, c, l, cslot, u0.i0 * 256 + u0.i1 * 64, 4);
    }
}
__device__ __forceinline__ void phase_p3_fast(const Args& a, const Ctx& c, int l, int cslot, int pure) {
    if (pure) { if (l == 0) phase_p3_impl<true, false>(a, c, l, cslot); else phase_p3_impl<false, false>(a, c, l, cslot); }
    else { if (l == 0) phase_p3_impl<true, true>(a, c, l, cslot); else phase_p3_impl<false, true>(a, c, l, cslot); }
}
__device__ __forceinline__ void phase_p4_fast(const Args& a, const Ctx& c, int l) {
    const unsigned* cnt = (const unsigned*)(a.ws + WS_CTL) + CW_CNT + l * 32;
    LAS int* pre = (LAS int*)(c.lds + LDSCTL_OFF + 256);
    const int ntile = build_tile_prefix(cnt, pre, c.tid);
    mm::SchedP4 S; S.tokl = (const int*)(a.ws + WS_SMALL + SO_TOKL); S.cnt = cnt; S.A2 = (const char*)(a.ws + WS_ACTX); S.Wgu = (const char*)(a.ws + WS_WGU) + (size_t)l * NE * 1024 * 1024 * 2; S.pre = pre;
    S.nU = ntile * 8; S.G = c.nwg; S.c = c.wg; S.nt = 16; S.lda = 2048; S.ldb = 2048;
    mm::EpiP4 E{(bf16*)(a.ws + WS_ACT), S.tokl, (const float*)(a.ws + WS_SMALL + SO_SSQB), (const float*)(a.ws + WS_SMALL + SO_BIASGU) + (size_t)l * 8 * 16 * 1024, (const float*)(a.ws + WS_SMALL + SO_GATES), 0};
    {
        mm::MUnit u;
        for (int i = 0; i < 3 && S.next(i, u); ++i) {
            if (c.tid < 256) {
                const int rr = u.i1 * 256 + c.tid; const bool valid = rr < u.i3; const int t = valid ? S.tokl[u.i0 * TOKCAP + rr] : 0;
                ((LAS int*)(c.lds + mm::TAB_OFF + i * 3072))[c.tid] = t;
                ((LAS float*)(c.lds + mm::TAB_OFF + i * 3072 + 1024))[c.tid] = rstd_from16(E.ssq, t);
                ((LAS float*)(c.lds + mm::TAB_OFF + i * 3072 + 2048))[c.tid] = valid ? E.gates[(size_t)t * 2 + (u.i2 >> 2)] : 0.f;
                if (valid && u.i2 == 0) ((int*)(a.ws + WS_SMALL + SO_ROWX))[t] = pre[64 + u.i0] + rr;
            }
        }
        __syncthreads();
    }
    mm::mm_phase<mm::EpiP4, mm::SchedP4, true>(c.lds, S, E, c.tid);
}
__device__ __forceinline__ void phase_p5_fast(const Args& a, const Ctx& c, int l) {
    const unsigned* cnt = (const unsigned*)(a.ws + WS_CTL) + CW_CNT + l * 32;
    LAS int* pre = (LAS int*)(c.lds + LDSCTL_OFF + 256);
    const int ntile = build_tile_prefix(cnt, pre, c.tid);
    mm::SchedP5 S; S.cnt = cnt; S.act = (const char*)(a.ws + WS_ACT); S.Wd = (const char*)(a.ws + WS_WD) + (size_t)l * NE * 1024 * 512 * 2; S.pre = pre;
    S.nU = ntile * 4; S.G = c.nwg; S.c = c.wg; S.nt = 8; S.lda = 2048; S.ldb = 1024;
    mm::EpiP5 E{(const bf16*)(a.ws + WS_XA), (bf16*)(a.ws + WS_X2B), (bf16*)(a.ws + WS_A3), (float*)(a.ws + WS_SMALL + SO_SSQA),
                (const float*)(a.ws + WS_SMALL + SO_MODV) + (size_t)l * 8 * 6144 + 5120, (const float*)(a.ws + WS_SMALL + SO_G1) + (size_t)(l + 1 < DEPTH ? l + 1 : l) * 8 * 1024, (l + 1 < DEPTH) ? 1 : 0};
    const int* tokl_ = (const int*)(a.ws + WS_SMALL + SO_TOKL);
    {
        mm::MUnit u;
        for (int i = 0; i < 3 && S.next(2 * i, u); ++i) {
            if (c.tid < 256) { const int rr = u.i1 * 256 + c.tid; ((LAS int*)(c.lds + mm::TAB_OFF + i * 3072))[c.tid] = (rr < u.i3) ? tokl_[u.i0 * TOKCAP + rr] : 0; }
        }
        __syncthreads();
    }
    mm::mm_phase<mm::EpiP5, mm::SchedP5, false>(c.lds, S, E, c.tid);
}


__device__ __forceinline__ void phase_p45(const Args& a, const Ctx& c, int l, int rslot, int pure) {
    const unsigned* cnt = (const unsigned*)(a.ws + WS_CTL) + CW_CNT + l * 32;
    LAS int* pre = (LAS int*)(c.lds + LDSCTL_OFF + 256);
    const int ntile = build_tile_prefix(cnt, pre, c.tid);
    mm::Sched45 S; S.A2 = (const char*)(a.ws + WS_ACTX); S.Wgu = (const char*)(a.ws + WS_WGU) + (size_t)l * NE * 1024 * 1024 * 2; S.act = (const char*)(a.ws + WS_ACT);
    S.Wd = (const char*)(a.ws + WS_WD) + (size_t)l * NE * 1024 * 512 * 2; S.pre = pre;
    { const int x = c.wg & 7; S.t0 = (x * ntile) >> 3; S.ntl = (((x + 1) * ntile) >> 3) - S.t0; S.rank = c.wg >> 3; S.n4 = (8 * S.ntl > S.rank) ? (8 * S.ntl - S.rank + 31) / 32 : 0; }
    const int* tokl = (const int*)(a.ws + WS_SMALL + SO_TOKL);
    mm::EpiP4 E4{(bf16*)(a.ws + WS_ACT), tokl, (const float*)(a.ws + WS_SMALL + SO_SSQB), (const float*)(a.ws + WS_SMALL + SO_BIASGU) + (size_t)l * 8 * 16 * 1024, (const float*)(a.ws + WS_SMALL + SO_GATES), pure ? 0 : 1};
    mm::EpiP5 E5{(const bf16*)(a.ws + WS_XA), (bf16*)(a.ws + WS_X2B), (bf16*)(a.ws + WS_A3), (float*)(a.ws + WS_SMALL + SO_SSQA),
                 (const float*)(a.ws + WS_SMALL + SO_MODV) + (size_t)l * 8 * 6144 + 5120, (const float*)(a.ws + WS_SMALL + SO_G1) + (size_t)(l + 1 < DEPTH ? l + 1 : l) * 8 * 1024, (l + 1 < DEPTH) ? 1 : 0};
    {
        mm::MUnit45 u;
        for (int i = 0; i < 3 + 4 && S.next(i, u); ++i) {
            if (u.kind == 1 && !u.first) continue;
            if (c.tid < 256) {
                const int rr = u.i1 * 256 + c.tid; const bool valid = rr < u.i3; const int t = valid ? tokl[u.i0 * TOKCAP + rr] : 0;
                if (u.kind == 0) {
                    ((LAS int*)(c.lds + mm::TAB_OFF + u.slot * 3072))[c.tid] = t;
                    ((LAS float*)(c.lds + mm::TAB_OFF + u.slot * 3072 + 1024))[c.tid] = rstd_from16(E4.ssq, t);
                    ((LAS float*)(c.lds + mm::TAB_OFF + u.slot * 3072 + 2048))[c.tid] = valid ? E4.gates[(size_t)t * 2 + (u.i2 >> 2)] : 0.f;
                    if (valid && u.i2 == 0) ((int*)(a.ws + WS_SMALL + SO_ROWX))[t] = pre[64 + u.i0] + rr;
                } else ((LAS int*)(c.lds + mm::TAB_OFF + u.i5))[c.tid] = t;
            }
        }
        __syncthreads();
    }
    mm::mm_phase45(c.lds, S, E4, E5, c.tid, (unsigned*)(a.ws + WS_CTL) + CW_RDY + rslot * 96 * 16, (unsigned*)(a.ws + WS_CTL) + CW_TMO);
}
namespace p2 {
typedef float f32x16 __attribute__((ext_vector_type(16)));
typedef short s16x4 __attribute__((ext_vector_type(4)));
constexpr int EXT_OFF = 131072;
constexpr int ST_OFF = 131072 + 4096;
constexpr float NEG = -1e30f;
__device__ __forceinline__ int crow(int r, int hi) { return (r & 3) + 8 * (r >> 2) + 4 * hi; }
__device__ __forceinline__ s16x4 vtr(const LAS unsigned char* p) { return __builtin_bit_cast(s16x4, __builtin_amdgcn_ds_read_tr16_b64_v4i16((LAS s16x4*)p)); }
__device__ __forceinline__ unsigned cvtpk(float lo, float hi) { unsigned r; asm volatile("v_cvt_pk_bf16_f32 %0, %1, %2" : "=v"(r) : "v"(lo), "v"(hi)); return r; }
__device__ __forceinline__ float halves_max(float v) { auto rr = __builtin_amdgcn_permlane32_swap(__float_as_uint(v), __float_as_uint(v), false, false); return fmaxf(__uint_as_float(rr[0]), __uint_as_float(rr[1])); }
__device__ __forceinline__ float halves_sum(float v) { auto rr = __builtin_amdgcn_permlane32_swap(__float_as_uint(v), __float_as_uint(v), false, false); return __uint_as_float(rr[0]) + __uint_as_float(rr[1]); }
__device__ __forceinline__ u32x4 pair_swap(uint2 a, uint2 b) {
    auto r0 = __builtin_amdgcn_permlane32_swap(a.x, b.x, false, false); auto r1 = __builtin_amdgcn_permlane32_swap(a.y, b.y, false, false);
    u32x4 w; w.x = r0[0]; w.y = r1[0]; w.z = r0[1]; w.w = r1[1]; return w;
}
__device__ __forceinline__ void pair_unswap(u32x4 w, uint2& a, uint2& b) {
    auto r0 = __builtin_amdgcn_permlane32_swap(w.x, w.z, false, false); auto r1 = __builtin_amdgcn_permlane32_swap(w.y, w.w, false, false);
    a.x = r0[0]; a.y = r1[0]; b.x = r0[1]; b.y = r1[1];
}

__device__ __forceinline__ void attn_task(const bf16* qh, const bf16* kh, const bf16* vh, int b, int h, int cfg, int r, int iq0, int blk, LAS unsigned char* lds, LAS unsigned char* vbuf, bf16* osc, float* lsc, int lane) {
    const int d = 1 << (2 * cfg), q = lane & 31, hi = lane >> 5;
    const int kbase = iq0 - 128;
    const size_t rowq = ((size_t)(b * 8 + h) * SEQ + d * (iq0 + q) + r) * 64;
    bf16x8 qf[4];
#pragma unroll
    for (int d0 = 0; d0 < 4; ++d0) qf[d0] = *(const bf16x8*)(qh + rowq + 16 * d0 + 8 * hi);
    f32x16 S[5];
    const int e0_ = 31 - q + 4 * hi, sft_ = e0_ & 3;
    const LAS float* ext = (const LAS float*)(lds + EXT_OFF) + sft_ * 768 + cfg * 256 + (e0_ - sft_);
#pragma unroll
    for (int a = 0; a < 5; ++a) {
        if (kbase + 32 * a >= 0) {
            const size_t rowk = ((size_t)(b * 8 + h) * SEQ + d * (kbase + 32 * a + q) + r) * 64 + 8 * hi;
            bf16x8 kf[4];
#pragma unroll
            for (int d0 = 0; d0 < 4; ++d0) kf[d0] = *(const bf16x8*)(kh + rowk + 16 * d0);
            f32x16 s;
#pragma unroll
            for (int k8 = 0; k8 < 4; ++k8) { const f32x4 ev = *(const LAS f32x4*)(ext + 32 * a + 8 * k8); s[4 * k8] = ev[0]; s[4 * k8 + 1] = ev[1]; s[4 * k8 + 2] = ev[2]; s[4 * k8 + 3] = ev[3]; }
#pragma unroll
            for (int d0 = 0; d0 < 4; ++d0) s = __builtin_amdgcn_mfma_f32_32x32x16_bf16(kf[d0], qf[d0], s, 0, 0, 0);
            S[a] = s;
        } else {
#pragma unroll
            for (int rr = 0; rr < 16; ++rr) S[a][rr] = NEG;
        }
    }
    float m = NEG;
#pragma unroll
    for (int a = 0; a < 5; ++a)
#pragma unroll
        for (int rr = 0; rr < 16; ++rr) m = fmaxf(m, S[a][rr]);
    m = halves_max(m);
    float lsum = 0.f;
#pragma unroll
    for (int a = 0; a < 5; ++a)
#pragma unroll
        for (int rr = 0; rr < 16; ++rr) { const float p = __builtin_amdgcn_exp2f(S[a][rr] - m); S[a][rr] = p; lsum += p; }
    lsum = halves_sum(lsum);
    f32x16 o[2];
#pragma unroll
    for (int dh = 0; dh < 2; ++dh)
#pragma unroll
        for (int rr = 0; rr < 16; ++rr) o[dh][rr] = 0.f;
    const LAS unsigned char* vrd = vbuf + ((lane >> 4) & 1) * 32 + (lane & 3) * 8 + (4 * hi + ((lane & 15) >> 2)) * 64;
    u32x4 vreg[4][4];
#pragma unroll
    for (int a = 1; a < 5; ++a)
        if (kbase + 32 * a >= 0) {
#pragma unroll
            for (int i = 0; i < 4; ++i) { const int id = lane + 64 * i, kv = id >> 3, d8 = id & 7;
                vreg[a - 1][i] = *(const u32x4*)(vh + ((size_t)(b * 8 + h) * SEQ + d * (kbase + 32 * a + kv) + r) * 64 + d8 * 8); }
        }
#pragma unroll
    for (int a = 1; a < 5; ++a) {
        if (kbase + 32 * a >= 0) {
#pragma unroll
            for (int i = 0; i < 4; ++i) { const int id = lane + 64 * i, kv = id >> 3, d8 = id & 7;
                *(LAS u32x4*)(vbuf + (d8 >> 2) * 2048 + (kv >> 4) * 1024 + (kv & 15) * 64 + (d8 & 3) * 16) = vreg[a - 1][i]; }
            asm volatile("s_waitcnt lgkmcnt(0)" ::: "memory");
            const LAS unsigned char* vr = vrd;
#pragma unroll
            for (int ks = 0; ks < 2; ++ks) {
                u32x4 pw; pw.x = cvtpk(S[a][8 * ks + 0], S[a][8 * ks + 1]); pw.y = cvtpk(S[a][8 * ks + 2], S[a][8 * ks + 3]); pw.z = cvtpk(S[a][8 * ks + 4], S[a][8 * ks + 5]); pw.w = cvtpk(S[a][8 * ks + 6], S[a][8 * ks + 7]);
                const bf16x8 pb = __builtin_bit_cast(bf16x8, pw);
#pragma unroll
                for (int dh = 0; dh < 2; ++dh) {
                    const s16x4 lo = vtr(vr + dh * 2048 + ks * 1024), hh = vtr(vr + dh * 2048 + ks * 1024 + 512);
                    const bf16x8 vf = (bf16x8){lo[0], lo[1], lo[2], lo[3], hh[0], hh[1], hh[2], hh[3]};
                    o[dh] = __builtin_amdgcn_mfma_f32_32x32x16_bf16(vf, pb, o[dh], 0, 0, 0);
                }
            }
            asm volatile("s_waitcnt lgkmcnt(0)" ::: "memory");
        }
    }
    const int tl = d * (iq0 + q) + r - 512 * blk;
    const float inv = __builtin_amdgcn_rcpf(lsum);
    bf16* orow = osc + (size_t)tl * 64;
#pragma unroll
    for (int dh = 0; dh < 2; ++dh)
#pragma unroll
        for (int k2 = 0; k2 < 2; ++k2) {
            uint2 pa, pb;
            pa.x = cvtpk(o[dh][8 * k2] * inv, o[dh][8 * k2 + 1] * inv); pa.y = cvtpk(o[dh][8 * k2 + 2] * inv, o[dh][8 * k2 + 3] * inv);
            pb.x = cvtpk(o[dh][8 * k2 + 4] * inv, o[dh][8 * k2 + 5] * inv); pb.y = cvtpk(o[dh][8 * k2 + 6] * inv, o[dh][8 * k2 + 7] * inv);
            *(u32x4*)(orow + 32 * dh + 16 * k2 + 8 * hi) = pair_swap(pa, pb);
        }
    if (hi == 0) lsc[cfg * 512 + tl] = m + __builtin_amdgcn_logf(lsum);
}

__device__ __forceinline__ void stage_kv(const bf16* kh, const bf16* vh, int b, int h, int d, int r, int kb0, int R, LAS unsigned char* kl, LAS unsigned char* vl, int wave, int lane, int slot0, int nslots) {
    const int nk = R >> 3;
    for (int n = slot0 + wave; n < 2 * nk; n += nslots) {
        if (n < nk) {
            const int row = 8 * n + (lane >> 3), idx = max(kb0 + row, 0);
            {
                const int cch = (lane & 7) ^ ((row >> 1) & 7);
                const bf16* src = kh + ((size_t)(b * 8 + h) * SEQ + d * idx + r) * 64 + cch * 8;
                __builtin_amdgcn_global_load_lds((const unsigned*)src, (LAS unsigned*)(kl + n * 1024), 16, 0, 0);
            }
        } else {
            const int m = n - nk, p = m >> 1, dh = m & 1, row = 16 * p + (lane >> 2), idx = max(kb0 + row, 0);
            {
                const bf16* src = vh + ((size_t)(b * 8 + h) * SEQ + d * idx + r) * 64 + dh * 32 + (lane & 3) * 8;
                __builtin_amdgcn_global_load_lds((const unsigned*)src, (LAS unsigned*)(vl + dh * (R * 64) + p * 1024), 16, 0, 0);
            }
        }
    }
}
struct MergeArgs { const bf16* osc0; const bf16* osc2; const float* lsc; bf16* a3; float* ssq; };
template <bool WT, bool MG>
__device__ __forceinline__ void attn_task_lds(const bf16* proj, int b, int h, int cfg, int r, int iq0, int blk, const bf16x8 (&qf)[4], const LAS unsigned char* kl, const LAS unsigned char* vl, int vdh, int row0,
                                              LAS unsigned char* lds, bf16* osc, float* lsrow, int lane, const MergeArgs& mg) {
    const int d = 1 << (2 * cfg), q = lane & 31, hi = lane >> 5;
    const int kbase = iq0 - 128;
    f32x16 S[5];
    const int e0_ = 31 - q + 4 * hi, sft_ = e0_ & 3;
    const LAS float* ext = (const LAS float*)(lds + EXT_OFF) + sft_ * 768 + cfg * 256 + (e0_ - sft_);
#pragma unroll
    for (int a = 0; a < 5; ++a) {
        const int eo = (kbase + 32 * a >= 0) ? 32 * a : 160;
#pragma unroll
        for (int k8 = 0; k8 < 4; ++k8) { const f32x4 ev = *(const LAS f32x4*)(ext + eo + 8 * k8); S[a][4 * k8] = ev[0]; S[a][4 * k8 + 1] = ev[1]; S[a][4 * k8 + 2] = ev[2]; S[a][4 * k8 + 3] = ev[3]; }
    }
    const int tl = d * (iq0 + q) + r - 512 * blk;
    u32x4 A0[2][2], A2[2][2]; float l0 = 0.f, l2 = 0.f;
    if constexpr (MG) {
        l0 = mg.lsc[tl]; l2 = mg.lsc[1024 + tl];
#pragma unroll
        for (int dh = 0; dh < 2; ++dh)
#pragma unroll
            for (int k2 = 0; k2 < 2; ++k2) { A0[dh][k2] = *(const u32x4*)(mg.osc0 + (size_t)tl * 64 + 32 * dh + 16 * k2 + 8 * hi); A2[dh][k2] = *(const u32x4*)(mg.osc2 + (size_t)tl * 64 + 32 * dh + 16 * k2 + 8 * hi); }
    }
    {
        bf16x8 kf[2][4];
#define AT_LDK(buf, a_) do { const int row_ = row0 + 32 * (a_) + q; const LAS unsigned char* kr_ = kl + row_ * 128; const int sw_ = (row_ >> 1) & 7; \
            _Pragma("unroll") for (int d0 = 0; d0 < 4; ++d0) kf[buf][d0] = *(const LAS bf16x8*)(kr_ + (((2 * d0 + hi) ^ sw_) << 4)); } while (0)
        AT_LDK(0, 0);
#pragma unroll
        for (int a = 0; a < 5; ++a) {
            if (a < 4) AT_LDK((a + 1) & 1, a + 1);
#pragma unroll
            for (int d0 = 0; d0 < 4; ++d0) S[a] = __builtin_amdgcn_mfma_f32_32x32x16_bf16(kf[a & 1][d0], qf[d0], S[a], 0, 0, 0);
        }
#undef AT_LDK
    }
    float m = NEG;
#pragma unroll
    for (int a = 0; a < 5; ++a)
#pragma unroll
        for (int rr = 0; rr < 16; ++rr) m = fmaxf(m, S[a][rr]);
    m = halves_max(m);
    float lsum = 0.f;
#pragma unroll
    for (int a = 0; a < 5; ++a)
#pragma unroll
        for (int rr = 0; rr < 16; ++rr) { const float p = __builtin_amdgcn_exp2f(S[a][rr] - m); S[a][rr] = p; lsum += p; }
    lsum = halves_sum(lsum);
    f32x16 o[2];
#pragma unroll
    for (int dh = 0; dh < 2; ++dh)
#pragma unroll
        for (int rr = 0; rr < 16; ++rr) o[dh][rr] = 0.f;
    const LAS unsigned char* vrd = vl + ((lane >> 4) & 1) * 32 + (lane & 3) * 8 + (4 * hi + ((lane & 15) >> 2)) * 64 + (row0 >> 4) * 1024;
    {
        s16x4 vr[2][4];
#define AT_LDV(buf, st_) do { _Pragma("unroll") for (int dh = 0; dh < 2; ++dh) { const LAS unsigned char* vp_ = vrd + dh * vdh + (st_) * 1024; vr[buf][2 * dh] = vtr(vp_); vr[buf][2 * dh + 1] = vtr(vp_ + 512); } } while (0)
        AT_LDV(0, 0);
#pragma unroll
        for (int st = 0; st < 10; ++st) {
            if (st < 9) AT_LDV((st + 1) & 1, st + 1);
            const int a = st >> 1, ks = st & 1;
            u32x4 pw; pw.x = cvtpk(S[a][8 * ks + 0], S[a][8 * ks + 1]); pw.y = cvtpk(S[a][8 * ks + 2], S[a][8 * ks + 3]); pw.z = cvtpk(S[a][8 * ks + 4], S[a][8 * ks + 5]); pw.w = cvtpk(S[a][8 * ks + 6], S[a][8 * ks + 7]);
            const bf16x8 pb = __builtin_bit_cast(bf16x8, pw);
#pragma unroll
            for (int dh = 0; dh < 2; ++dh) {
                const s16x4 lo = vr[st & 1][2 * dh], hh = vr[st & 1][2 * dh + 1];
                const bf16x8 vf = (bf16x8){lo[0], lo[1], lo[2], lo[3], hh[0], hh[1], hh[2], hh[3]};
                o[dh] = __builtin_amdgcn_mfma_f32_32x32x16_bf16(vf, pb, o[dh], 0, 0, 0);
            }
        }
#undef AT_LDV
    }
    const float inv = __builtin_amdgcn_rcpf(lsum);
    if constexpr (MG) {
        const float l1 = m + __builtin_amdgcn_logf(lsum);
        const float mx = fmaxf(l0, fmaxf(l1, l2));
        float w0 = __builtin_amdgcn_exp2f(l0 - mx), w1 = __builtin_amdgcn_exp2f(l1 - mx), w2 = __builtin_amdgcn_exp2f(l2 - mx);
        const float iw = __builtin_amdgcn_rcpf(w0 + w1 + w2); w0 *= iw; w2 *= iw; w1 *= iw * inv;
        float ss = 0.f;
        bf16* arow = mg.a3 + (size_t)tl * 1024;
#pragma unroll
        for (int dh = 0; dh < 2; ++dh)
#pragma unroll
            for (int k2 = 0; k2 < 2; ++k2) {
                uint2 x0[2], x2[2], pk[2]; pair_unswap(A0[dh][k2], x0[0], x0[1]); pair_unswap(A2[dh][k2], x2[0], x2[1]);
#pragma unroll
                for (int i = 0; i < 2; ++i) {
                    const int ob = 8 * k2 + 4 * i;
                    const float v0 = w1 * o[dh][ob] + w0 * __uint_as_float(x0[i].x << 16) + w2 * __uint_as_float(x2[i].x << 16);
                    const float v1 = w1 * o[dh][ob + 1] + w0 * __uint_as_float(x0[i].x & 0xffff0000u) + w2 * __uint_as_float(x2[i].x & 0xffff0000u);
                    const float v2 = w1 * o[dh][ob + 2] + w0 * __uint_as_float(x0[i].y << 16) + w2 * __uint_as_float(x2[i].y << 16);
                    const float v3 = w1 * o[dh][ob + 3] + w0 * __uint_as_float(x0[i].y & 0xffff0000u) + w2 * __uint_as_float(x2[i].y & 0xffff0000u);
                    pk[i].x = cvtpk(v0, v1); pk[i].y = cvtpk(v2, v3);
                    ss += (v0 * v0 + v1 * v1) + (v2 * v2 + v3 * v3);
                }
                *(u32x4*)(arow + 32 * dh + 16 * k2 + 8 * hi) = pair_swap(pk[0], pk[1]);
            }
        ss = halves_sum(ss);
        if (hi == 0) mg.ssq[(size_t)tl * 16] = ss;
        return;
    }
    bf16* orow = osc + (size_t)tl * 64;
#pragma unroll
    for (int dh = 0; dh < 2; ++dh)
#pragma unroll
        for (int k2 = 0; k2 < 2; ++k2) {
            uint2 pa, pb;
            pa.x = cvtpk(o[dh][8 * k2] * inv, o[dh][8 * k2 + 1] * inv); pa.y = cvtpk(o[dh][8 * k2 + 2] * inv, o[dh][8 * k2 + 3] * inv);
            pb.x = cvtpk(o[dh][8 * k2 + 4] * inv, o[dh][8 * k2 + 5] * inv); pb.y = cvtpk(o[dh][8 * k2 + 6] * inv, o[dh][8 * k2 + 7] * inv);
            if (WT) { __hip_atomic_store((unsigned long long*)(orow + 32 * dh + 16 * k2 + 4 * hi), ((unsigned long long)pa.y << 32) | pa.x, __ATOMIC_RELAXED, __HIP_MEMORY_SCOPE_AGENT);
                      __hip_atomic_store((unsigned long long*)(orow + 32 * dh + 16 * k2 + 8 + 4 * hi), ((unsigned long long)pb.y << 32) | pb.x, __ATOMIC_RELAXED, __HIP_MEMORY_SCOPE_AGENT); }
            else *(u32x4*)(orow + 32 * dh + 16 * k2 + 8 * hi) = pair_swap(pa, pb);
        }
    if (hi == 0) { const float lv = m + __builtin_amdgcn_logf(lsum);
        if (WT) __hip_atomic_store(lsrow + tl, lv, __ATOMIC_RELAXED, __HIP_MEMORY_SCOPE_AGENT); else lsrow[tl] = lv; }
}

__device__ __forceinline__ void attn_unit(const Args& a, const Ctx& c, int l, int cslot) {
    const bf16* proj = (const bf16*)(a.ws + WS_PROJ); bf16* A3 = (bf16*)(a.ws + WS_A3);
    const bf16* qh = (const bf16*)(a.ws + WS_QH); const bf16* kh = (const bf16*)(a.ws + WS_KH); const bf16* vh = (const bf16*)(a.ws + WS_VH);
    float* ssqc = (float*)(a.ws + WS_SMALL + SO_SSQC);
    const int xcd = c.wg & 7, j = c.wg >> 3, p = xcd * 8 + (j >> 2), blk = j & 3, b = p >> 3, h = p & 7;
    bf16* osc01 = (bf16*)(a.ws + WS_XA + (size_t)xcd * 4 * MiB) + (size_t)j * (2 * 512 * 64); bf16* osc2 = (bf16*)(a.ws + WS_ACTX + (size_t)xcd * 4 * MiB + 256 * 1024) + (size_t)j * (512 * 64);
    float* lsc = (float*)(a.ws + WS_ACTX + (size_t)xcd * 4 * MiB) + (size_t)j * (3 * 512);
    {
        LAS float* ext = (LAS float*)(c.lds + EXT_OFF); const float* relb = a.in[I_RELB];
        for (int x = c.tid; x < 3 * 256; x += NTHREADS) {
            const int cfg = x >> 8, xx = x & 255, rel = 159 - xx;
            ext[x] = (rel >= 0 && rel <= 128) ? relb[(int)T5B[cfg][rel] * 8 + h] * LOG2E : NEG;
        }
        __syncthreads();
        for (int x = c.tid; x < 3 * 768; x += NTHREADS) {
            const int s = 1 + x / 768, y = x % 768;
            ext[s * 768 + y] = ((y & 255) + s < 256) ? ext[y + s] : NEG;
        }
    }
    const int q = c.lane & 31, hi = c.lane >> 5;
    __syncthreads();
    LAS unsigned char* vbuf = c.lds + 98304 + c.wave * 4096;
    const MergeArgs mga{osc01, osc2, lsc, A3 + ((size_t)b * SEQ + 512 * blk) * 1024 + 512 + h * 64, ssqc + ((size_t)b * SEQ + 512 * blk) * 16 + 8 + h};
#pragma unroll 1
    for (int hf = 0; hf < 2; ++hf) {
        const int kb0 = 512 * blk + 256 * hf - 128, iq0 = 512 * blk + 256 * hf + 32 * c.wave;
        stage_kv(kh, vh, b, h, 1, 0, kb0, 384, c.lds, c.lds + 49152, c.wave, c.lane, 0, 8);
        attn_task(qh, kh, vh, b, h, 2, 2 * c.wave + hf, 32 * blk, blk, c.lds, vbuf, osc2, lsc, c.lane);
        bf16x8 qf[4];
        const size_t rowq = ((size_t)(b * 8 + h) * SEQ + iq0 + q) * 64;
#pragma unroll
        for (int d0 = 0; d0 < 4; ++d0) qf[d0] = *(const bf16x8*)(qh + rowq + 16 * d0 + 8 * hi);
        asm volatile("s_waitcnt vmcnt(0)" ::: "memory");
        __syncthreads();
        attn_task_lds<false, false>(proj, b, h, 0, 0, iq0, blk, qf, c.lds, c.lds + 49152, 384 * 64, 32 * c.wave, c.lds, osc01, lsc, c.lane, mga);
        __syncthreads();
    }
#pragma unroll 1
    for (int rd_ = 0; rd_ < ((P2_REP & 2) ? 4 : 2); ++rd_) { const int rd = rd_ & 1;
        const int kb0 = 128 * blk - 128, s = c.wave >> 2, r = 2 * rd + s, iq0 = 128 * blk + 32 * (c.wave & 3);
        bf16x8 qf[4];
        const size_t rowq = ((size_t)(b * 8 + h) * SEQ + 4 * (iq0 + q) + r) * 64;
#pragma unroll
        for (int d0 = 0; d0 < 4; ++d0) qf[d0] = *(const bf16x8*)(qh + rowq + 16 * d0 + 8 * hi);
        stage_kv(kh, vh, b, h, 4, 2 * rd, kb0, 256, c.lds, c.lds + 65536, c.wave, c.lane, 0, 8);
        stage_kv(kh, vh, b, h, 4, 2 * rd + 1, kb0, 256, c.lds + 32768, c.lds + 65536 + 32768, c.wave, c.lane, 0, 8);
        asm volatile("s_waitcnt vmcnt(0)" ::: "memory");
        __syncthreads();
        attn_task_lds<false, true>(proj, b, h, 1, r, iq0, blk, qf, c.lds + s * 32768, c.lds + 65536 + s * 32768, 256 * 64, 32 * (c.wave & 3), c.lds, osc01 + 512 * 64, lsc + 512, c.lane, mga);
        __syncthreads();
    }
    __syncthreads();
}

__device__ __forceinline__ void gmlp_unit(const Args& a, const Ctx& c, int l) {
    const bf16* proj = (const bf16*)(a.ws + WS_PROJ); bf16* A3 = (bf16*)(a.ws + WS_A3); float* ssqc = (float*)(a.ws + WS_SMALL + SO_SSQC);
    const bf16* wsp = (const bf16*)(a.ws + WS_WS) + (size_t)l * 8 * 128 * 128;
    const float* lng = a.in[I_LNG] + l * 512; const float* lnb = a.in[I_LNB] + l * 512; const float* gbs = a.in[I_GBS] + l * 8 * 128;
    const int bn = (c.wg & 7) * 16 + (c.wg >> 4), hf = (c.wg >> 3) & 1, t0 = bn * CHUNK;
    const int gl = c.wave & 3, th = c.wave >> 2, g = 4 * hf + gl, q = c.lane & 31, hi = c.lane >> 5;
    u32x4 raw[16];
#pragma unroll
    for (int i = 0; i < 16; ++i) raw[i] = *(const u32x4*)(proj + (size_t)(t0 + c.wave * 16 + i) * 1024 + 512 + c.lane * 8);
    const f32x4 g0 = *(const f32x4*)(lng + c.lane * 8), g1 = *(const f32x4*)(lng + c.lane * 8 + 4), b0 = *(const f32x4*)(lnb + c.lane * 8), b1 = *(const f32x4*)(lnb + c.lane * 8 + 4);
    bf16x8 wf[2][8]; u32x4 uw[2][2][2]; float bias[2];
#pragma unroll
    for (int tt = 0; tt < 2; ++tt) {
        const int t = 32 * (2 * th + tt) + q;
        const bf16* wrow = wsp + ((size_t)g * 128 + t) * 128 + 8 * hi;
#pragma unroll
        for (int ks = 0; ks < 8; ++ks) wf[tt][ks] = *(const bf16x8*)(wrow + 16 * ks);
#pragma unroll
        for (int eh = 0; eh < 2; ++eh)
#pragma unroll
            for (int k2 = 0; k2 < 2; ++k2) uw[tt][eh][k2] = *(const u32x4*)(proj + ((size_t)t0 + t) * 1024 + g * 64 + 32 * eh + 16 * k2 + 8 * hi);
        bias[tt] = gbs[g * 128 + t];
    }
    {
        const int e8 = c.lane & 7, glw = (c.lane >> 3) & 3;
#pragma unroll
        for (int i = 0; i < 16; ++i) {
            float v[8]; float sm = 0.f, sq = 0.f;
#pragma unroll
            for (int e = 0; e < 4; ++e) { v[2 * e] = __uint_as_float(raw[i][e] << 16); v[2 * e + 1] = __uint_as_float(raw[i][e] & 0xffff0000u); sm += v[2 * e] + v[2 * e + 1]; sq += v[2 * e] * v[2 * e] + v[2 * e + 1] * v[2 * e + 1]; }
            sm = wave_sum(sm); sq = wave_sum(sq);
            const float mu = sm * (1.0f / 512.0f), var = fmaxf(sq * (1.0f / 512.0f) - mu * mu, 0.f), rs = rsqrtf(var + EPS);
            if (hi == hf) {
                const int s = c.wave * 16 + i;
                u32x4 w;
                w.x = cvtpk((v[0] - mu) * rs * g0[0] + b0[0], (v[1] - mu) * rs * g0[1] + b0[1]); w.y = cvtpk((v[2] - mu) * rs * g0[2] + b0[2], (v[3] - mu) * rs * g0[3] + b0[3]);
                w.z = cvtpk((v[4] - mu) * rs * g1[0] + b1[0], (v[5] - mu) * rs * g1[1] + b1[1]); w.w = cvtpk((v[6] - mu) * rs * g1[2] + b1[2], (v[7] - mu) * rs * g1[3] + b1[3]);
                *(LAS u32x4*)(c.lds + glw * 16384 + (e8 >> 2) * 8192 + (s >> 4) * 1024 + (s & 15) * 64 + (e8 & 3) * 16) = w;
            }
        }
    }
    __syncthreads();
    {
        const LAS unsigned char* vr = c.lds + gl * 16384 + ((c.lane >> 4) & 1) * 32 + (c.lane & 3) * 8 + (4 * hi + ((c.lane & 15) >> 2)) * 64;
#pragma unroll
        for (int tt = 0; tt < 2; ++tt) {
            const int tti = 2 * th + tt, t = 32 * tti + q;
            const size_t tg = (size_t)t0 + t;
            f32x16 acc[2];
#pragma unroll
            for (int eh = 0; eh < 2; ++eh)
#pragma unroll
                for (int rr = 0; rr < 16; ++rr) acc[eh][rr] = 0.f;
#pragma unroll
            for (int ks = 0; ks < 8; ++ks) {
                if (ks < 2 * tti + 2) {
#pragma unroll
                    for (int eh = 0; eh < 2; ++eh) {
                        const s16x4 lo = vtr(vr + eh * 8192 + ks * 1024), hh = vtr(vr + eh * 8192 + ks * 1024 + 512);
                        const bf16x8 vf = (bf16x8){lo[0], lo[1], lo[2], lo[3], hh[0], hh[1], hh[2], hh[3]};
                        acc[eh] = __builtin_amdgcn_mfma_f32_32x32x16_bf16(vf, wf[tt][ks], acc[eh], 0, 0, 0);
                    }
                }
            }
            float ss = 0.f;
#pragma unroll
            for (int eh = 0; eh < 2; ++eh)
#pragma unroll
                for (int k2 = 0; k2 < 2; ++k2) {
                    uint2 uu[2], pk[2]; pair_unswap(uw[tt][eh][k2], uu[0], uu[1]);
#pragma unroll
                    for (int i = 0; i < 2; ++i) { const int k4 = 2 * k2 + i; const uint2 uv = uu[i];
                        const float o0 = (acc[eh][4 * k4] + bias[tt]) * __uint_as_float(uv.x << 16), o1 = (acc[eh][4 * k4 + 1] + bias[tt]) * __uint_as_float(uv.x & 0xffff0000u);
                        const float o2 = (acc[eh][4 * k4 + 2] + bias[tt]) * __uint_as_float(uv.y << 16), o3 = (acc[eh][4 * k4 + 3] + bias[tt]) * __uint_as_float(uv.y & 0xffff0000u);
                        pk[i].x = cvtpk(o0, o1); pk[i].y = cvtpk(o2, o3);
                        ss += (o0 * o0 + o1 * o1) + (o2 * o2 + o3 * o3); }
                    *(u32x4*)(A3 + tg * 1024 + g * 64 + 32 * eh + 16 * k2 + 8 * hi) = pair_swap(pk[0], pk[1]);
                }
            ss = halves_sum(ss);
            if (hi == 0) ssqc[tg * 16 + g] = ss;
        }
    }
    __syncthreads();
}
}
__device__ __forceinline__ void phase_p2_fast(const Args& a, const Ctx& c, int l, int cslot) {
    p2::attn_unit(a, c, l, cslot);
    p2::gmlp_unit(a, c, l);
    if ((DUP_MASK >> 10) & 1) p2::gmlp_unit(a, c, l);
}

constexpr int NPL = MERGE45 ? 4 : 5;
constexpr int NPHASE = 1 + NPL * DEPTH + 1;
__device__ __forceinline__ Ctx make_ctx(int tid, LAS unsigned char* lds, int zs) {
    Ctx c; c.lds = lds; c.tid = tid; c.lane = tid & 63; c.wave = __builtin_amdgcn_readfirstlane(tid >> 6);
    c.wg = (int)blockIdx.x + zs; c.nwg = (int)gridDim.x + zs; c.gw = c.wg * NWAVES + c.wave; c.ngw = c.nwg * NWAVES; c.gtid = c.wg * NTHREADS + tid; c.ngt = c.nwg * NTHREADS;
    return c;
}
__global__ void __launch_bounds__(NTHREADS, 2) fwd_kernel(Args a0) {
    extern __shared__ __attribute__((aligned(16))) unsigned char lds_raw[];
    LAS unsigned char* const lds0 = (LAS unsigned char*)lds_raw;
    volatile LAS unsigned* MISC = (volatile LAS unsigned*)(lds0 + LDSCTL_OFF);
    int tid_ = threadIdx.x;
    for (int u = tid_; u < (LDS_BYTES - LDSCTL_OFF) / 4; u += NTHREADS) MISC[u] = 0u;
    __syncthreads();
    const int lo = a0.ph_lo, hi = a0.ph_hi;
    XcdBarrier bar; bar.bar = (unsigned*)(a0.ws + WS_CTL) + CW_BAR; bar.x = 0; bar.st = MISC + 8;
    if (hi - lo > 1) bar = xcd_barrier_post((unsigned*)(a0.ws + WS_CTL) + CW_BAR, MISC + 8, tid_);
    if (tid_ == 0) __hip_atomic_store((unsigned*)(a0.ws + WS_CTL) + CW_XT + blockIdx.x, xb_xcc_id() + 1u, __ATOMIC_RELAXED, __HIP_MEMORY_SCOPE_AGENT);
    int pure = 0;
    int ph = 0;
#define RUN_PHASE(kind, body) do { if (ph >= lo && ph < hi) { for (int rep_ = 0; rep_ < (((DUP_MASK >> (kind)) & 1) ? 2 : 1); ++rep_) { int zs_ = 0; asm volatile("" : "+s"(zs_)); Args a = a0; \
        _Pragma("unroll") for (int i_ = 0; i_ < 21; ++i_) a.in[i_] = a0.in[i_] + zs_; a.out = a0.out + zs_; a.ws = a0.ws + zs_; \
        asm volatile("" : "+v"(tid_)); const Ctx c = make_ctx(tid_, lds0 + zs_, zs_); body; if (ph + 1 < hi || rep_ == 0 && ((DUP_MASK >> (kind)) & 1)) { \
            if (((kind) == 2 || (kind) == 3) && pure && DUP_MASK == 0) group_barrier((unsigned*)(a0.ws + WS_CTL), ((ph - 1) / NPL) * 2 + ((kind) - 2), (int)blockIdx.x + zs_, tid_); else xcd_barrier(bar, tid_); } } } ++ph; } while (0)
    RUN_PHASE(0, { phase_p0a(a, c); phase_p0b(a, c); });
    if (lo == 0 && hi == NPHASE && gridDim.x == 256) {
        if (tid_ < 256) { unsigned* xt = (unsigned*)(a0.ws + WS_CTL) + CW_XT; const unsigned v = xb_ld(xt + tid_), r = xb_ld(xt + (tid_ & 7)); if (v != r || v == 0u) MISC[13] = 1u; }
        __syncthreads();
        pure = __builtin_amdgcn_readfirstlane(MISC[13] == 0u ? 1 : 0);
    }
    for (int l = 0; l < DEPTH; ++l) {
        RUN_PHASE(2, phase_p1_fast(a, c, l));
        RUN_PHASE(3, phase_p2_fast(a, c, l, l + 2 * rep_));
        RUN_PHASE(4, phase_p3_fast(a, c, l, l + 2 * rep_, pure));
#if MERGE45
        RUN_PHASE(6, phase_p45(a, c, l, l + 2 * rep_, pure));
#else
        RUN_PHASE(6, phase_p4_fast(a, c, l));
        RUN_PHASE(7, phase_p5_fast(a, c, l));
#endif
    }
    RUN_PHASE(8, phase_p6(a, c));
#undef RUN_PHASE
}

extern "C" void kernel_launch(void* const* d_in, const int* in_sizes, int n_in, void* d_out, int out_size, void* d_ws, size_t ws_size, hipStream_t stream) {
    static int grid = 0;
    if (grid == 0) {
        if (n_in != 21 || out_size != T * D || ws_size < WS_END) { fprintf(stderr, "kernel_launch: unexpected shapes (n_in %d, out %d, ws %zu)\n", n_in, out_size, ws_size); grid = -1; return; }
        int dev = 0, cus = 0, per_cu = 0;
        if (hipGetDevice(&dev) != hipSuccess || hipDeviceGetAttribute(&cus, hipDeviceAttributeMultiprocessorCount, dev) != hipSuccess) { grid = -1; return; }
        if (hipFuncSetAttribute((const void*)fwd_kernel, hipFuncAttributeMaxDynamicSharedMemorySize, LDS_BYTES) != hipSuccess) { fprintf(stderr, "kernel_launch: hipFuncSetAttribute failed\n"); grid = -1; return; }
        if (hipOccupancyMaxActiveBlocksPerMultiprocessor(&per_cu, (const void*)fwd_kernel, NTHREADS, LDS_BYTES) != hipSuccess || per_cu < 1)
            fprintf(stderr, "kernel_launch: occupancy query reports %d workgroups per CU\n", per_cu);
        (void)hipGetLastError();
        grid = cus;
    }
    if (grid < 0) return;
    if (hipMemsetAsync((char*)d_ws + WS_CTL, 0, CTL_BYTES, stream) != hipSuccess) return;
    Args a{};
    for (int i = 0; i < 21; ++i) a.in[i] = (const float*)d_in[i];
    a.out = (float*)d_out; a.ws = (unsigned char*)d_ws;
#if N_LAUNCH_MODE == 1
    a.ph_lo = 0; a.ph_hi = NPHASE;
    hipLaunchKernelGGL(fwd_kernel, dim3(grid), dim3(NTHREADS), LDS_BYTES, stream, a);
#else
    for (int ph = 0; ph < NPHASE; ++ph) {
        a.ph_lo = ph; a.ph_hi = ph + 1;
        hipLaunchKernelGGL(fwd_kernel, dim3(grid), dim3(NTHREADS), LDS_BYTES, stream, a);
    }
#endif
}
```

```cpp
#include <hip/hip_runtime.h>
#include <cstdio>
#include <cstdint>

constexpr int D = 1024, BATCH = 8, SEQ = 2048, T = BATCH * SEQ, DEPTH = 2;
constexpr int AW = 512, HD = 64, INC = 2560, CHUNK = 128;
constexpr int NE = 16, DE = 512, NBKT = 24, TOKCAP = 16384;
constexpr float EPS = 1e-6f;
constexpr float LOG2E = 1.4426950408889634f;
constexpr float C2 = 0.125f * LOG2E;
#ifndef FAST_P2
#define FAST_P2 1
#endif
#ifndef MERGE45
#define MERGE45 1
#endif
#ifndef EPI_TWICE
#define EPI_TWICE 0
#endif
#ifndef P2_REP
#define P2_REP 0
#endif
#ifndef DUP_MASK
#define DUP_MASK 0
#endif
#ifndef N_LAUNCH_MODE
#define N_LAUNCH_MODE 1
#endif

constexpr size_t MiB = 1u << 20;
constexpr size_t WS_CTL = 0, CTL_BYTES = 131072;
constexpr size_t WS_SMALL = 1 * MiB;
constexpr size_t WS_WIN = 9 * MiB;
constexpr size_t WS_WOUT = 19 * MiB;
constexpr size_t WS_WS = 23 * MiB;
constexpr size_t WS_WGU = 24 * MiB;
constexpr size_t WS_WD = 88 * MiB;
constexpr size_t WS_XA = 120 * MiB;
constexpr size_t WS_X2B = 152 * MiB;
constexpr size_t WS_ACTX = 184 * MiB;
constexpr size_t WS_PROJ = 216 * MiB;
constexpr size_t WS_QH = WS_PROJ + 32 * MiB, WS_KH = WS_PROJ + 48 * MiB, WS_VH = WS_PROJ + 64 * MiB;
constexpr size_t WS_A3 = 296 * MiB;
constexpr size_t WS_END = 328 * MiB;
constexpr size_t WS_ACT = WS_PROJ;
constexpr size_t SO_MODV = 0;
constexpr size_t SO_G1 = 512 * 1024;
constexpr size_t SO_G2 = 576 * 1024;
constexpr size_t SO_BIAS1 = 640 * 1024;
constexpr size_t SO_RBIAS = 800 * 1024;
constexpr size_t SO_BIASGU = 1 * MiB;
constexpr size_t SO_GATES = 2 * MiB;
constexpr size_t SO_TOKL = 2 * MiB + 512 * 1024;
constexpr size_t SO_SSQA = 4 * MiB;
constexpr size_t SO_SSQB = 5 * MiB;
constexpr size_t SO_ROWX = 7 * MiB + 512 * 1024;
constexpr size_t SO_RWT = 7 * MiB;
constexpr size_t SO_SSQC = 6 * MiB;
constexpr int CW_TMO = 0, CW_CNT = 64  , CW_BAR = 1024, CW_RDY = 8192  , CW_MOD = 32  , CW_SIB = 24576  , CW_PNL = 16384  ,
              CW_XT = 28672  , CW_GRP = 29184  ;

constexpr int NWAVES = 8, NTHREADS = 512;
constexpr int LDS_BYTES = 162816;
constexpr int LDSCTL_OFF = 143360;

#define GAS __attribute__((address_space(1)))
#define LAS __attribute__((address_space(3)))
typedef unsigned short bf16;
typedef short bf16x8 __attribute__((ext_vector_type(8)));
typedef float f32x4 __attribute__((ext_vector_type(4)));
typedef unsigned u32x4 __attribute__((ext_vector_type(4)));
#define LDS_WAIT() asm volatile("s_waitcnt lgkmcnt(0)" ::: "memory")

__device__ __forceinline__ float bf2f(bf16 b) { return __uint_as_float((unsigned)b << 16); }
__device__ __forceinline__ unsigned f2bf(float f) { unsigned u = __float_as_uint(f); return (u + 0x7fffu + ((u >> 16) & 1u)) >> 16; }
__device__ __forceinline__ unsigned pk2(float lo, float hi) { unsigned r; asm volatile("v_cvt_pk_bf16_f32 %0, %1, %2" : "=v"(r) : "v"(lo), "v"(hi)); return r; }
__device__ __forceinline__ float wave_sum(float v) {
    v += __builtin_bit_cast(float, __builtin_amdgcn_update_dpp(0, __builtin_bit_cast(int, v), 0xB1, 0xF, 0xF, true));
    v += __builtin_bit_cast(float, __builtin_amdgcn_update_dpp(0, __builtin_bit_cast(int, v), 0x4E, 0xF, 0xF, true));
    v += __builtin_bit_cast(float, __builtin_amdgcn_update_dpp(0, __builtin_bit_cast(int, v), 0x141, 0xF, 0xF, true));
    v += __builtin_bit_cast(float, __builtin_amdgcn_update_dpp(0, __builtin_bit_cast(int, v), 0x140, 0xF, 0xF, true));
    { auto rr = __builtin_amdgcn_permlane16_swap(__float_as_uint(v), __float_as_uint(v), false, false); v = __uint_as_float(rr[0]) + __uint_as_float(rr[1]); }
    { auto rr = __builtin_amdgcn_permlane32_swap(__float_as_uint(v), __float_as_uint(v), false, false); v = __uint_as_float(rr[0]) + __uint_as_float(rr[1]); }
    return v;
}
__device__ __forceinline__ float rows_sum(float v) {
    { auto rr = __builtin_amdgcn_permlane16_swap(__float_as_uint(v), __float_as_uint(v), false, false); v = __uint_as_float(rr[0]) + __uint_as_float(rr[1]); }
    { auto rr = __builtin_amdgcn_permlane32_swap(__float_as_uint(v), __float_as_uint(v), false, false); v = __uint_as_float(rr[0]) + __uint_as_float(rr[1]); }
    return v;
}
__device__ __forceinline__ float rows_max(float v) {
    { auto rr = __builtin_amdgcn_permlane16_swap(__float_as_uint(v), __float_as_uint(v), false, false); v = fmaxf(__uint_as_float(rr[0]), __uint_as_float(rr[1])); }
    { auto rr = __builtin_amdgcn_permlane32_swap(__float_as_uint(v), __float_as_uint(v), false, false); v = fmaxf(__uint_as_float(rr[0]), __uint_as_float(rr[1])); }
    return v;
}
__device__ __forceinline__ float oct_sum(float v) {
    v += __builtin_bit_cast(float, __builtin_amdgcn_update_dpp(0, __builtin_bit_cast(int, v), 0xB1, 0xF, 0xF, true));
    v += __builtin_bit_cast(float, __builtin_amdgcn_update_dpp(0, __builtin_bit_cast(int, v), 0x4E, 0xF, 0xF, true));
    v += __builtin_bit_cast(float, __builtin_amdgcn_update_dpp(0, __builtin_bit_cast(int, v), 0x141, 0xF, 0xF, true));
    return v;
}
__device__ __forceinline__ float gelu_exact(float x) { return 0.5f * x * (1.0f + erff(x * 0.70710678118654752f)); }
__device__ __forceinline__ float silu_f(float x) { return x / (1.0f + __expf(-x)); }

__device__ const unsigned char T5B[3][132] = {
{0,1,2,3,4,5,6,7,8,9,10,11,12,13,14,15,16,16,16,16,16,16,17,17,17,17,17,17,17,17,18,18,18,18,18,18,18,18,18,18,19,19,19,19,19,19,19,19,19,19,19,19,19,19,20,20,20,20,20,20,20,20,20,20,20,20,20,20,20,20,20,20,20,21,21,21,21,21,21,21,21,21,21,21,21,21,21,21,21,21,21,21,21,21,21,21,21,21,21,22,22,22,22,22,22,22,22,22,22,22,22,22,22,22,22,22,22,22,22,22,22,22,22,22,22,22,22,22,22,0,0,0},
{0,4,8,12,16,16,17,17,18,18,19,19,19,19,20,20,20,20,20,21,21,21,21,21,21,22,22,22,22,22,22,22,22,22,23,23,23,23,23,23,23,23,23,23,23,23,24,24,24,24,24,24,24,24,24,24,24,24,24,24,24,24,25,25,25,25,25,25,25,25,25,25,25,25,25,25,25,25,25,25,25,25,25,26,26,26,26,26,26,26,26,26,26,26,26,26,26,26,26,26,26,26,26,26,26,26,26,26,26,26,26,26,26,27,27,27,27,27,27,27,27,27,27,27,27,27,27,27,27,0,0,0},
{0,16,18,19,20,21,21,22,22,23,23,23,24,24,24,24,25,25,25,25,25,26,26,26,26,26,26,26,26,27,27,27,27,27,27,27,27,27,27,28,28,28,28,28,28,28,28,28,28,28,28,28,29,29,29,29,29,29,29,29,29,29,29,29,29,29,29,29,29,29,30,30,30,30,30,30,30,30,30,30,30,30,30,30,30,30,30,30,30,30,30,30,30,30,30,31,31,31,31,31,31,31,31,31,31,31,31,31,31,31,31,31,31,31,31,31,31,31,31,31,31,31,31,31,31,31,31,31,31,0,0,0}};

#define XB_TMO      128
#define XB_XCNT(j)  (256  + 64 * (j))
#define XB_XSUB(j)  (1280 + 64 * (j))
#define XB_XGEN(j)  (2304 + 64 * (j))
#define XB_TOP      3328
#define XB_TOPGEN   3392
#define XCD_BAR_WORDS 3456
#define XB_SPIN_CAP (1u << 18)

__device__ __forceinline__ unsigned xb_ld(unsigned* p)              { return __hip_atomic_load(p, __ATOMIC_RELAXED, __HIP_MEMORY_SCOPE_AGENT); }
__device__ __forceinline__ unsigned xb_add(unsigned* p, unsigned v) { return __hip_atomic_fetch_add(p, v, __ATOMIC_RELAXED, __HIP_MEMORY_SCOPE_AGENT); }
__device__ __forceinline__ unsigned xb_xcc_id() { return (unsigned)__builtin_amdgcn_s_getreg((3 << 11) | 20) & 0xFu; }
#define XB_SPIN(cond, bar) do { unsigned _sp = 0; while (cond) { __builtin_amdgcn_s_sleep(1); \
    if ((++_sp & 255u) == 0u) { if (xb_ld(&(bar)[XB_TMO])) break; if (_sp > XB_SPIN_CAP) { atomicAdd(&(bar)[XB_TMO], 1u); break; } } } } while (0)

struct XcdBarrier {
    unsigned* bar; unsigned x;
    volatile LAS unsigned* st;
};
__device__ __forceinline__ XcdBarrier xcd_barrier_post(unsigned* bar, volatile LAS unsigned* st, int tid) {
    XcdBarrier b; b.bar = bar; b.x = xb_xcc_id(); b.st = st;
    if (tid == 0) (void)xb_add(&bar[XB_XCNT(b.x)], 1u);
    return b;
}
__device__ __forceinline__ void xcd_barrier_complete(unsigned* bar, unsigned x, unsigned& nloc, unsigned& nx) {
    const unsigned G = gridDim.x * gridDim.y * gridDim.z;
    unsigned sum, cnt, mine, sp = 0u;
    for (;;) {
        sum = 0u; cnt = 0u; mine = 0u;
#pragma unroll
        for (unsigned j = 0; j < 16; ++j) { const unsigned c = xb_ld(&bar[XB_XCNT(j)]); sum += c; cnt += (c > 0u) ? 1u : 0u; mine = (j == x) ? c : mine; }
        if (sum == G) break;
        __builtin_amdgcn_s_sleep(1);
        if ((++sp & 255u) == 0u) { if (xb_ld(&bar[XB_TMO])) break; if (sp > XB_SPIN_CAP) { atomicAdd(&bar[XB_TMO], 1u); break; } }
    }
    nloc = mine > 0u ? mine : 1u; nx = cnt > 0u ? cnt : 1u;
}
__device__ __forceinline__ void xcd_barrier(const XcdBarrier& b, int tid) {
    asm volatile("s_waitcnt vmcnt(0)" ::: "memory");
    __syncthreads();
    if (tid == 0) {
        unsigned* bar = b.bar;
        __builtin_amdgcn_s_waitcnt(0);
        unsigned nloc = b.st[0], nx = b.st[1];
        if (nloc == 0u) { xcd_barrier_complete(bar, b.x, nloc, nx); b.st[0] = nloc; b.st[1] = nx; }
        const unsigned old = xb_add(&bar[XB_XSUB(b.x)], 1u);
        const unsigned gen = old / nloc;
        if (old + 1u == (gen + 1u) * nloc) {
            __builtin_amdgcn_fence(__ATOMIC_RELEASE, "agent");
            asm volatile("s_waitcnt vmcnt(0)" ::: "memory");
            const unsigned og = xb_add(&bar[XB_TOP], 1u);
            const unsigned tg = og / nx;
            if (og + 1u == (tg + 1u) * nx) xb_add(&bar[XB_TOPGEN], 1u);
            else XB_SPIN(xb_ld(&bar[XB_TOPGEN]) == tg, bar);
            __builtin_amdgcn_fence(__ATOMIC_ACQUIRE, "agent");
            xb_add(&bar[XB_XGEN(b.x)], 1u);
            asm volatile("s_waitcnt vmcnt(0)" ::: "memory");
        } else {
            XB_SPIN(xb_ld(&bar[XB_XGEN(b.x)]) == gen, bar);
            __builtin_amdgcn_fence(__ATOMIC_ACQUIRE, "agent");
            asm volatile("s_waitcnt vmcnt(0)" ::: "memory");
        }
    }
    __syncthreads();
}

__device__ __forceinline__ void group_barrier(unsigned* ctl, int inst, int wg, int tid) {
    asm volatile("s_waitcnt vmcnt(0)" ::: "memory");
    __syncthreads();
    if (tid == 0) {
        unsigned* w = ctl + CW_GRP + (inst * 8 + (wg & 7)) * 16; unsigned* bar = ctl + CW_BAR;
        __builtin_amdgcn_s_waitcnt(0);
        (void)xb_add(w, 1u);
        XB_SPIN(xb_ld(w) < 32u, bar);
        __builtin_amdgcn_fence(__ATOMIC_ACQUIRE, "agent");
        asm volatile("s_waitcnt vmcnt(0)" ::: "memory");
    }
    __syncthreads();
}

struct Args { const float* in[21]; float* out; unsigned char* ws; int ph_lo, ph_hi; };
enum { I_X = 0, I_C, I_RELB, I_RW, I_RB, I_MODW, I_MODB, I_N1G, I_WIN, I_LNG, I_LNB, I_GWS, I_GBS, I_ONA, I_ONB, I_WOUT, I_N2G, I_WG, I_WU, I_WD, I_FING };

struct Ctx {
    int tid, lane, wave, wg, nwg, gw, ngw, gtid, ngt;
    LAS unsigned char* lds;
};

__device__ __forceinline__ void bucket_experts(int bkt, int& e0, int& e1) {
    const int grp = bkt / 6, pi = bkt % 6;
    const int pa = (pi >= 3) + (pi >= 5);
    const int pb = pi + 1 - (pa == 0 ? 0 : (pa == 1 ? 2 : 3));
    e0 = grp * 4 + pa; e1 = grp * 4 + pb;
}
__device__ __forceinline__ float rstd_from16(const float* ssq, int t) {
    const f32x4* p = (const f32x4*)(ssq + (size_t)t * 16);
    const f32x4 a = p[0], b = p[1], c = p[2], d = p[3];
    const float s = ((a.x + a.y) + (a.z + a.w)) + ((b.x + b.y) + (b.z + b.w)) + ((c.x + c.y) + (c.z + c.w)) + ((d.x + d.y) + (d.z + d.w));
    return rsqrtf(s * (1.0f / 1024.0f) + EPS);
}

__device__ __forceinline__ void tr_item(const float* W, int ldw, int k0, int n0, bf16* WT, int ldt, int drow0, const float* kscale, float nscale, LAS float* scr, int lane) {
    {
        f32x4 v[8];
#pragma unroll
        for (int j = 0; j < 8; ++j) v[j] = __builtin_nontemporal_load((const f32x4*)&W[(size_t)(k0 + 8 * j + (lane >> 3)) * ldw + n0 + (lane & 7) * 4]);
#pragma unroll
        for (int j = 0; j < 8; ++j) { const int kk = 8 * j + (lane >> 3); const float sc = (kscale ? kscale[k0 + kk] : 1.0f) * nscale; LAS float* d = scr + kk * 33 + (lane & 7) * 4;
            d[0] = v[j][0] * sc; d[1] = v[j][1] * sc; d[2] = v[j][2] * sc; d[3] = v[j][3] * sc; }
    }
    LDS_WAIT(); asm volatile("" ::: "memory");
    const int c = lane & 7;
#pragma unroll
    for (int j = 0; j < 4; ++j) {
        const int n = (lane >> 3) + 8 * j; const LAS float* s = scr + (8 * c) * 33 + n;
        u32x4 o; o.x = pk2(s[0 * 33], s[1 * 33]); o.y = pk2(s[2 * 33], s[3 * 33]); o.z = pk2(s[4 * 33], s[5 * 33]); o.w = pk2(s[6 * 33], s[7 * 33]);
        __builtin_nontemporal_store(o, (u32x4*)(WT + (size_t)(drow0 + n) * ldt + k0 + 8 * c));
    }
    LDS_WAIT(); asm volatile("" ::: "memory");
}
__device__ __forceinline__ void conv_wdown(const Args& a, const Ctx& c) {
    LAS float* scr = (LAS float*)(c.lds + c.wave * 8704);
    bf16* wd = (bf16*)(a.ws + WS_WD);
    for (int it = c.gw; it < DEPTH * NE * 256; it += c.ngw) {
        const int le = it >> 8, q = it & 255, kb = q / 32, nb = q % 32;
        tr_item(a.in[I_WD] + (size_t)le * 512 * 1024, 1024, kb * 64, nb * 32, wd + (size_t)le * 1024 * 512, 512, nb * 32, nullptr, 1.0f, scr, c.lane);
    }
}
__device__ __forceinline__ void conv_panel_item(const float* W, int ldw, int n0, bf16* WT, int drow0, float nscale, const float* sh, float* out, int ob, LAS unsigned char* lds, int wave, int lane, int tid, bool nts) {
    LAS float* scr = (LAS float*)(lds + wave * 12800); LAS float* shl = (LAS float*)(lds + wave * 12800 + 8704);
    LAS float* red = (LAS float*)(lds + 8 * 12800);
    const int kbase = wave * 128;
#pragma unroll
    for (int i = 0; i < 16; ++i) { const int id = lane + 64 * i, b = id >> 7, kk = id & 127; shl[id] = sh[b * 6144 + kbase + kk]; }
    const int n = lane & 31, bh = lane >> 5;
    float acc[4] = {0.f, 0.f, 0.f, 0.f};
#pragma unroll 1
    for (int tI = 0; tI < 2; ++tI) {
        const int k0 = kbase + 64 * tI;
        {
            f32x4 v[8];
#pragma unroll
            for (int j = 0; j < 8; ++j) v[j] = __builtin_nontemporal_load((const f32x4*)&W[(size_t)(k0 + 8 * j + (lane >> 3)) * ldw + n0 + (lane & 7) * 4]);
#pragma unroll
            for (int j = 0; j < 8; ++j) { LAS float* d = scr + (8 * j + (lane >> 3)) * 33 + (lane & 7) * 4; d[0] = v[j][0] * nscale; d[1] = v[j][1] * nscale; d[2] = v[j][2] * nscale; d[3] = v[j][3] * nscale; }
        }
        LDS_WAIT(); asm volatile("" ::: "memory");
        const int cc = lane & 7;
#pragma unroll
        for (int j = 0; j < 4; ++j) {
            const int nn = (lane >> 3) + 8 * j; const LAS float* s = scr + (8 * cc) * 33 + nn;
            u32x4 o; o.x = pk2(s[0 * 33], s[1 * 33]); o.y = pk2(s[2 * 33], s[3 * 33]); o.z = pk2(s[4 * 33], s[5 * 33]); o.w = pk2(s[6 * 33], s[7 * 33]);
            if (nts) __builtin_nontemporal_store(o, (u32x4*)(WT + (size_t)(drow0 + nn) * 1024 + k0 + 8 * cc)); else *(u32x4*)(WT + (size_t)(drow0 + nn) * 1024 + k0 + 8 * cc) = o;
        }
#pragma unroll 4
        for (int k4 = 0; k4 < 64; k4 += 4) {
            const float v0 = scr[(k4 + 0) * 33 + n], v1 = scr[(k4 + 1) * 33 + n], v2 = scr[(k4 + 2) * 33 + n], v3 = scr[(k4 + 3) * 33 + n];
#pragma unroll
            for (int i = 0; i < 4; ++i) { const f32x4 s4 = *(const LAS f32x4*)(shl + (4 * bh + i) * 128 + 64 * tI + k4); acc[i] += (s4.x * v0 + s4.y * v1) + (s4.z * v2 + s4.w * v3); }
        }
        LDS_WAIT(); asm volatile("" ::: "memory");
    }
#pragma unroll
    for (int i = 0; i < 4; ++i) red[(wave * 8 + 4 * bh + i) * 32 + n] = acc[i];
    __syncthreads();
    if (tid < 256) { const int b = tid >> 5, nn = tid & 31; float s = 0.f;
#pragma unroll
        for (int w = 0; w < 8; ++w) s += red[(w * 8 + b) * 32 + nn];
        out[(size_t)b * ob + nn] = s; }
    __syncthreads();
}
template <class SH>
__device__ __forceinline__ void bias_item(const float* Wc, int ldw, const SH* sh, int shs, float* out, int ob, float scale, const float* addv, LAS float* red, int tid) {
    const int c4 = tid & 15, kc = tid >> 4;
    f32x4 acc[8];
#pragma unroll
    for (int b = 0; b < 8; ++b) acc[b] = (f32x4){0.f, 0.f, 0.f, 0.f};
#pragma unroll 1
    for (int k0 = kc * 32; k0 < kc * 32 + 32; k0 += 16) {
        f32x4 w[16];
#pragma unroll
        for (int u = 0; u < 16; ++u) w[u] = __builtin_nontemporal_load((const f32x4*)&Wc[(size_t)(k0 + u) * ldw + c4 * 4]);
#pragma unroll
        for (int u = 0; u < 16; ++u)
#pragma unroll
            for (int b = 0; b < 8; ++b) acc[b] = acc[b] + w[u] * (float)sh[b * shs + k0 + u];
    }
#pragma unroll
    for (int b = 0; b < 8; ++b) *(LAS f32x4*)(red + (kc * 8 + b) * 64 + c4 * 4) = acc[b];
    __syncthreads();
    {
        const int b = tid >> 6, nn = tid & 63; float s = 0.f;
#pragma unroll
        for (int k2 = 0; k2 < 32; ++k2) s += red[(k2 * 8 + b) * 64 + nn];
        __hip_atomic_store(out + (size_t)b * ob + nn, s * scale + (addv ? addv[nn] : 0.f), __ATOMIC_RELAXED, __HIP_MEMORY_SCOPE_AGENT);
    }
    __syncthreads();
}
__device__ __forceinline__ void phase_p0a(const Args& a, const Ctx& c) {
    float* modv = (float*)(a.ws + WS_SMALL + SO_MODV);
    if (c.wg < 192) {
        LAS float* cact = (LAS float*)(c.lds + 65536);
        for (int i = c.tid; i < 8 * 1024; i += NTHREADS) cact[i] = silu_f(a.in[I_C][i]);
        __syncthreads();
        const int l = c.wg / 96, j0 = (c.wg % 96) * 64;
        bias_item(a.in[I_MODW] + (size_t)l * 1024 * 6144 + j0, 6144, cact, 1024, modv + (size_t)l * 8 * 6144 + j0, 6144, 1.0f, a.in[I_MODB] + l * 6144 + j0, (LAS float*)c.lds, c.tid);
        asm volatile("s_waitcnt vmcnt(0)" ::: "memory");
        __syncthreads();
        if (c.tid == 0) __hip_atomic_fetch_add((unsigned*)(a.ws + WS_CTL) + CW_MOD, 1u, __ATOMIC_RELAXED, __HIP_MEMORY_SCOPE_AGENT);
    }
    {
        bf16* rwt = (bf16*)(a.ws + WS_SMALL + SO_RWT);
        for (int i = c.gtid; i < 16 * 1024; i += c.ngt) { const int e = i >> 10, kk = i & 1023; rwt[i] = (bf16)f2bf(a.in[I_RW][kk * 16 + e]); }
    }
    LAS float* scr = (LAS float*)(c.lds + c.wave * 8704);
    {
        bf16* wtout = (bf16*)(a.ws + WS_WOUT);
        for (int it = c.gw; it < DEPTH * 512; it += c.ngw) {
            const int l = it >> 9, q = it & 511, kb = q / 32, nb = q % 32, k0 = kb * 64;
            const float* ks = (k0 < 512) ? (a.in[I_ONA] + l * 512) : (a.in[I_ONB] + l * 512 - 512);
            tr_item(a.in[I_WOUT] + (size_t)l * 1024 * 1024, 1024, k0, nb * 32, wtout + (size_t)l * 1024 * 1024, 1024, nb * 32, ks, 1.0f, scr, c.lane);
        }
    }
    {
        bf16* ws = (bf16*)(a.ws + WS_WS); const float* g = a.in[I_GWS];
        for (int i = c.gtid; i < DEPTH * 8 * 128 * 128; i += c.ngt) {
            const int col = i & 127, t = (i >> 7) & 127, ks = col >> 4, hh = (col >> 3) & 1, jj = col & 7, s = 16 * ks + 8 * (jj >> 2) + 4 * hh + (jj & 3);
            ws[i] = (bf16)f2bf(s <= t ? g[(i & ~127) + s] : 0.f);
        }
    }
    conv_wdown(a, c);
}

__device__ __forceinline__ void phase_p0b(const Args& a, const Ctx& c) {
    {
        unsigned* w = (unsigned*)(a.ws + WS_CTL) + CW_MOD; unsigned* tmo = (unsigned*)(a.ws + WS_CTL) + CW_TMO;
        if (c.tid < 64) {
            unsigned sp = 0;
            while ((unsigned)__builtin_amdgcn_readfirstlane(__hip_atomic_load(w, __ATOMIC_RELAXED, __HIP_MEMORY_SCOPE_AGENT)) < 192u) {
                __builtin_amdgcn_s_sleep(2);
                if ((++sp & 255u) == 0u) { if (__builtin_amdgcn_readfirstlane(__hip_atomic_load(tmo, __ATOMIC_RELAXED, __HIP_MEMORY_SCOPE_AGENT)) != 0u) break;
                    if (sp > (1u << 20)) { if (c.lane == 0) __hip_atomic_store(tmo, 0x11u, __ATOMIC_RELAXED, __HIP_MEMORY_SCOPE_AGENT); break; } }
            }
            __builtin_amdgcn_fence(__ATOMIC_ACQUIRE, "agent");
            asm volatile("s_waitcnt vmcnt(0)" ::: "memory");
        }
        __syncthreads();
    }
    const float* modv = (const float*)(a.ws + WS_SMALL + SO_MODV);
    float* G1 = (float*)(a.ws + WS_SMALL + SO_G1); float* G2 = (float*)(a.ws + WS_SMALL + SO_G2);
    for (int i = c.gtid; i < DEPTH * BATCH * 1024; i += c.ngt) {
        const int k = i & 1023, lb = i >> 10, l = lb / BATCH;
        G1[i] = a.in[I_N1G][l * 1024 + k] * (1.0f + modv[(size_t)lb * 6144 + 1024 + k]);
        G2[i] = a.in[I_N2G][l * 1024 + k] * (1.0f + modv[(size_t)lb * 6144 + 4096 + k]);
    }
    {
        float* rb = (float*)(a.ws + WS_SMALL + SO_RBIAS);
        for (int i = c.gw; i < DEPTH * BATCH * 16; i += c.ngw) {
            const int e = i & 15, lb = i >> 4; const float* sh = modv + (size_t)lb * 6144 + 3072; float acc = 0.f;
#pragma unroll
            for (int j = 0; j < 16; ++j) { const int kk = c.lane + 64 * j; acc += sh[kk] * a.in[I_RW][kk * 16 + e]; }
            acc = wave_sum(acc);
            if (c.lane == 0) rb[i] = acc;
        }
    }
    {
        float* bias1 = (float*)(a.ws + WS_SMALL + SO_BIAS1); float* biasgu = (float*)(a.ws + WS_SMALL + SO_BIASGU);
        bf16* wtin = (bf16*)(a.ws + WS_WIN); bf16* wgu = (bf16*)(a.ws + WS_WGU);
        for (int it = c.wg; it < 160 + 1024; it += c.nwg) {
            if (it < 160) {
                const int l = it / 80, n0 = (it % 80) * 32; const float sc = (n0 >= 1024 && n0 < 1536) ? C2 : 1.0f;
                conv_panel_item(a.in[I_WIN] + (size_t)l * 1024 * INC, INC, n0, wtin + (size_t)l * INC * 1024, n0, sc, modv + (size_t)l * 8 * 6144, bias1 + (size_t)l * 8 * INC + n0, INC, c.lds, c.wave, c.lane, c.tid, l != 0);
            } else {
                const int r = it - 160, le = r >> 5, q = r & 31, half = q >> 4, nb = q & 15, n0 = nb * 32, l = le >> 4, e = le & 15;
                const float* W = (half ? a.in[I_WU] : a.in[I_WG]) + (size_t)le * 1024 * 512;
                const int drow0 = (n0 / 128) * 256 + (n0 % 128) + half * 128;
                conv_panel_item(W, 512, n0, wgu + (size_t)le * 1024 * 1024, drow0, 1.0f, modv + (size_t)l * 8 * 6144 + 3072, biasgu + ((size_t)l * 8 * 16 + e) * 1024 + drow0, 16 * 1024, c.lds, c.wave, c.lane, c.tid, true);
            }
        }
    }
    {
        bf16* A1 = (bf16*)(a.ws + WS_ACTX); float* ssq = (float*)(a.ws + WS_SMALL + SO_SSQA);
        const float* x = a.in[I_X];
        for (int t = c.gw; t < T; t += c.ngw) {
            const int b = t / SEQ; float s = 0.f;
            const f32x4* xr = (const f32x4*)(x + (size_t)t * 1024);
#pragma unroll
            for (int j = 0; j < 4; ++j) {
                const int kk = (c.lane + 64 * j) * 4; const f32x4 v = __builtin_nontemporal_load(&xr[c.lane + 64 * j]);
                s += (v.x * v.x + v.y * v.y) + (v.z * v.z + v.w * v.w);
                const f32x4 ng = *(const f32x4*)(a.in[I_N1G] + kk), sc = *(const f32x4*)(modv + (size_t)b * 6144 + 1024 + kk);
                uint2 o; o.x = pk2(v.x * ng.x * (1.0f + sc.x), v.y * ng.y * (1.0f + sc.y)); o.y = pk2(v.z * ng.z * (1.0f + sc.z), v.w * ng.w * (1.0f + sc.w));
                *(uint2*)(A1 + (size_t)t * 1024 + kk) = o;
            }
            s = wave_sum(s);
            if (c.lane < 16) ssq[(size_t)t * 16 + c.lane] = (c.lane == 0) ? s : 0.f;
            if (c.lane == 0) ((int*)(a.ws + WS_SMALL + SO_ROWX))[t] = t;
        }
    }
}

__device__ __forceinline__ void route_tokens(const Args& a, const Ctx& c, int l, int cslot, int tbase, int nw) {
    const bf16* A2 = (const bf16*)(a.ws + WS_ACTX); const bf16* rwt = (const bf16*)(a.ws + WS_SMALL + SO_RWT);
    const float* ssq = (const float*)(a.ws + WS_SMALL + SO_SSQB); const float* rbias = (const float*)(a.ws + WS_SMALL + SO_RBIAS) + l * 8 * 16;
    float* gates = (float*)(a.ws + WS_SMALL + SO_GATES); int* tokl = (int*)(a.ws + WS_SMALL + SO_TOKL);
    unsigned* cnt = (unsigned*)(a.ws + WS_CTL) + CW_CNT + cslot * 32; const float* rb = a.in[I_RB];
    const int fr = c.lane & 15, fq = c.lane >> 4;
    LAS unsigned* hist = (LAS unsigned*)(c.lds + 131072 + 1024); LAS unsigned* base = (LAS unsigned*)(c.lds + 131072 + 1024 + 128);
    {
        if (c.tid < 32) hist[c.tid] = 0u;
        for (int i0 = c.tid; i0 < nw * 16 * 128; i0 += 8 * NTHREADS) {
            u32x4 rr[8];
#pragma unroll
            for (int j = 0; j < 8; ++j) { const int i = i0 + j * NTHREADS, row = i >> 7, ch = i & 127; rr[j] = *(const u32x4*)(A2 + (size_t)(tbase + row) * 1024 + ch * 8); }
#pragma unroll
            for (int j = 0; j < 8; ++j) { const int i = i0 + j * NTHREADS, row = i >> 7, ch = i & 127; *(LAS u32x4*)(c.lds + row * 2048 + ((ch ^ (row & 15)) << 4)) = rr[j]; }
        }
        __syncthreads();
        const bool act = c.wave < nw;
        const int rloc = (act ? c.wave : 0) * 16 + fr, t = tbase + rloc, b = t >> 11;
        const LAS unsigned char* arow = c.lds + rloc * 2048; const bf16* wrow = rwt + fr * 1024 + 8 * fq;
        f32x4 acc = {0.f, 0.f, 0.f, 0.f};
        {
            bf16x8 wq[2][8], aq[2][8];
#define RT_LD(buf, bt_) do { _Pragma("unroll") for (int i = 0; i < 8; ++i) { const int k0_ = ((bt_) * 8 + i) * 32; wq[buf][i] = *(const bf16x8*)(wrow + k0_); \
                aq[buf][i] = *(const LAS bf16x8*)(arow + ((((k0_ >> 3) + fq) ^ (rloc & 15)) << 4)); } } while (0)
            RT_LD(0, 0);
#pragma unroll
            for (int bt = 0; bt < 4; ++bt) {
                if (bt < 3) RT_LD((bt + 1) & 1, bt + 1);
#pragma unroll
                for (int i = 0; i < 8; ++i) acc = __builtin_amdgcn_mfma_f32_16x16x32_bf16(wq[bt & 1][i], aq[bt & 1][i], acc, 0, 0, 0);
            }
#undef RT_LD
        }
        const float rs = rstd_from16(ssq, t);
        float lg[4], p[4], sel[4];
#pragma unroll
        for (int j = 0; j < 4; ++j) lg[j] = rs * acc[j] + rbias[b * 16 + 4 * fq + j];
        float mx = fmaxf(fmaxf(lg[0], lg[1]), fmaxf(lg[2], lg[3]));
        mx = rows_max(mx);
        float ps = 0.f;
#pragma unroll
        for (int j = 0; j < 4; ++j) { p[j] = __expf(lg[j] - mx); ps += p[j]; }
        ps = rows_sum(ps);
        const float inv = 1.0f / ps;
#pragma unroll
        for (int j = 0; j < 4; ++j) { p[j] *= inv; sel[j] = p[j] + rb[4 * fq + j]; }
        float m1 = -INFINITY, m2 = -INFINITY;
#pragma unroll
        for (int j = 0; j < 4; ++j) { const float v = sel[j]; if (v > m1) { m2 = m1; m1 = v; } else if (v > m2) { m2 = v; } }
        const float gs = m1 + m2;
        int best = 0; float bests = __uint_as_float((unsigned)__builtin_amdgcn_ds_bpermute(fr << 2, (int)__float_as_uint(gs)));
#pragma unroll
        for (int gg = 1; gg < 4; ++gg) { const float o = __uint_as_float((unsigned)__builtin_amdgcn_ds_bpermute((fr + 16 * gg) << 2, (int)__float_as_uint(gs))); if (o > bests) { bests = o; best = gg; } }
        int bkt = 0; unsigned rank = 0u; float ga = 0.f, gb = 0.f;
        const bool win = act && (fq == best);
        if (win) {
            int i1 = 0; float v1 = sel[0];
            if (sel[1] > v1) { v1 = sel[1]; i1 = 1; } if (sel[2] > v1) { v1 = sel[2]; i1 = 2; } if (sel[3] > v1) { v1 = sel[3]; i1 = 3; }
            int i2 = -1; float v2 = -INFINITY;
            if (i1 != 0 && sel[0] > v2) { v2 = sel[0]; i2 = 0; } if (i1 != 1 && sel[1] > v2) { v2 = sel[1]; i2 = 1; } if (i1 != 2 && sel[2] > v2) { v2 = sel[2]; i2 = 2; } if (i1 != 3 && sel[3] > v2) { v2 = sel[3]; i2 = 3; }
            const int ea = min(i1, i2), eb = max(i1, i2);
            const float pa = (ea == 0) ? p[0] : (ea == 1) ? p[1] : (ea == 2) ? p[2] : p[3];
            const float pb = (eb == 0) ? p[0] : (eb == 1) ? p[1] : (eb == 2) ? p[2] : p[3];
            const int pi = (ea == 0) ? (eb - 1) : (ea == 1) ? (eb + 1) : 5;
            bkt = best * 6 + pi; ga = pa / (pa + pb); gb = pb / (pa + pb);
            rank = atomicAdd((unsigned*)(hist + bkt), 1u);
        }
        __syncthreads();
        if (c.tid < NBKT) { const unsigned n = hist[c.tid]; base[c.tid] = n ? atomicAdd(&cnt[c.tid], n) : 0u; }
        __syncthreads();
        if (win) {
            const unsigned pos = base[bkt] + rank;
            tokl[bkt * TOKCAP + (int)pos] = t;
            gates[(size_t)t * 2] = ga; gates[(size_t)t * 2 + 1] = gb;
        }
        __syncthreads();
    }
}

__device__ __forceinline__ void phase_p6(const Args& a, const Ctx& c) {
    const float* ssq = (const float*)(a.ws + WS_SMALL + SO_SSQA); const float* fg = a.in[I_FING];
    const int* rowx = (const int*)(a.ws + WS_SMALL + SO_ROWX); const bf16* x2b = (const bf16*)(a.ws + WS_X2B);
    for (int t = c.gw; t < T; t += c.ngw) {
        const int r = rowx[t]; const float rs = rstd_from16(ssq, t);
        const uint2* xr = (const uint2*)(x2b + (size_t)r * 1024); f32x4* orow = (f32x4*)(a.out + (size_t)t * 1024);
#pragma unroll
        for (int j = 0; j < 4; ++j) {
            typedef unsigned u32x2 __attribute__((ext_vector_type(2)));
            const u32x2 rw = __builtin_nontemporal_load((const u32x2*)&xr[c.lane + 64 * j]); uint2 raw; raw.x = rw.x; raw.y = rw.y; const f32x4 g = ((const f32x4*)fg)[c.lane + 64 * j];
            f32x4 v; v.x = __uint_as_float(raw.x << 16) * rs * g.x; v.y = __uint_as_float(raw.x & 0xffff0000u) * rs * g.y; v.z = __uint_as_float(raw.y << 16) * rs * g.z; v.w = __uint_as_float(raw.y & 0xffff0000u) * rs * g.w;
            __builtin_nontemporal_store(v, &orow[c.lane + 64 * j]);
        }
    }
}

namespace mm {
constexpr int BM = 256, BK = 64, HALF = 128, HTB = HALF * BK * 2, STAGE_BYTES = 8 * HTB;
__device__ __forceinline__ int lds_byte(int r, int c) { const int st = (r >> 4) * 2 + (c >> 5), rr = r & 15, cc = c & 31, ob = rr * 64 + cc * 2; return st * 1024 + (ob ^ (((ob >> 9) & 1) << 5)); }
__device__ __forceinline__ void stage_rc(int b, int& R, int& C) { const int st = b / 1024, sb = b % 1024, swz = sb ^ (((sb >> 9) & 1) << 5); R = (st >> 1) * 16 + swz / 64; C = (st & 1) * 32 + (swz % 64) / 2; }
__device__ __forceinline__ int perm32(int rho) { const int n = rho >> 4, i = rho & 15; return 8 * (i >> 2) + 4 * n + (i & 3); }
__device__ __forceinline__ int xcd_remap(int L, int nU) { const int q = nU / 8, r = nU % 8, xcd = L % 8, off = L / 8; return (xcd < r ? xcd * (q + 1) : r * (q + 1) + (xcd - r) * q) + off; }

constexpr int SIDE_OFF = 146432;
constexpr int TAB_OFF = 131072;
struct MUnit { const char* A; const char* B; int first, last; int i0, i1, i2, i3, i4, i5; };

__device__ __forceinline__ unsigned cvt_pk_bf16(float lo, float hi) { unsigned r; asm volatile("v_cvt_pk_bf16_f32 %0, %1, %2" : "=v"(r) : "v"(lo), "v"(hi)); return r; }
typedef float f32x2 __attribute__((ext_vector_type(2)));
__device__ __forceinline__ f32x2 gelu_pk(f32x2 v) {
    f32x2 c; c.x = __builtin_amdgcn_fmed3f(v.x, -4.25f, 4.25f); c.y = __builtin_amdgcn_fmed3f(v.y, -4.25f, 4.25f);
    const f32x2 u = c * c;
    f32x2 q = u * (-8.460361597e-10f) + 7.570799355e-08f;
    q = q * u + (-2.938792968e-06f); q = q * u + 6.552695497e-05f; q = q * u + (-9.404465092e-04f); q = q * u + 9.257818770e-03f; q = q * u + (-6.545349156e-02f); q = q * u + 3.984200383e-01f;
    const f32x2 ph = c * q + 0.5f;
    return v * ph;
}

template <class Epi, class Sched, bool GATHER>
__device__ __forceinline__ void mm_phase(LAS unsigned char* lds, const Sched& S, const Epi& E, const int tid) {
    const int wid = __builtin_amdgcn_readfirstlane(tid >> 6), lane = tid & 63, wr = wid >> 2, wc = wid & 3, fr = lane & 15, fq = lane >> 4;
    const int nt = S.nt; const unsigned lda = S.lda, ldb = S.ldb;
    int Rr[2], Cc;
    unsigned voffA[2], voffB[2];
#pragma unroll
    for (int i = 0; i < 2; ++i) { int R, C; stage_rc(tid * 16 + i * 8192, R, C); const int Rb = Epi::PERM ? ((R & ~31) + perm32(R & 31)) : R;
        Rr[i] = R; Cc = C; voffA[i] = (unsigned)R * lda + (unsigned)C * 2u; voffB[i] = (unsigned)Rb * ldb + (unsigned)C * 2u; }
    const size_t kstep = (size_t)(BK * 2);
    const size_t hstepA = (size_t)HALF * lda, hstepB = (size_t)HALF * ldb;
    const unsigned ldsw = (unsigned)wid * 1024u;
    const int aoff = lds_byte(wr * 64 + fr, fq * 8), boff = lds_byte(wc * 32 + fr, fq * 8);
#define MM_SA(b, h) (((b) * 2 + (h)) * HTB)
#define MM_SB(b, h) ((4 + (b) * 2 + (h)) * HTB)
#define MM_STAGE_B(bufoff, gbase) do { _Pragma("unroll") for (int _i = 0; _i < 2; ++_i) \
        __builtin_amdgcn_global_load_lds((const unsigned*)((const char*)(gbase) + voffB[_i]), (LAS unsigned*)(lds + (bufoff) + ldsw + _i * 8192), 16, 0, 0); } while (0)
#define MM_STAGE_A(bufoff, nx, h, koff) do { \
        const char* gb_ = GATHER ? (cA + (koff)) : (((nx) ? nA : cA) + (size_t)(h) * hstepA + (koff)); \
        _Pragma("unroll") for (int _i = 0; _i < 2; ++_i) { \
            unsigned vo_ = GATHER ? vAc[h][_i] : voffA[_i]; \
            if (GATHER) { if (nx) vo_ = S.gather1(nslot, (h) * 128 + Rr[_i], Cc, lds); } \
            __builtin_amdgcn_global_load_lds((const unsigned*)(gb_ + vo_), (LAS unsigned*)(lds + (bufoff) + ldsw + _i * 8192), 16, 0, 0); } } while (0)
#define MM_LDA(dst, b, h) do { _Pragma("unroll") for (int m = 0; m < 4; ++m) _Pragma("unroll") for (int k = 0; k < 2; ++k) dst[m][k] = *(const LAS bf16x8*)(lds + MM_SA(b, h) + aoff + m * 2048 + k * 1024); } while (0)
#define MM_LDB(dst, b, h) do { _Pragma("unroll") for (int n = 0; n < 2; ++n) _Pragma("unroll") for (int k = 0; k < 2; ++k) dst[n][k] = *(const LAS bf16x8*)(lds + MM_SB(b, h) + boff + n * 2048 + k * 1024); } while (0)
#define MM_MMA(ai, bj, At, Bt) do { __builtin_amdgcn_s_setprio(1); _Pragma("unroll") for (int m = 0; m < 4; ++m) _Pragma("unroll") for (int n = 0; n < 2; ++n) _Pragma("unroll") for (int k = 0; k < 2; ++k) \
        acc[ai][bj][m][n] = __builtin_amdgcn_mfma_f32_16x16x32_bf16(Bt[n][k], At[m][k], acc[ai][bj][m][n], 0, 0, 0); __builtin_amdgcn_s_setprio(0); } while (0)
#define MM_WAIT_V(n) asm volatile("s_waitcnt vmcnt(" #n ")" ::: "memory")
#define MM_WAIT_L(n) asm volatile("s_waitcnt lgkmcnt(" #n ")" ::: "memory")
#define MM_BAR __builtin_amdgcn_s_barrier()
#define MM_SCHED __builtin_amdgcn_sched_barrier(0)
#define MM_ZERO() do { _Pragma("unroll") for (int a_ = 0; a_ < 2; ++a_) _Pragma("unroll") for (int b_ = 0; b_ < 2; ++b_) _Pragma("unroll") for (int m_ = 0; m_ < 4; ++m_) _Pragma("unroll") for (int n_ = 0; n_ < 2; ++n_) \
        acc[a_][b_][m_][n_] = (f32x4){0.f, 0.f, 0.f, 0.f}; } while (0)
    MUnit cur, nxt; int ui = 0;
    if (!S.next(0, cur)) return;
    f32x4 acc[2][2][4][2];
    MM_ZERO();
    bf16x8 At[4][2], B0[2][2], B1[2][2];
    unsigned vAc[2][2]; int nslot = 0;
    if constexpr (GATHER) { S.gather(0, Rr, Cc, vAc, lds); }
    else {
#pragma unroll
        for (int h = 0; h < 2; ++h)
#pragma unroll
            for (int i = 0; i < 2; ++i) vAc[h][i] = 0u;
    }
    const char* cA = cur.A; const char* cB = cur.B;
    const char* nA = cA;
    MM_STAGE_B(MM_SB(0, 0), cB); MM_STAGE_B(MM_SB(0, 1), cB + hstepB); MM_STAGE_A(MM_SA(0, 0), false, 0, 0); MM_STAGE_A(MM_SA(0, 1), false, 1, 0);
    if (wr == 1) MM_BAR;
    MM_WAIT_V(2); MM_BAR;
    MM_STAGE_B(MM_SB(1, 0), cB + kstep); MM_STAGE_A(MM_SA(1, 0), false, 0, kstep); MM_STAGE_B(MM_SB(1, 1), cB + hstepB + kstep);
    MM_WAIT_V(6); MM_BAR;
    for (;;) {
        const bool has_next = S.next(ui + 1, nxt);
        nA = has_next ? nxt.A : cA; const char* nB = has_next ? nxt.B : cB;
        nslot = has_next ? ui + 1 : ui;
        for (int t = 0; t < nt; t += 2) {
            const bool last = (t == nt - 2);
            const size_t k1 = (size_t)(t + 1) * kstep;
            const size_t k2 = last ? 0 : (size_t)(t + 2) * kstep;
            const size_t k3 = k2 + kstep;
            const char* b2 = (last ? nB : cB) + k2; const char* b3 = b2 + kstep;
            MM_LDB(B0, 0, 0); MM_LDB(B1, 0, 1); MM_SCHED; MM_LDA(At, 0, 0); MM_STAGE_A(MM_SA(1, 1), false, 1, k1);
            MM_WAIT_V(8); MM_WAIT_L(0); MM_BAR; MM_MMA(0, 0, At, B0); MM_MMA(0, 1, At, B1); MM_BAR; MM_SCHED;
            MM_LDA(At, 0, 1); MM_STAGE_B(MM_SB(0, 0), b2); MM_STAGE_B(MM_SB(0, 1), b2 + hstepB); MM_STAGE_A(MM_SA(0, 0), last, 0, k2);
            MM_WAIT_V(8); MM_WAIT_L(0); MM_BAR; MM_MMA(1, 0, At, B0); MM_MMA(1, 1, At, B1); MM_BAR; MM_SCHED;
            MM_LDB(B0, 1, 0); MM_LDB(B1, 1, 1); MM_SCHED; MM_LDA(At, 1, 0); MM_STAGE_A(MM_SA(0, 1), last, 1, k2);
            MM_WAIT_V(8); MM_WAIT_L(0); MM_BAR; MM_MMA(0, 0, At, B0); MM_MMA(0, 1, At, B1); MM_BAR; MM_SCHED;
            MM_LDA(At, 1, 1); MM_STAGE_B(MM_SB(1, 0), b3); MM_STAGE_B(MM_SB(1, 1), b3 + hstepB); MM_STAGE_A(MM_SA(1, 0), last, 0, k3);
            MM_WAIT_V(8); MM_WAIT_L(0); MM_BAR; MM_MMA(1, 0, At, B0); MM_MMA(1, 1, At, B1); MM_BAR; MM_SCHED;
        }
        const bool epi = cur.last != 0;
        int fr_ = fr, fq_ = fq, wr_ = wr, wc_ = wc; asm volatile("" : "+v"(fr_), "+v"(fq_), "+s"(wr_), "+s"(wc_));
        if constexpr (Epi::HAS_MID) E.mid(acc, ui, epi, wr_, fr_, lds);
        if (epi) { if (wr == 0) MM_BAR; E(acc, cur, ui, wr_, wc_, fr_, fq_, lds);
#if EPI_TWICE
            E(acc, cur, ui, wr_, wc_, fr_, fq_, lds);
#endif
        }
        if (!has_next) break;
        if (nxt.first) MM_ZERO();
        cur = nxt; cA = nA; cB = nB; ++ui;
        if constexpr (GATHER) { S.gather(ui, Rr, Cc, vAc, lds); }
        if (epi) { if (wr == 1) MM_BAR; }
    }
    MM_WAIT_V(0);
    MM_BAR;
#undef MM_SA
#undef MM_SB
#undef MM_STAGE_A
#undef MM_STAGE_B
#undef MM_LDA
#undef MM_LDB
#undef MM_MMA
#undef MM_WAIT_V
#undef MM_WAIT_L
#undef MM_BAR
#undef MM_SCHED
#undef MM_ZERO
}

struct SchedDense {
    const char* A; const char* B; int nM, nN, nU, G, c, nt; unsigned lda, ldb;
    __device__ __forceinline__ bool next(int i, MUnit& u) const {
        const int L = i * G + c; if (L >= nU) return false;
        const int wgid = xcd_remap(L, nU);
        const int nig = 8 * nN, gid = wgid / nig, fm = gid * 8, gsz = (nM - fm) < 8 ? (nM - fm) : 8;
        const int pm = fm + ((wgid % nig) % gsz), pn = (wgid % nig) / gsz;
        u.A = A + (size_t)pm * 256 * lda; u.B = B + (size_t)pn * 256 * ldb; u.first = 1; u.last = 1; u.i0 = pm; u.i1 = pn; u.i2 = 0; u.i3 = 0; u.i4 = 0; u.i5 = 0;
        return true;
    }
    __device__ __forceinline__ void gather(int, const int (&)[2], int, unsigned (&)[2][2], LAS unsigned char*) const {}
    __device__ __forceinline__ unsigned gather1(int, int, int, LAS unsigned char*) const { return 0u; }
};
struct SchedP1 {
    const char* A; const char* B; int nM, nN, nU, G, c, nt; unsigned lda, ldb;
    __device__ __forceinline__ bool next(int i, MUnit& u) const {
        const int L = i * G + c; if (L >= nU) return false;
        const int wgid = xcd_remap(L, nU);
        const int nig = 8 * nN, gid = wgid / nig, fm = gid * 8, gsz = (nM - fm) < 8 ? (nM - fm) : 8;
        const int pm = fm + ((wgid % nig) % gsz), pn = (wgid % nig) / gsz;
        u.A = A; u.B = B + (size_t)pn * 256 * ldb; u.first = 1; u.last = 1; u.i0 = pm; u.i1 = pn; u.i2 = 0; u.i3 = 0; u.i4 = 0; u.i5 = 0;
        return true;
    }
    __device__ __forceinline__ void gather(int slot, const int (&Rr)[2], int Cc, unsigned (&v)[2][2], LAS unsigned char* lds) const {
        const LAS int* tk = (const LAS int*)(lds + TAB_OFF + slot * 3072);
#pragma unroll
        for (int h = 0; h < 2; ++h)
#pragma unroll
            for (int i = 0; i < 2; ++i) v[h][i] = (unsigned)tk[h * 128 + Rr[i]] * 2048u + (unsigned)Cc * 2u;
    }
    __device__ __forceinline__ unsigned gather1(int slot, int row, int Cc, LAS unsigned char* lds) const {
        return (unsigned)((const LAS int*)(lds + TAB_OFF + slot * 3072))[row] * 2048u + (unsigned)Cc * 2u;
    }
};
struct SchedP3 {
    const char* A; const char* B; int nM, nN, nU, G, c, nt; unsigned lda, ldb;
    __device__ __forceinline__ bool next(int i, MUnit& u) const {
        const int L = (i >> 1) * G + c, sub = i & 1; if (L >= nU) return false;
        const int wgid = xcd_remap(L, nU);
        const int nig = 8 * nN, gid = wgid / nig, fm = gid * 8, gsz = (nM - fm) < 8 ? (nM - fm) : 8;
        const int pm = fm + ((wgid % nig) % gsz), pn = (wgid % nig) / gsz;
        u.A = A + (size_t)pm * 256 * lda + sub * 1024; u.B = B + (size_t)pn * 256 * ldb + sub * 1024; u.first = (sub == 0); u.last = (sub == 1); u.i0 = pm; u.i1 = pn; u.i2 = 0; u.i3 = 0; u.i4 = 0; u.i5 = 0;
        return true;
    }
    __device__ __forceinline__ void gather(int, const int (&)[2], int, unsigned (&)[2][2], LAS unsigned char*) const {}
    __device__ __forceinline__ unsigned gather1(int, int, int, LAS unsigned char*) const { return 0u; }
};
struct SchedP4 {
    const int* tokl; const unsigned* cnt; const char* A2; const char* Wgu; LAS const int* pre; int nU, G, c, nt; unsigned lda, ldb;
    __device__ __forceinline__ bool next(int i, MUnit& u) const {
        const int L = i * G + c; if (L >= nU) return false;
        const int id = xcd_remap(L, nU), tile_id = id >> 3, pn = id & 7;
        int bkt = 0;
        for (int b = 1; b < NBKT; ++b) if (pre[b] <= tile_id) bkt = b;
        const int rt = tile_id - pre[bkt]; int e0, e1; bucket_experts(bkt, e0, e1);
        const int slot = pn >> 2, tile = pn & 3, e = slot ? e1 : e0;
        u.A = A2; u.B = Wgu + ((size_t)e * 1024 + tile * 256) * 2048; u.first = 1; u.last = 1;
        u.i0 = bkt; u.i1 = rt; u.i2 = pn; u.i3 = pre[32 + bkt]; u.i4 = pre[bkt] * 256; u.i5 = e;
        return true;
    }
    __device__ __forceinline__ void gather(int slot, const int (&Rr)[2], int Cc, unsigned (&v)[2][2], LAS unsigned char* lds) const {
        const LAS int* tk = (const LAS int*)(lds + TAB_OFF + slot * 3072);
#pragma unroll
        for (int h = 0; h < 2; ++h)
#pragma unroll
            for (int i = 0; i < 2; ++i) v[h][i] = (unsigned)tk[h * 128 + Rr[i]] * 2048u + (unsigned)Cc * 2u;
    }
    __device__ __forceinline__ unsigned gather1(int slot, int row, int Cc, LAS unsigned char* lds) const {
        return (unsigned)((const LAS int*)(lds + TAB_OFF + slot * 3072))[row] * 2048u + (unsigned)Cc * 2u;
    }
};
struct SchedP5 {
    const unsigned* cnt; const char* act; const char* Wd; LAS const int* pre; int nU, G, c, nt; unsigned lda, ldb;
    __device__ __forceinline__ bool next(int i, MUnit& u) const {
        const int L = (i >> 1) * G + c, sub = i & 1; if (L >= nU) return false;
        const int id = xcd_remap(L, nU), tile_id = id >> 2, pn = id & 3;
        int bkt = 0;
        for (int b = 1; b < NBKT; ++b) if (pre[b] <= tile_id) bkt = b;
        const int rt = tile_id - pre[bkt]; int e0, e1; bucket_experts(bkt, e0, e1);
        const int e = sub ? e1 : e0, off = pre[bkt] * 256;
        u.A = act + (size_t)(off + rt * 256) * 2048 + sub * 1024; u.B = Wd + ((size_t)e * 1024 + pn * 256) * 1024; u.first = (sub == 0); u.last = (sub == 1);
        u.i0 = bkt; u.i1 = rt; u.i2 = pn; u.i3 = pre[32 + bkt]; u.i4 = pre[64 + bkt]; u.i5 = (i >> 1) * 3072;
        return true;
    }
    __device__ __forceinline__ void gather(int, const int (&)[2], int, unsigned (&)[2][2], LAS unsigned char*) const {}
    __device__ __forceinline__ unsigned gather1(int, int, int, LAS unsigned char*) const { return 0u; }
};

struct EpiP1 {
    static constexpr bool PERM = true, HAS_MID = false;
    bf16* proj; const float* ssq; const float* bias1;
    __device__ __forceinline__ void operator()(const f32x4 (&acc)[2][2][4][2], const MUnit& u, int slot, int wr, int wc, int fr, int fq, LAS unsigned char* lds) const {
        const int pm = u.i0, pn = u.i1, b = pm >> 3;
        const int row0 = pm * 256 + wr * 64 + fr, col0 = pn * 256 + wc * 32 + 8 * fq;
        const LAS float* rtab = (const LAS float*)(lds + TAB_OFF + slot * 3072 + 1024);
        f32x4 bv[2][2];
#pragma unroll
        for (int bj = 0; bj < 2; ++bj)
#pragma unroll
            for (int n = 0; n < 2; ++n) bv[bj][n] = *(const f32x4*)(bias1 + b * INC + col0 + bj * 128 + 4 * n);
        const bool act = pn < 4;
#pragma unroll
        for (int ai = 0; ai < 2; ++ai)
#pragma unroll
            for (int m = 0; m < 4; ++m) {
                const int row = row0 + ai * 128 + m * 16; const float rs = rtab[wr * 64 + fr + ai * 128 + m * 16];
                const int tq = row & 2047;
#pragma unroll
                for (int bj = 0; bj < 2; ++bj) {
                    f32x4 v0 = acc[ai][bj][m][0] * rs + bv[bj][0], v1 = acc[ai][bj][m][1] * rs + bv[bj][1];
                    if (act) { const f32x2 p = gelu_pk((f32x2){v0[0], v0[1]}), q = gelu_pk((f32x2){v0[2], v0[3]}), r = gelu_pk((f32x2){v1[0], v1[1]}), s = gelu_pk((f32x2){v1[2], v1[3]});
                        v0 = (f32x4){p.x, p.y, q.x, q.y}; v1 = (f32x4){r.x, r.y, s.x, s.y}; }
                    u32x4 w; w.x = cvt_pk_bf16(v0[0], v0[1]); w.y = cvt_pk_bf16(v0[2], v0[3]); w.z = cvt_pk_bf16(v1[0], v1[1]); w.w = cvt_pk_bf16(v1[2], v1[3]);
                    if (act) *(u32x4*)(proj + (size_t)row * 1024 + col0 + bj * 128) = w;
                    else { const int c512 = ((pn - 4) & 1) * 256 + bj * 128 + wc * 32 + 8 * fq, which = (pn - 4) >> 1;
                        *(u32x4*)(proj + (size_t)(32 + 16 * which) * (MiB / 2) + ((size_t)((b * 8 + (c512 >> 6)) * 2048 + tq)) * 64 + (c512 & 63)) = w; }
                }
            }
    }
};
template <bool L0, bool WT>
struct EpiP3 {
    static constexpr bool PERM = true, HAS_MID = true;
    const float* xin;        const bf16* x2b;
    bf16* x1; bf16* A2; float* ssq; const float* g1;     const float* G2;
    __device__ __forceinline__ void mid(f32x4 (&acc)[2][2][4][2], int ui, bool epi, int wr, int fr, LAS unsigned char* lds) const {
        const LAS float* rho = (const LAS float*)(lds + TAB_OFF + (ui >> 1) * 3072 + 1024);
#pragma unroll
        for (int ai = 0; ai < 2; ++ai)
#pragma unroll
            for (int m = 0; m < 4; ++m) { const float r0 = rho[ai * 128 + wr * 64 + m * 16 + fr]; const float r = epi ? 1.0f : r0;
#pragma unroll
                for (int bj = 0; bj < 2; ++bj)
#pragma unroll
                    for (int n = 0; n < 2; ++n) acc[ai][bj][m][n] = acc[ai][bj][m][n] * r; }
    }
    __device__ __forceinline__ void operator()(const f32x4 (&acc)[2][2][4][2], const MUnit& u, int ui, int wr, int wc, int fr, int fq, LAS unsigned char* lds) const {
        const int pm = u.i0, pn = u.i1, b = pm >> 3;
        const int row0 = pm * 256 + wr * 64 + fr, col0 = pn * 256 + wc * 32 + 8 * fq;
        const LAS float* rbt = (const LAS float*)(lds + TAB_OFF + (ui >> 1) * 3072 + 2048); const LAS int* rxt = (const LAS int*)(lds + TAB_OFF + (ui >> 1) * 3072);
        f32x4 gv[2][2], Gv[2][2];
#pragma unroll
        for (int bj = 0; bj < 2; ++bj)
#pragma unroll
            for (int n = 0; n < 2; ++n) { gv[bj][n] = *(const f32x4*)(g1 + b * 6144 + col0 + bj * 128 + 4 * n); Gv[bj][n] = *(const f32x4*)(G2 + b * 1024 + col0 + bj * 128 + 4 * n); }
        constexpr int AH = L0 ? 2 : 4;
        f32x4 PF[L0 ? AH : 1][2][2]; u32x4 RW[L0 ? 1 : AH][2];
#define P3_LOAD(ai_, m_) do { const int rl_ = (ai_) * 128 + wr * 64 + (m_) * 16 + fr; _Pragma("unroll") for (int bj = 0; bj < 2; ++bj) { \
            if (L0) { const float* xp = xin + (size_t)(pm * 256 + rl_) * 1024 + col0 + bj * 128; PF[L0 ? ((m_) % AH) : 0][bj][0] = __builtin_nontemporal_load((const f32x4*)xp); PF[L0 ? ((m_) % AH) : 0][bj][1] = __builtin_nontemporal_load((const f32x4*)(xp + 4)); } \
            else RW[L0 ? 0 : ((m_) % AH)][bj] = *(const u32x4*)(x2b + (size_t)rxt[rl_] * 1024 + col0 + bj * 128); } } while (0)
#pragma unroll
        for (int m = 0; m < AH; ++m) P3_LOAD(0, m);
#pragma unroll
        for (int ai = 0; ai < 2; ++ai)
#pragma unroll
            for (int m = 0; m < 4; ++m) {
                const int rl = ai * 128 + wr * 64 + m * 16 + fr, row = pm * 256 + rl; float ss = 0.f; const float rb = rbt[rl];
                f32x4 pp[2][2];
#pragma unroll
                for (int bj = 0; bj < 2; ++bj) {
                    if (L0) { pp[bj][0] = PF[L0 ? (m % AH) : 0][bj][0]; pp[bj][1] = PF[L0 ? (m % AH) : 0][bj][1]; }
                    else { const u32x4 raw = RW[L0 ? 0 : (m % AH)][bj];
                        pp[bj][0] = (f32x4){__uint_as_float(raw.x << 16), __uint_as_float(raw.x & 0xffff0000u), __uint_as_float(raw.y << 16), __uint_as_float(raw.y & 0xffff0000u)};
                        pp[bj][1] = (f32x4){__uint_as_float(raw.z << 16), __uint_as_float(raw.z & 0xffff0000u), __uint_as_float(raw.w << 16), __uint_as_float(raw.w & 0xffff0000u)}; }
                }
                { constexpr int dummy_ = 0; (void)dummy_; const int it_ = ai * 4 + m + AH; if (it_ < 8) P3_LOAD(it_ >> 2, it_ & 3); }
#pragma unroll
                for (int bj = 0; bj < 2; ++bj) {
                    const f32x4 p0 = pp[bj][0], p1 = pp[bj][1];
                    const f32x4 v0 = p0 + gv[bj][0] * (acc[ai][bj][m][0] * rb), v1 = p1 + gv[bj][1] * (acc[ai][bj][m][1] * rb);
                    ss += ((v0[0] * v0[0] + v0[1] * v0[1]) + (v0[2] * v0[2] + v0[3] * v0[3])) + ((v1[0] * v1[0] + v1[1] * v1[1]) + (v1[2] * v1[2] + v1[3] * v1[3]));
                    const size_t o = (size_t)row * 1024 + col0 + bj * 128;
                    u32x4 w; w.x = cvt_pk_bf16(v0[0], v0[1]); w.y = cvt_pk_bf16(v0[2], v0[3]); w.z = cvt_pk_bf16(v1[0], v1[1]); w.w = cvt_pk_bf16(v1[2], v1[3]);
                    *(u32x4*)(x1 + o) = w;
                    const f32x4 a0 = v0 * Gv[bj][0], a1 = v1 * Gv[bj][1];
                    u32x4 z; z.x = cvt_pk_bf16(a0[0], a0[1]); z.y = cvt_pk_bf16(a0[2], a0[3]); z.z = cvt_pk_bf16(a1[0], a1[1]); z.w = cvt_pk_bf16(a1[2], a1[3]);
                    if constexpr (WT) { const __amdgpu_buffer_rsrc_t rs2 = __builtin_amdgcn_make_buffer_rsrc((void*)A2, (short)0, 0x2000000, 0x00020000);
                      __builtin_amdgcn_raw_buffer_store_b128(z, rs2, (int)((unsigned)o * 2u), 0, 16); }
                    else *(u32x4*)(A2 + o) = z;
                }
                ss = rows_sum(ss);
                if (fq == 0) { if constexpr (WT) __hip_atomic_store(ssq + (size_t)row * 16 + pn * 4 + wc, ss, __ATOMIC_RELAXED, __HIP_MEMORY_SCOPE_AGENT); else ssq[(size_t)row * 16 + pn * 4 + wc] = ss; }
            }
#undef P3_LOAD
    }
};
struct EpiP4 {
    static constexpr bool PERM = true, HAS_MID = false;
    bf16* act; const int* tokl; const float* ssq; const float* biasgu;     const float* gates; int wt;
    __device__ __forceinline__ void side(const MUnit& u, int wid, int lane, LAS unsigned char* lds) const {
        const float* src = biasgu + ((size_t)wid * 16 + u.i5) * 1024 + (u.i2 & 3) * 256 + ((lane ^ wid) << 2);
        __builtin_amdgcn_global_load_lds((const unsigned*)src, (LAS unsigned*)(lds + SIDE_OFF + wid * 1024), 16, 0, 0);
    }
    __device__ __forceinline__ void operator()(const f32x4 (&acc)[2][2][4][2], const MUnit& u, int uslot, int wr, int wc, int fr, int fq, LAS unsigned char* lds) const {
        const int rt = u.i1, pn = u.i2, off = u.i4, e = u.i5, slot = pn >> 2, tile = pn & 3;
        const LAS int* ttab = (const LAS int*)(lds + TAB_OFF + uslot * 3072); const LAS float* rtab = (const LAS float*)(lds + TAB_OFF + uslot * 3072 + 1024); const LAS float* gtab = (const LAS float*)(lds + TAB_OFF + uslot * 3072 + 2048);
        const LAS unsigned char* sb = lds + SIDE_OFF; const int ch = wc * 8 + 2 * fq;
        int tq[8]; float rq[8], gq[8];
#pragma unroll
        for (int i = 0; i < 8; ++i) { const int rl = (i >> 2) * 128 + wr * 64 + (i & 3) * 16 + fr; tq[i] = ttab[rl]; rq[i] = rtab[rl]; gq[i] = gtab[rl]; }
        f32x4 bq[2][4];
#define E4_LDB(buf, i_) do { const int b_ = tq[i_] >> 11; _Pragma("unroll") for (int nn = 0; nn < 2; ++nn) { bq[buf][nn] = *(const LAS f32x4*)(sb + b_ * 1024 + (((ch + nn) ^ b_) << 4)); \
            bq[buf][2 + nn] = *(const LAS f32x4*)(sb + b_ * 1024 + (((32 + ch + nn) ^ b_) << 4)); } } while (0)
        E4_LDB(0, 0);
#pragma unroll
        for (int ai = 0; ai < 2; ++ai)
#pragma unroll
            for (int m = 0; m < 4; ++m) {
                const int it = ai * 4 + m;
                if (it < 7) E4_LDB((it + 1) & 1, it + 1);
                const int rl = ai * 128 + wr * 64 + m * 16 + fr, r = rt * 256 + rl;
                const float rs = rq[it]; const float g = gq[it];
                unsigned wv[4];
#pragma unroll
                for (int nn = 0; nn < 2; ++nn) {
                    const f32x4 bg = bq[it & 1][nn], bu = bq[it & 1][2 + nn];
                    const f32x4 hg = acc[ai][0][m][nn] * rs + bg, hu = acc[ai][1][m][nn] * rs + bu;
                    float o[4];
#pragma unroll
                    for (int j = 0; j < 4; ++j) o[j] = hg[j] * __builtin_amdgcn_rcpf(1.0f + __expf(-hg[j])) * hu[j] * g;
                    wv[2 * nn] = cvt_pk_bf16(o[0], o[1]); wv[2 * nn + 1] = cvt_pk_bf16(o[2], o[3]);
                }
                u32x4 w; w.x = wv[0]; w.y = wv[1]; w.z = wv[2]; w.w = wv[3];
                if (wt) { const __amdgpu_buffer_rsrc_t rs = __builtin_amdgcn_make_buffer_rsrc((void*)act, (short)0, 0x3000000, 0x00020000);
                    __builtin_amdgcn_raw_buffer_store_b128(w, rs, (int)(((unsigned)(off + r) * 1024u + (unsigned)(slot * 512 + tile * 128 + wc * 32 + 8 * fq)) * 2u), 0, 16); }
                else *(u32x4*)(act + (size_t)(off + r) * 1024 + slot * 512 + tile * 128 + wc * 32 + 8 * fq) = w;
                ;
            }
#undef E4_LDB
    }
};
struct EpiP5 {
    static constexpr bool PERM = true, HAS_MID = false;
    const bf16* x1; bf16* x2b; bf16* A1; float* ssq; const float* g2;     const float* G1n; int haveNext;
    __device__ __forceinline__ void side(const MUnit& u, int wid, int lane, LAS unsigned char* lds) const {
        const int co = u.i2 * 256 + ((lane ^ wid) << 2);
        __builtin_amdgcn_global_load_lds((const unsigned*)(g2 + wid * 6144 + co), (LAS unsigned*)(lds + SIDE_OFF + wid * 1024), 16, 0, 0);
        if (haveNext) __builtin_amdgcn_global_load_lds((const unsigned*)(G1n + wid * 1024 + co), (LAS unsigned*)(lds + SIDE_OFF + 8192 + wid * 1024), 16, 0, 0);
    }
    __device__ __forceinline__ void operator()(const f32x4 (&acc)[2][2][4][2], const MUnit& u, int ui, int wr, int wc, int fr, int fq, LAS unsigned char* lds) const {
        const int rt = u.i1, pn = u.i2, n = u.i3, xoff = u.i4;
        const int col0 = pn * 256 + wc * 32 + 8 * fq;
        const LAS int* ttab = (const LAS int*)(lds + TAB_OFF + u.i5);
        const LAS unsigned char* sb = lds + SIDE_OFF; const int ch = wc * 8 + 2 * fq;
        int tq[8];
#pragma unroll
        for (int i = 0; i < 8; ++i) tq[i] = ttab[(i >> 2) * 128 + wr * 64 + (i & 3) * 16 + fr];
        u32x4 raw[4][2];
#pragma unroll
        for (int m = 0; m < 4; ++m) {
#pragma unroll
            for (int bj = 0; bj < 2; ++bj) raw[m][bj] = *(const u32x4*)(x1 + (size_t)tq[m] * 1024 + col0 + bj * 128); }
#pragma unroll
        for (int ai = 0; ai < 2; ++ai)
#pragma unroll
            for (int m = 0; m < 4; ++m) {
                const int rl = ai * 128 + wr * 64 + m * 16 + fr, r = rt * 256 + rl; const bool valid = r < n;
                const int t = tq[ai * 4 + m]; const int b = t >> 11; float ss = 0.f;
                const size_t orow = (size_t)(xoff + r);
                u32x4 w[2], z[2];
                f32x4 gq[2][2];
#pragma unroll
                for (int bj = 0; bj < 2; ++bj) { const int c0 = ch + 32 * bj;
                    gq[bj][0] = *(const LAS f32x4*)(sb + b * 1024 + ((c0 ^ b) << 4)); gq[bj][1] = *(const LAS f32x4*)(sb + b * 1024 + (((c0 + 1) ^ b) << 4)); }
                const u32x4 rw0 = raw[m][0], rw1 = raw[m][1];
                if (ai == 0) { const int tn = tq[4 + m];
#pragma unroll
                    for (int bj = 0; bj < 2; ++bj) raw[m][bj] = *(const u32x4*)(x1 + (size_t)tn * 1024 + col0 + bj * 128); }
#pragma unroll
                for (int bj = 0; bj < 2; ++bj) {
                    const f32x4 ga = gq[bj][0], gb = gq[bj][1];
                    const u32x4 rw = bj ? rw1 : rw0;
                    const f32x4 p0 = (f32x4){__uint_as_float(rw.x << 16), __uint_as_float(rw.x & 0xffff0000u), __uint_as_float(rw.y << 16), __uint_as_float(rw.y & 0xffff0000u)};
                    const f32x4 p1 = (f32x4){__uint_as_float(rw.z << 16), __uint_as_float(rw.z & 0xffff0000u), __uint_as_float(rw.w << 16), __uint_as_float(rw.w & 0xffff0000u)};
                    const f32x4 v0 = p0 + ga * acc[ai][bj][m][0], v1 = p1 + gb * acc[ai][bj][m][1];
                    ss += ((v0[0] * v0[0] + v0[1] * v0[1]) + (v0[2] * v0[2] + v0[3] * v0[3])) + ((v1[0] * v1[0] + v1[1] * v1[1]) + (v1[2] * v1[2] + v1[3] * v1[3]));
                    w[bj].x = cvt_pk_bf16(v0[0], v0[1]); w[bj].y = cvt_pk_bf16(v0[2], v0[3]); w[bj].z = cvt_pk_bf16(v1[0], v1[1]); w[bj].w = cvt_pk_bf16(v1[2], v1[3]);
                    if (haveNext) { const int c0 = ch + 32 * bj; const f32x4 Ga = *(const LAS f32x4*)(sb + 8192 + b * 1024 + ((c0 ^ b) << 4)), Gb = *(const LAS f32x4*)(sb + 8192 + b * 1024 + (((c0 + 1) ^ b) << 4));
                        const f32x4 a0 = v0 * Ga, a1 = v1 * Gb;
                        z[bj].x = cvt_pk_bf16(a0[0], a0[1]); z[bj].y = cvt_pk_bf16(a0[2], a0[3]); z[bj].z = cvt_pk_bf16(a1[0], a1[1]); z[bj].w = cvt_pk_bf16(a1[2], a1[3]); }
                }
                ss = rows_sum(ss);
                if (valid) {
#pragma unroll
                    for (int bj = 0; bj < 2; ++bj) {
                        *(u32x4*)(x2b + orow * 1024 + col0 + bj * 128) = w[bj];
                        if (haveNext) *(u32x4*)(A1 + (size_t)t * 1024 + col0 + bj * 128) = z[bj];
                    }
                    if (fq == 0) ssq[(size_t)t * 16 + pn * 4 + wc] = ss;
                }
            }
    }
};

struct MUnit45 : MUnit { int kind, nt, slot, tile; unsigned ldb; };
struct Sched45 {
    const char* A2; const char* Wgu; const char* act; const char* Wd; LAS const int* pre; int t0, ntl, rank, n4;
    __device__ __forceinline__ bool next(int i, MUnit45& u) const {
        if (i < n4) {
            const int en = rank + 32 * i, tile_id = t0 + (en >> 3), pn = en & 7;
            int bkt = 0;
            for (int b = 1; b < NBKT; ++b) if (pre[b] <= tile_id) bkt = b;
            bkt = __builtin_amdgcn_readfirstlane(bkt);
            const int pb_ = __builtin_amdgcn_readfirstlane(pre[bkt]);
            const int rt = tile_id - pb_; int e0, e1; bucket_experts(bkt, e0, e1);
            const int slot = pn >> 2, tile = pn & 3, e = slot ? e1 : e0;
            u.A = A2; u.B = Wgu + ((size_t)e * 1024 + tile * 256) * 2048; u.first = 1; u.last = 1;
            u.i0 = bkt; u.i1 = rt; u.i2 = pn; u.i3 = __builtin_amdgcn_readfirstlane(pre[32 + bkt]); u.i4 = pb_ * 256; u.i5 = e;
            u.kind = 0; u.nt = 16; u.slot = i; u.tile = tile_id; u.ldb = 2048u;
            return true;
        }
        const int j = i - n4, k5 = j >> 1, sub = j & 1, en = rank + 32 * (n4 + k5) - 8 * ntl; if (en >= 4 * ntl) return false;
        const int tile_id = t0 + (en >> 2), pn = en & 3;
        int bkt = 0;
        for (int b = 1; b < NBKT; ++b) if (pre[b] <= tile_id) bkt = b;
        bkt = __builtin_amdgcn_readfirstlane(bkt);
        const int pb_ = __builtin_amdgcn_readfirstlane(pre[bkt]);
        const int rt = tile_id - pb_; int e0, e1; bucket_experts(bkt, e0, e1);
        const int e = sub ? e1 : e0, off = pb_ * 256;
        u.A = act + (size_t)(off + rt * 256) * 2048 + sub * 1024; u.B = Wd + ((size_t)e * 1024 + pn * 256) * 1024; u.first = (sub == 0); u.last = (sub == 1);
        u.i0 = bkt; u.i1 = rt; u.i2 = pn; u.i3 = __builtin_amdgcn_readfirstlane(pre[32 + bkt]); u.i4 = __builtin_amdgcn_readfirstlane(pre[64 + bkt]); u.i5 = 9216 + k5 * 1024;
        u.kind = 1; u.nt = 8; u.slot = k5; u.tile = tile_id; u.ldb = 1024u;
        return true;
    }
    __device__ __forceinline__ unsigned aoff(const MUnit45& u, int row, int Cc, LAS unsigned char* lds) const {
        if (u.kind == 0) return (unsigned)((const LAS int*)(lds + TAB_OFF + u.slot * 3072))[row] * 2048u + (unsigned)Cc * 2u;
        return (unsigned)row * 2048u + (unsigned)Cc * 2u;
    }
};
template <class Epi4, class Epi5>
__device__ __forceinline__ void mm_phase45(LAS unsigned char* lds, const Sched45& S, const Epi4& E4, const Epi5& E5, const int tid, unsigned* ready, unsigned* tmo) {
    const int wid = __builtin_amdgcn_readfirstlane(tid >> 6), lane = tid & 63, wr = wid >> 2, wc = wid & 3, fr = lane & 15, fq = lane >> 4;
    int Rr[2], RbV[2], Cc;
#pragma unroll
    for (int i = 0; i < 2; ++i) { int R, C; stage_rc(tid * 16 + i * 8192, R, C); Rr[i] = R; RbV[i] = (R & ~31) + perm32(R & 31); Cc = C; }
    const size_t kstep = (size_t)(BK * 2);
    const unsigned ldsw = (unsigned)wid * 1024u;
    const int aoff = lds_byte(wr * 64 + fr, fq * 8), boff = lds_byte(wc * 32 + fr, fq * 8);
#define MM_SA(b, h) (((b) * 2 + (h)) * HTB)
#define MM_SB(b, h) ((4 + (b) * 2 + (h)) * HTB)
#define MM_STAGE_B(bufoff, nx, hb, koff) do { \
        const unsigned ldb_ = (nx) ? pf.ldb : cur.ldb; const char* gb_ = ((nx) ? pf.B : cur.B) + (size_t)(hb) * 128u * ldb_ + (koff); \
        _Pragma("unroll") for (int _i = 0; _i < 2; ++_i) { \
            const unsigned vo_ = (unsigned)RbV[_i] * ldb_ + (unsigned)Cc * 2u; \
            __builtin_amdgcn_global_load_lds((const unsigned*)(gb_ + vo_), (LAS unsigned*)(lds + (bufoff) + ldsw + _i * 8192), 16, 0, 0); } } while (0)
#define MM_STAGE_A(bufoff, nx, h, koff) do { \
        const char* gb_ = ((nx) ? pf.A : cur.A) + (koff); \
        _Pragma("unroll") for (int _i = 0; _i < 2; ++_i) { \
            unsigned vo_ = vAc[h][_i]; \
            if (nx) vo_ = S.aoff(pf, (h) * 128 + Rr[_i], Cc, lds); \
            __builtin_amdgcn_global_load_lds((const unsigned*)(gb_ + vo_), (LAS unsigned*)(lds + (bufoff) + ldsw + _i * 8192), 16, 0, 0); } } while (0)
#define MM_LDA(dst, b, h) do { _Pragma("unroll") for (int m = 0; m < 4; ++m) _Pragma("unroll") for (int k = 0; k < 2; ++k) dst[m][k] = *(const LAS bf16x8*)(lds + MM_SA(b, h) + aoff + m * 2048 + k * 1024); } while (0)
#define MM_LDB(dst, b, h) do { _Pragma("unroll") for (int n = 0; n < 2; ++n) _Pragma("unroll") for (int k = 0; k < 2; ++k) dst[n][k] = *(const LAS bf16x8*)(lds + MM_SB(b, h) + boff + n * 2048 + k * 1024); } while (0)
#define MM_MMA(ai, bj, At, Bt) do { __builtin_amdgcn_s_setprio(1); _Pragma("unroll") for (int m = 0; m < 4; ++m) _Pragma("unroll") for (int n = 0; n < 2; ++n) _Pragma("unroll") for (int k = 0; k < 2; ++k) \
        acc[ai][bj][m][n] = __builtin_amdgcn_mfma_f32_16x16x32_bf16(Bt[n][k], At[m][k], acc[ai][bj][m][n], 0, 0, 0); __builtin_amdgcn_s_setprio(0); } while (0)
#define MM_WAIT_V(n) asm volatile("s_waitcnt vmcnt(" #n ")" ::: "memory")
#define MM_WAIT_L(n) asm volatile("s_waitcnt lgkmcnt(" #n ")" ::: "memory")
#define MM_BAR __builtin_amdgcn_s_barrier()
#define MM_SCHED __builtin_amdgcn_sched_barrier(0)
#define MM_ZERO() do { _Pragma("unroll") for (int a_ = 0; a_ < 2; ++a_) _Pragma("unroll") for (int b_ = 0; b_ < 2; ++b_) _Pragma("unroll") for (int m_ = 0; m_ < 4; ++m_) _Pragma("unroll") for (int n_ = 0; n_ < 2; ++n_) \
        acc[a_][b_][m_][n_] = (f32x4){0.f, 0.f, 0.f, 0.f}; } while (0)
    MUnit45 cur, nxt, pf; int ui = 0;
    if (!S.next(0, cur)) return;
    nxt = cur; pf = cur;
    f32x4 acc[2][2][4][2];
    MM_ZERO();
    bf16x8 At[4][2], B0[2][2], B1[2][2];
    unsigned vAc[2][2];
#pragma unroll
    for (int h = 0; h < 2; ++h)
#pragma unroll
        for (int i = 0; i < 2; ++i) vAc[h][i] = S.aoff(cur, h * 128 + Rr[i], Cc, lds);
    MM_STAGE_B(MM_SB(0, 0), false, 0, 0); MM_STAGE_B(MM_SB(0, 1), false, 1, 0); MM_STAGE_A(MM_SA(0, 0), false, 0, 0); MM_STAGE_A(MM_SA(0, 1), false, 1, 0);
    if (wr == 1) MM_BAR;
    MM_WAIT_V(2); MM_BAR;
    MM_STAGE_B(MM_SB(1, 0), false, 0, kstep); MM_STAGE_A(MM_SA(1, 0), false, 0, kstep); MM_STAGE_B(MM_SB(1, 1), false, 1, kstep);
    MM_WAIT_V(6); MM_BAR;
    for (;;) {
        const bool has_next = S.next(ui + 1, nxt);
        const bool need_wait = has_next && nxt.kind == 1 && nxt.first;
        const bool defer = need_wait && cur.kind == 0;
        pf = (has_next && !defer) ? nxt : cur;
        const int nt = cur.nt;
        for (int t = 0; t < nt; t += 2) {
            const bool last = (t == nt - 2);
            const size_t k1 = (size_t)(t + 1) * kstep;
            const size_t k2 = last ? 0 : (size_t)(t + 2) * kstep;
            const size_t k3 = k2 + kstep;
            if (t == 2 && cur.last) { int ln_ = lane, wd_ = wid; asm volatile("" : "+v"(ln_), "+s"(wd_)); if (cur.kind == 0) E4.side(cur, wd_, ln_, lds); else E5.side(cur, wd_, ln_, lds); }
            if (last && need_wait && !defer) {
                if (tid < 64) {
                    unsigned* w = ready + 16 * nxt.tile; unsigned sp = 0;
                    while ((unsigned)__builtin_amdgcn_readfirstlane(__hip_atomic_load(w, __ATOMIC_RELAXED, __HIP_MEMORY_SCOPE_AGENT)) < 64u) {
                        __builtin_amdgcn_s_sleep(2);
                        if ((++sp & 255u) == 0u) { if (__builtin_amdgcn_readfirstlane(__hip_atomic_load(tmo, __ATOMIC_RELAXED, __HIP_MEMORY_SCOPE_AGENT)) != 0u) break;
                            if (sp > (1u << 20)) { if (lane == 0) __hip_atomic_store(tmo, 0x45u, __ATOMIC_RELAXED, __HIP_MEMORY_SCOPE_AGENT); break; } }
                    }
                    __builtin_amdgcn_fence(__ATOMIC_ACQUIRE, "agent");
                    asm volatile("s_waitcnt vmcnt(0)" ::: "memory");
                }
                asm volatile("" ::: "memory"); MM_BAR; asm volatile("" ::: "memory");
            }
            MM_LDB(B0, 0, 0); MM_LDB(B1, 0, 1); MM_SCHED; MM_LDA(At, 0, 0); MM_STAGE_A(MM_SA(1, 1), false, 1, k1);
            MM_WAIT_V(8); MM_WAIT_L(0); MM_BAR; MM_MMA(0, 0, At, B0); MM_MMA(0, 1, At, B1); MM_BAR; MM_SCHED;
            MM_LDA(At, 0, 1); MM_STAGE_B(MM_SB(0, 0), last, 0, k2); MM_STAGE_B(MM_SB(0, 1), last, 1, k2); MM_STAGE_A(MM_SA(0, 0), last, 0, k2);
            MM_WAIT_V(8); MM_WAIT_L(0); MM_BAR; MM_MMA(1, 0, At, B0); MM_MMA(1, 1, At, B1); MM_BAR; MM_SCHED;
            MM_LDB(B0, 1, 0); MM_LDB(B1, 1, 1); MM_SCHED; MM_LDA(At, 1, 0); MM_STAGE_A(MM_SA(0, 1), last, 1, k2);
            MM_WAIT_V(8); MM_WAIT_L(0); MM_BAR; MM_MMA(0, 0, At, B0); MM_MMA(0, 1, At, B1); MM_BAR; MM_SCHED;
            MM_LDA(At, 1, 1); MM_STAGE_B(MM_SB(1, 0), last, 0, k3); MM_STAGE_B(MM_SB(1, 1), last, 1, k3); MM_STAGE_A(MM_SA(1, 0), last, 0, k3);
            MM_WAIT_V(8); MM_WAIT_L(0); MM_BAR; MM_MMA(1, 0, At, B0); MM_MMA(1, 1, At, B1); MM_BAR; MM_SCHED;
        }
        const bool epi = cur.last != 0;
        int fr_ = fr, fq_ = fq, wr_ = wr, wc_ = wc; asm volatile("" : "+v"(fr_), "+v"(fq_), "+s"(wr_), "+s"(wc_));
        if (epi) {
            if (wr == 0) MM_BAR;
            if (cur.kind == 0) {
                E4(acc, cur, cur.slot, wr_, wc_, fr_, fq_, lds);
                asm volatile("s_waitcnt vmcnt(0)" ::: "memory");
                if (lane == 0) __hip_atomic_fetch_add(ready + 16 * cur.tile, 1u, __ATOMIC_RELAXED, __HIP_MEMORY_SCOPE_AGENT);
            } else E5(acc, cur, ui, wr_, wc_, fr_, fq_, lds);
        }
        if (!has_next) break;
        if (nxt.first) MM_ZERO();
        cur = nxt; ++ui;
#pragma unroll
        for (int h = 0; h < 2; ++h)
#pragma unroll
            for (int i = 0; i < 2; ++i) vAc[h][i] = S.aoff(cur, h * 128 + Rr[i], Cc, lds);
        if (defer) {
            MM_WAIT_V(0);
            if (tid < 64) {
                unsigned* w = ready + 16 * cur.tile; unsigned sp = 0;
                while ((unsigned)__builtin_amdgcn_readfirstlane(__hip_atomic_load(w, __ATOMIC_RELAXED, __HIP_MEMORY_SCOPE_AGENT)) < 64u) {
                    __builtin_amdgcn_s_sleep(2);
                    if ((++sp & 255u) == 0u) { if (__builtin_amdgcn_readfirstlane(__hip_atomic_load(tmo, __ATOMIC_RELAXED, __HIP_MEMORY_SCOPE_AGENT)) != 0u) break;
                        if (sp > (1u << 20)) { if (lane == 0) __hip_atomic_store(tmo, 0x46u, __ATOMIC_RELAXED, __HIP_MEMORY_SCOPE_AGENT); break; } }
                }
                __builtin_amdgcn_fence(__ATOMIC_ACQUIRE, "agent");
                asm volatile("s_waitcnt vmcnt(0)" ::: "memory");
            }
            asm volatile("" ::: "memory"); MM_BAR; asm volatile("" ::: "memory");
            MM_STAGE_B(MM_SB(0, 0), false, 0, 0); MM_STAGE_B(MM_SB(0, 1), false, 1, 0); MM_STAGE_A(MM_SA(0, 0), false, 0, 0); MM_STAGE_A(MM_SA(0, 1), false, 1, 0);
            if (wr == 1) MM_BAR;
            MM_WAIT_V(2); MM_BAR;
            MM_STAGE_B(MM_SB(1, 0), false, 0, kstep); MM_STAGE_A(MM_SA(1, 0), false, 0, kstep); MM_STAGE_B(MM_SB(1, 1), false, 1, kstep);
            MM_WAIT_V(6); MM_BAR;
        } else if (epi) { if (wr == 1) MM_BAR; }
    }
    MM_WAIT_V(0);
    MM_BAR;
#undef MM_SA
#undef MM_SB
#undef MM_STAGE_A
#undef MM_STAGE_B
#undef MM_LDA
#undef MM_LDB
#undef MM_MMA
#undef MM_WAIT_V
#undef MM_WAIT_L
#undef MM_BAR
#undef MM_SCHED
#undef MM_ZERO
}
}

__device__ __forceinline__ int build_tile_prefix(const unsigned* cnt, LAS int* pre, int tid) {
    if (tid == 0) { int s = 0, x = 0; for (int b = 0; b < NBKT; ++b) { const unsigned n = cnt[b]; pre[b] = s; pre[32 + b] = (int)n; pre[64 + b] = x; s += (int)((n + 255u) >> 8); x += (int)n; } pre[NBKT] = s; }
    __syncthreads();
    return pre[NBKT];
}
__device__ __forceinline__ void phase_p1_fast(const Args& a, const Ctx& c, int l) {
    mm::SchedP1 S; S.A = (const char*)(a.ws + (l == 0 ? WS_ACTX : WS_A3)); S.B = (const char*)(a.ws + WS_WIN) + (size_t)l * INC * 1024 * 2;
    S.nM = 64; S.nN = 10; S.nU = 640; S.G = c.nwg; S.c = c.wg; S.nt = 16; S.lda = 2048; S.ldb = 2048;
    mm::EpiP1 E{(bf16*)(a.ws + WS_PROJ), (const float*)(a.ws + WS_SMALL + SO_SSQA), (const float*)(a.ws + WS_SMALL + SO_BIAS1) + (size_t)l * 8 * INC};
    {
        const int* rowx = (const int*)(a.ws + WS_SMALL + SO_ROWX);
        mm::MUnit u;
        for (int i = 0; i < 3 && S.next(i, u); ++i) {
            if (c.tid < 256) { const int r = u.i0 * 256 + c.tid;
                ((LAS int*)(c.lds + mm::TAB_OFF + i * 3072))[c.tid] = r;
                ((LAS float*)(c.lds + mm::TAB_OFF + i * 3072 + 1024))[c.tid] = rstd_from16(E.ssq, r); }
        }
        __syncthreads();
    }
    mm::mm_phase<mm::EpiP1, mm::SchedP1, true>(c.lds, S, E, c.tid);
}
template <bool L0, bool WT>
__device__ __forceinline__ void phase_p3_impl(const Args& a, const Ctx& c, int l, int cslot) {
    mm::SchedP3 S; S.A = (const char*)(a.ws + WS_A3); S.B = (const char*)(a.ws + WS_WOUT) + (size_t)l * 1024 * 1024 * 2;
    S.nM = 64; S.nN = 4; S.nU = 256; S.G = c.nwg; S.c = c.wg; S.nt = 8; S.lda = 2048; S.ldb = 2048;
    mm::EpiP3<L0, WT> E{a.in[I_X], (const bf16*)(a.ws + WS_X2B), (bf16*)(a.ws + WS_XA), (bf16*)(a.ws + WS_ACTX), (float*)(a.ws + WS_SMALL + SO_SSQB),
                    (const float*)(a.ws + WS_SMALL + SO_MODV) + (size_t)l * 8 * 6144 + 2048, (const float*)(a.ws + WS_SMALL + SO_G2) + (size_t)l * 8 * 1024};
    {
        const float* ssqc = (const float*)(a.ws + WS_SMALL + SO_SSQC); const int* rowx = (const int*)(a.ws + WS_SMALL + SO_ROWX);
        mm::MUnit u;
        for (int i = 0; i < 3 && S.next(2 * i, u); ++i) {
            if (c.tid < 256) {
                const f32x4* p = (const f32x4*)(ssqc + (size_t)(u.i0 * 256 + c.tid) * 16);
                const f32x4 a0 = p[0], a1 = p[1], b0 = p[2], b1 = p[3];
                const float sa = ((a0.x + a0.y) + (a0.z + a0.w)) + ((a1.x + a1.y) + (a1.z + a1.w)), sb = ((b0.x + b0.y) + (b0.z + b0.w)) + ((b1.x + b1.y) + (b1.z + b1.w));
                const float ra = rsqrtf(sa * (1.0f / 512.0f) + EPS), rb = rsqrtf(sb * (1.0f / 512.0f) + EPS);
                ((LAS int*)(c.lds + mm::TAB_OFF + i * 3072))[c.tid] = rowx[u.i0 * 256 + c.tid];
                ((LAS float*)(c.lds + mm::TAB_OFF + i * 3072 + 1024))[c.tid] = ra / rb;
                ((LAS float*)(c.lds + mm::TAB_OFF + i * 3072 + 2048))[c.tid] = rb;
            }
        }
        __syncthreads();
    }
    mm::mm_phase<mm::EpiP3<L0, WT>, mm::SchedP3, false>(c.lds, S, E, c.tid);
    mm::MUnit u0;
    if (S.next(0, u0)) {
        unsigned* pnl = (unsigned*)(a.ws + WS_CTL) + CW_PNL + (cslot * 64 + u0.i0) * 16; unsigned* tmo = (unsigned*)(a.ws + WS_CTL) + CW_TMO;
        asm volatile("s_waitcnt vmcnt(0)" ::: "memory");
        __syncthreads();
        if (c.tid == 0) __hip_atomic_fetch_add(pnl, 1u, __ATOMIC_RELAXED, __HIP_MEMORY_SCOPE_AGENT);
        if (c.tid < 64) {
            unsigned sp = 0;
            while ((unsigned)__builtin_amdgcn_readfirstlane(__hip_atomic_load(pnl, __ATOMIC_RELAXED, __HIP_MEMORY_SCOPE_AGENT)) < 4u) {
                __builtin_amdgcn_s_sleep(2);
                if ((++sp & 255u) == 0u) { if (__builtin_amdgcn_readfirstlane(__hip_atomic_load(tmo, __ATOMIC_RELAXED, __HIP_MEMORY_SCOPE_AGENT)) != 0u) break;
                    if (sp > (1u << 20)) { if (c.lane == 0) __hip_atomic_store(tmo, 0x33u, __ATOMIC_RELAXED, __HIP_MEMORY_SCOPE_AGENT); break; } }
            }
            __builtin_amdgcn_fence(__ATOMIC_ACQUIRE, "agent");
            asm volatile("s_waitcnt vmcnt(0)" ::: "memory");
        }
        __syncthreads();
        route_tokens(a, c, l, cslot, u0.i0 * 256 + u0.i1 * 64, 4);
    }
}
__device__ __forceinline__ void phase_p3_fast(const Args& a, const Ctx& c, int l, int cslot, int pure) {
    if (pure) { if (l == 0) phase_p3_impl<true, false>(a, c, l, cslot); else phase_p3_impl<false, false>(a, c, l, cslot); }
    else { if (l == 0) phase_p3_impl<true, true>(a, c, l, cslot); else phase_p3_impl<false, true>(a, c, l, cslot); }
}
__device__ __forceinline__ void phase_p4_fast(const Args& a, const Ctx& c, int l) {
    const unsigned* cnt = (const unsigned*)(a.ws + WS_CTL) + CW_CNT + l * 32;
    LAS int* pre = (LAS int*)(c.lds + LDSCTL_OFF + 256);
    const int ntile = build_tile_prefix(cnt, pre, c.tid);
    mm::SchedP4 S; S.tokl = (const int*)(a.ws + WS_SMALL + SO_TOKL); S.cnt = cnt; S.A2 = (const char*)(a.ws + WS_ACTX); S.Wgu = (const char*)(a.ws + WS_WGU) + (size_t)l * NE * 1024 * 1024 * 2; S.pre = pre;
    S.nU = ntile * 8; S.G = c.nwg; S.c = c.wg; S.nt = 16; S.lda = 2048; S.ldb = 2048;
    mm::EpiP4 E{(bf16*)(a.ws + WS_ACT), S.tokl, (const float*)(a.ws + WS_SMALL + SO_SSQB), (const float*)(a.ws + WS_SMALL + SO_BIASGU) + (size_t)l * 8 * 16 * 1024, (const float*)(a.ws + WS_SMALL + SO_GATES), 0};
    {
        mm::MUnit u;
        for (int i = 0; i < 3 && S.next(i, u); ++i) {
            if (c.tid < 256) {
                const int rr = u.i1 * 256 + c.tid; const bool valid = rr < u.i3; const int t = valid ? S.tokl[u.i0 * TOKCAP + rr] : 0;
                ((LAS int*)(c.lds + mm::TAB_OFF + i * 3072))[c.tid] = t;
                ((LAS float*)(c.lds + mm::TAB_OFF + i * 3072 + 1024))[c.tid] = rstd_from16(E.ssq, t);
                ((LAS float*)(c.lds + mm::TAB_OFF + i * 3072 + 2048))[c.tid] = valid ? E.gates[(size_t)t * 2 + (u.i2 >> 2)] : 0.f;
                if (valid && u.i2 == 0) ((int*)(a.ws + WS_SMALL + SO_ROWX))[t] = pre[64 + u.i0] + rr;
            }
        }
        __syncthreads();
    }
    mm::mm_phase<mm::EpiP4, mm::SchedP4, true>(c.lds, S, E, c.tid);
}
__device__ __forceinline__ void phase_p5_fast(const Args& a, const Ctx& c, int l) {
    const unsigned* cnt = (const unsigned*)(a.ws + WS_CTL) + CW_CNT + l * 32;
    LAS int* pre = (LAS int*)(c.lds + LDSCTL_OFF + 256);
    const int ntile = build_tile_prefix(cnt, pre, c.tid);
    mm::SchedP5 S; S.cnt = cnt; S.act = (const char*)(a.ws + WS_ACT); S.Wd = (const char*)(a.ws + WS_WD) + (size_t)l * NE * 1024 * 512 * 2; S.pre = pre;
    S.nU = ntile * 4; S.G = c.nwg; S.c = c.wg; S.nt = 8; S.lda = 2048; S.ldb = 1024;
    mm::EpiP5 E{(const bf16*)(a.ws + WS_XA), (bf16*)(a.ws + WS_X2B), (bf16*)(a.ws + WS_A3), (float*)(a.ws + WS_SMALL + SO_SSQA),
                (const float*)(a.ws + WS_SMALL + SO_MODV) + (size_t)l * 8 * 6144 + 5120, (const float*)(a.ws + WS_SMALL + SO_G1) + (size_t)(l + 1 < DEPTH ? l + 1 : l) * 8 * 1024, (l + 1 < DEPTH) ? 1 : 0};
    const int* tokl_ = (const int*)(a.ws + WS_SMALL + SO_TOKL);
    {
        mm::MUnit u;
        for (int i = 0; i < 3 && S.next(2 * i, u); ++i) {
            if (c.tid < 256) { const int rr = u.i1 * 256 + c.tid; ((LAS int*)(c.lds + mm::TAB_OFF + i * 3072))[c.tid] = (rr < u.i3) ? tokl_[u.i0 * TOKCAP + rr] : 0; }
        }
        __syncthreads();
    }
    mm::mm_phase<mm::EpiP5, mm::SchedP5, false>(c.lds, S, E, c.tid);
}


__device__ __forceinline__ void phase_p45(const Args& a, const Ctx& c, int l, int rslot, int pure) {
    const unsigned* cnt = (const unsigned*)(a.ws + WS_CTL) + CW_CNT + l * 32;
    LAS int* pre = (LAS int*)(c.lds + LDSCTL_OFF + 256);
    const int ntile = build_tile_prefix(cnt, pre, c.tid);
    mm::Sched45 S; S.A2 = (const char*)(a.ws + WS_ACTX); S.Wgu = (const char*)(a.ws + WS_WGU) + (size_t)l * NE * 1024 * 1024 * 2; S.act = (const char*)(a.ws + WS_ACT);
    S.Wd = (const char*)(a.ws + WS_WD) + (size_t)l * NE * 1024 * 512 * 2; S.pre = pre;
    { const int x = c.wg & 7; S.t0 = (x * ntile) >> 3; S.ntl = (((x + 1) * ntile) >> 3) - S.t0; S.rank = c.wg >> 3; S.n4 = (8 * S.ntl > S.rank) ? (8 * S.ntl - S.rank + 31) / 32 : 0; }
    const int* tokl = (const int*)(a.ws + WS_SMALL + SO_TOKL);
    mm::EpiP4 E4{(bf16*)(a.ws + WS_ACT), tokl, (const float*)(a.ws + WS_SMALL + SO_SSQB), (const float*)(a.ws + WS_SMALL + SO_BIASGU) + (size_t)l * 8 * 16 * 1024, (const float*)(a.ws + WS_SMALL + SO_GATES), pure ? 0 : 1};
    mm::EpiP5 E5{(const bf16*)(a.ws + WS_XA), (bf16*)(a.ws + WS_X2B), (bf16*)(a.ws + WS_A3), (float*)(a.ws + WS_SMALL + SO_SSQA),
                 (const float*)(a.ws + WS_SMALL + SO_MODV) + (size_t)l * 8 * 6144 + 5120, (const float*)(a.ws + WS_SMALL + SO_G1) + (size_t)(l + 1 < DEPTH ? l + 1 : l) * 8 * 1024, (l + 1 < DEPTH) ? 1 : 0};
    {
        mm::MUnit45 u;
        for (int i = 0; i < 3 + 4 && S.next(i, u); ++i) {
            if (u.kind == 1 && !u.first) continue;
            if (c.tid < 256) {
                const int rr = u.i1 * 256 + c.tid; const bool valid = rr < u.i3; const int t = valid ? tokl[u.i0 * TOKCAP + rr] : 0;
                if (u.kind == 0) {
                    ((LAS int*)(c.lds + mm::TAB_OFF + u.slot * 3072))[c.tid] = t;
                    ((LAS float*)(c.lds + mm::TAB_OFF + u.slot * 3072 + 1024))[c.tid] = rstd_from16(E4.ssq, t);
                    ((LAS float*)(c.lds + mm::TAB_OFF + u.slot * 3072 + 2048))[c.tid] = valid ? E4.gates[(size_t)t * 2 + (u.i2 >> 2)] : 0.f;
                    if (valid && u.i2 == 0) ((int*)(a.ws + WS_SMALL + SO_ROWX))[t] = pre[64 + u.i0] + rr;
                } else ((LAS int*)(c.lds + mm::TAB_OFF + u.i5))[c.tid] = t;
            }
        }
        __syncthreads();
    }
    mm::mm_phase45(c.lds, S, E4, E5, c.tid, (unsigned*)(a.ws + WS_CTL) + CW_RDY + rslot * 96 * 16, (unsigned*)(a.ws + WS_CTL) + CW_TMO);
}
namespace p2 {
typedef float f32x16 __attribute__((ext_vector_type(16)));
typedef short s16x4 __attribute__((ext_vector_type(4)));
constexpr int EXT_OFF = 131072;
constexpr int ST_OFF = 131072 + 4096;
constexpr float NEG = -1e30f;
__device__ __forceinline__ int crow(int r, int hi) { return (r & 3) + 8 * (r >> 2) + 4 * hi; }
__device__ __forceinline__ s16x4 vtr(const LAS unsigned char* p) { return __builtin_bit_cast(s16x4, __builtin_amdgcn_ds_read_tr16_b64_v4i16((LAS s16x4*)p)); }
__device__ __forceinline__ unsigned cvtpk(float lo, float hi) { unsigned r; asm volatile("v_cvt_pk_bf16_f32 %0, %1, %2" : "=v"(r) : "v"(lo), "v"(hi)); return r; }
__device__ __forceinline__ float halves_max(float v) { auto rr = __builtin_amdgcn_permlane32_swap(__float_as_uint(v), __float_as_uint(v), false, false); return fmaxf(__uint_as_float(rr[0]), __uint_as_float(rr[1])); }
__device__ __forceinline__ float halves_sum(float v) { auto rr = __builtin_amdgcn_permlane32_swap(__float_as_uint(v), __float_as_uint(v), false, false); return __uint_as_float(rr[0]) + __uint_as_float(rr[1]); }
__device__ __forceinline__ u32x4 pair_swap(uint2 a, uint2 b) {
    auto r0 = __builtin_amdgcn_permlane32_swap(a.x, b.x, false, false); auto r1 = __builtin_amdgcn_permlane32_swap(a.y, b.y, false, false);
    u32x4 w; w.x = r0[0]; w.y = r1[0]; w.z = r0[1]; w.w = r1[1]; return w;
}
__device__ __forceinline__ void pair_unswap(u32x4 w, uint2& a, uint2& b) {
    auto r0 = __builtin_amdgcn_permlane32_swap(w.x, w.z, false, false); auto r1 = __builtin_amdgcn_permlane32_swap(w.y, w.w, false, false);
    a.x = r0[0]; a.y = r1[0]; b.x = r0[1]; b.y = r1[1];
}

__device__ __forceinline__ void attn_task(const bf16* qh, const bf16* kh, const bf16* vh, int b, int h, int cfg, int r, int iq0, int blk, LAS unsigned char* lds, LAS unsigned char* vbuf, bf16* osc, float* lsc, int lane) {
    const int d = 1 << (2 * cfg), q = lane & 31, hi = lane >> 5;
    const int kbase = iq0 - 128;
    const size_t rowq = ((size_t)(b * 8 + h) * SEQ + d * (iq0 + q) + r) * 64;
    bf16x8 qf[4];
#pragma unroll
    for (int d0 = 0; d0 < 4; ++d0) qf[d0] = *(const bf16x8*)(qh + rowq + 16 * d0 + 8 * hi);
    f32x16 S[5];
    const int e0_ = 31 - q + 4 * hi, sft_ = e0_ & 3;
    const LAS float* ext = (const LAS float*)(lds + EXT_OFF) + sft_ * 768 + cfg * 256 + (e0_ - sft_);
#pragma unroll
    for (int a = 0; a < 5; ++a) {
        if (kbase + 32 * a >= 0) {
            const size_t rowk = ((size_t)(b * 8 + h) * SEQ + d * (kbase + 32 * a + q) + r) * 64 + 8 * hi;
            bf16x8 kf[4];
#pragma unroll
            for (int d0 = 0; d0 < 4; ++d0) kf[d0] = *(const bf16x8*)(kh + rowk + 16 * d0);
            f32x16 s;
#pragma unroll
            for (int k8 = 0; k8 < 4; ++k8) { const f32x4 ev = *(const LAS f32x4*)(ext + 32 * a + 8 * k8); s[4 * k8] = ev[0]; s[4 * k8 + 1] = ev[1]; s[4 * k8 + 2] = ev[2]; s[4 * k8 + 3] = ev[3]; }
#pragma unroll
            for (int d0 = 0; d0 < 4; ++d0) s = __builtin_amdgcn_mfma_f32_32x32x16_bf16(kf[d0], qf[d0], s, 0, 0, 0);
            S[a] = s;
        } else {
#pragma unroll
            for (int rr = 0; rr < 16; ++rr) S[a][rr] = NEG;
        }
    }
    float m = NEG;
#pragma unroll
    for (int a = 0; a < 5; ++a)
#pragma unroll
        for (int rr = 0; rr < 16; ++rr) m = fmaxf(m, S[a][rr]);
    m = halves_max(m);
    float lsum = 0.f;
#pragma unroll
    for (int a = 0; a < 5; ++a)
#pragma unroll
        for (int rr = 0; rr < 16; ++rr) { const float p = __builtin_amdgcn_exp2f(S[a][rr] - m); S[a][rr] = p; lsum += p; }
    lsum = halves_sum(lsum);
    f32x16 o[2];
#pragma unroll
    for (int dh = 0; dh < 2; ++dh)
#pragma unroll
        for (int rr = 0; rr < 16; ++rr) o[dh][rr] = 0.f;
    const LAS unsigned char* vrd = vbuf + ((lane >> 4) & 1) * 32 + (lane & 3) * 8 + (4 * hi + ((lane & 15) >> 2)) * 64;
    u32x4 vreg[4][4];
#pragma unroll
    for (int a = 1; a < 5; ++a)
        if (kbase + 32 * a >= 0) {
#pragma unroll
            for (int i = 0; i < 4; ++i) { const int id = lane + 64 * i, kv = id >> 3, d8 = id & 7;
                vreg[a - 1][i] = *(const u32x4*)(vh + ((size_t)(b * 8 + h) * SEQ + d * (kbase + 32 * a + kv) + r) * 64 + d8 * 8); }
        }
#pragma unroll
    for (int a = 1; a < 5; ++a) {
        if (kbase + 32 * a >= 0) {
#pragma unroll
            for (int i = 0; i < 4; ++i) { const int id = lane + 64 * i, kv = id >> 3, d8 = id & 7;
                *(LAS u32x4*)(vbuf + (d8 >> 2) * 2048 + (kv >> 4) * 1024 + (kv & 15) * 64 + (d8 & 3) * 16) = vreg[a - 1][i]; }
            asm volatile("s_waitcnt lgkmcnt(0)" ::: "memory");
            const LAS unsigned char* vr = vrd;
#pragma unroll
            for (int ks = 0; ks < 2; ++ks) {
                u32x4 pw; pw.x = cvtpk(S[a][8 * ks + 0], S[a][8 * ks + 1]); pw.y = cvtpk(S[a][8 * ks + 2], S[a][8 * ks + 3]); pw.z = cvtpk(S[a][8 * ks + 4], S[a][8 * ks + 5]); pw.w = cvtpk(S[a][8 * ks + 6], S[a][8 * ks + 7]);
                const bf16x8 pb = __builtin_bit_cast(bf16x8, pw);
#pragma unroll
                for (int dh = 0; dh < 2; ++dh) {
                    const s16x4 lo = vtr(vr + dh * 2048 + ks * 1024), hh = vtr(vr + dh * 2048 + ks * 1024 + 512);
                    const bf16x8 vf = (bf16x8){lo[0], lo[1], lo[2], lo[3], hh[0], hh[1], hh[2], hh[3]};
                    o[dh] = __builtin_amdgcn_mfma_f32_32x32x16_bf16(vf, pb, o[dh], 0, 0, 0);
                }
            }
            asm volatile("s_waitcnt lgkmcnt(0)" ::: "memory");
        }
    }
    const int tl = d * (iq0 + q) + r - 512 * blk;
    const float inv = __builtin_amdgcn_rcpf(lsum);
    bf16* orow = osc + (size_t)tl * 64;
#pragma unroll
    for (int dh = 0; dh < 2; ++dh)
#pragma unroll
        for (int k2 = 0; k2 < 2; ++k2) {
            uint2 pa, pb;
            pa.x = cvtpk(o[dh][8 * k2] * inv, o[dh][8 * k2 + 1] * inv); pa.y = cvtpk(o[dh][8 * k2 + 2] * inv, o[dh][8 * k2 + 3] * inv);
            pb.x = cvtpk(o[dh][8 * k2 + 4] * inv, o[dh][8 * k2 + 5] * inv); pb.y = cvtpk(o[dh][8 * k2 + 6] * inv, o[dh][8 * k2 + 7] * inv);
            *(u32x4*)(orow + 32 * dh + 16 * k2 + 8 * hi) = pair_swap(pa, pb);
        }
    if (hi == 0) lsc[cfg * 512 + tl] = m + __builtin_amdgcn_logf(lsum);
}

__device__ __forceinline__ void stage_kv(const bf16* kh, const bf16* vh, int b, int h, int d, int r, int kb0, int R, LAS unsigned char* kl, LAS unsigned char* vl, int wave, int lane, int slot0, int nslots) {
    const int nk = R >> 3;
    for (int n = slot0 + wave; n < 2 * nk; n += nslots) {
        if (n < nk) {
            const int row = 8 * n + (lane >> 3), idx = max(kb0 + row, 0);
            {
                const int cch = (lane & 7) ^ ((row >> 1) & 7);
                const bf16* src = kh + ((size_t)(b * 8 + h) * SEQ + d * idx + r) * 64 + cch * 8;
                __builtin_amdgcn_global_load_lds((const unsigned*)src, (LAS unsigned*)(kl + n * 1024), 16, 0, 0);
            }
        } else {
            const int m = n - nk, p = m >> 1, dh = m & 1, row = 16 * p + (lane >> 2), idx = max(kb0 + row, 0);
            {
                const bf16* src = vh + ((size_t)(b * 8 + h) * SEQ + d * idx + r) * 64 + dh * 32 + (lane & 3) * 8;
                __builtin_amdgcn_global_load_lds((const unsigned*)src, (LAS unsigned*)(vl + dh * (R * 64) + p * 1024), 16, 0, 0);
            }
        }
    }
}
struct MergeArgs { const bf16* osc0; const bf16* osc2; const float* lsc; bf16* a3; float* ssq; };
template <bool WT, bool MG>
__device__ __forceinline__ void attn_task_lds(const bf16* proj, int b, int h, int cfg, int r, int iq0, int blk, const bf16x8 (&qf)[4], const LAS unsigned char* kl, const LAS unsigned char* vl, int vdh, int row0,
                                              LAS unsigned char* lds, bf16* osc, float* lsrow, int lane, const MergeArgs& mg) {
    const int d = 1 << (2 * cfg), q = lane & 31, hi = lane >> 5;
    const int kbase = iq0 - 128;
    f32x16 S[5];
    const int e0_ = 31 - q + 4 * hi, sft_ = e0_ & 3;
    const LAS float* ext = (const LAS float*)(lds + EXT_OFF) + sft_ * 768 + cfg * 256 + (e0_ - sft_);
#pragma unroll
    for (int a = 0; a < 5; ++a) {
        const int eo = (kbase + 32 * a >= 0) ? 32 * a : 160;
#pragma unroll
        for (int k8 = 0; k8 < 4; ++k8) { const f32x4 ev = *(const LAS f32x4*)(ext + eo + 8 * k8); S[a][4 * k8] = ev[0]; S[a][4 * k8 + 1] = ev[1]; S[a][4 * k8 + 2] = ev[2]; S[a][4 * k8 + 3] = ev[3]; }
    }
    const int tl = d * (iq0 + q) + r - 512 * blk;
    u32x4 A0[2][2], A2[2][2]; float l0 = 0.f, l2 = 0.f;
    if constexpr (MG) {
        l0 = mg.lsc[tl]; l2 = mg.lsc[1024 + tl];
#pragma unroll
        for (int dh = 0; dh < 2; ++dh)
#pragma unroll
            for (int k2 = 0; k2 < 2; ++k2) { A0[dh][k2] = *(const u32x4*)(mg.osc0 + (size_t)tl * 64 + 32 * dh + 16 * k2 + 8 * hi); A2[dh][k2] = *(const u32x4*)(mg.osc2 + (size_t)tl * 64 + 32 * dh + 16 * k2 + 8 * hi); }
    }
    {
        bf16x8 kf[2][4];
#define AT_LDK(buf, a_) do { const int row_ = row0 + 32 * (a_) + q; const LAS unsigned char* kr_ = kl + row_ * 128; const int sw_ = (row_ >> 1) & 7; \
            _Pragma("unroll") for (int d0 = 0; d0 < 4; ++d0) kf[buf][d0] = *(const LAS bf16x8*)(kr_ + (((2 * d0 + hi) ^ sw_) << 4)); } while (0)
        AT_LDK(0, 0);
#pragma unroll
        for (int a = 0; a < 5; ++a) {
            if (a < 4) AT_LDK((a + 1) & 1, a + 1);
#pragma unroll
            for (int d0 = 0; d0 < 4; ++d0) S[a] = __builtin_amdgcn_mfma_f32_32x32x16_bf16(kf[a & 1][d0], qf[d0], S[a], 0, 0, 0);
        }
#undef AT_LDK
    }
    float m = NEG;
#pragma unroll
    for (int a = 0; a < 5; ++a)
#pragma unroll
        for (int rr = 0; rr < 16; ++rr) m = fmaxf(m, S[a][rr]);
    m = halves_max(m);
    float lsum = 0.f;
#pragma unroll
    for (int a = 0; a < 5; ++a)
#pragma unroll
        for (int rr = 0; rr < 16; ++rr) { const float p = __builtin_amdgcn_exp2f(S[a][rr] - m); S[a][rr] = p; lsum += p; }
    lsum = halves_sum(lsum);
    f32x16 o[2];
#pragma unroll
    for (int dh = 0; dh < 2; ++dh)
#pragma unroll
        for (int rr = 0; rr < 16; ++rr) o[dh][rr] = 0.f;
    const LAS unsigned char* vrd = vl + ((lane >> 4) & 1) * 32 + (lane & 3) * 8 + (4 * hi + ((lane & 15) >> 2)) * 64 + (row0 >> 4) * 1024;
    {
        s16x4 vr[2][4];
#define AT_LDV(buf, st_) do { _Pragma("unroll") for (int dh = 0; dh < 2; ++dh) { const LAS unsigned char* vp_ = vrd + dh * vdh + (st_) * 1024; vr[buf][2 * dh] = vtr(vp_); vr[buf][2 * dh + 1] = vtr(vp_ + 512); } } while (0)
        AT_LDV(0, 0);
#pragma unroll
        for (int st = 0; st < 10; ++st) {
            if (st < 9) AT_LDV((st + 1) & 1, st + 1);
            const int a = st >> 1, ks = st & 1;
            u32x4 pw; pw.x = cvtpk(S[a][8 * ks + 0], S[a][8 * ks + 1]); pw.y = cvtpk(S[a][8 * ks + 2], S[a][8 * ks + 3]); pw.z = cvtpk(S[a][8 * ks + 4], S[a][8 * ks + 5]); pw.w = cvtpk(S[a][8 * ks + 6], S[a][8 * ks + 7]);
            const bf16x8 pb = __builtin_bit_cast(bf16x8, pw);
#pragma unroll
            for (int dh = 0; dh < 2; ++dh) {
                const s16x4 lo = vr[st & 1][2 * dh], hh = vr[st & 1][2 * dh + 1];
                const bf16x8 vf = (bf16x8){lo[0], lo[1], lo[2], lo[3], hh[0], hh[1], hh[2], hh[3]};
                o[dh] = __builtin_amdgcn_mfma_f32_32x32x16_bf16(vf, pb, o[dh], 0, 0, 0);
            }
        }
#undef AT_LDV
    }
    const float inv = __builtin_amdgcn_rcpf(lsum);
    if constexpr (MG) {
        const float l1 = m + __builtin_amdgcn_logf(lsum);
        const float mx = fmaxf(l0, fmaxf(l1, l2));
        float w0 = __builtin_amdgcn_exp2f(l0 - mx), w1 = __builtin_amdgcn_exp2f(l1 - mx), w2 = __builtin_amdgcn_exp2f(l2 - mx);
        const float iw = __builtin_amdgcn_rcpf(w0 + w1 + w2); w0 *= iw; w2 *= iw; w1 *= iw * inv;
        float ss = 0.f;
        bf16* arow = mg.a3 + (size_t)tl * 1024;
#pragma unroll
        for (int dh = 0; dh < 2; ++dh)
#pragma unroll
            for (int k2 = 0; k2 < 2; ++k2) {
                uint2 x0[2], x2[2], pk[2]; pair_unswap(A0[dh][k2], x0[0], x0[1]); pair_unswap(A2[dh][k2], x2[0], x2[1]);
#pragma unroll
                for (int i = 0; i < 2; ++i) {
                    const int ob = 8 * k2 + 4 * i;
                    const float v0 = w1 * o[dh][ob] + w0 * __uint_as_float(x0[i].x << 16) + w2 * __uint_as_float(x2[i].x << 16);
                    const float v1 = w1 * o[dh][ob + 1] + w0 * __uint_as_float(x0[i].x & 0xffff0000u) + w2 * __uint_as_float(x2[i].x & 0xffff0000u);
                    const float v2 = w1 * o[dh][ob + 2] + w0 * __uint_as_float(x0[i].y << 16) + w2 * __uint_as_float(x2[i].y << 16);
                    const float v3 = w1 * o[dh][ob + 3] + w0 * __uint_as_float(x0[i].y & 0xffff0000u) + w2 * __uint_as_float(x2[i].y & 0xffff0000u);
                    pk[i].x = cvtpk(v0, v1); pk[i].y = cvtpk(v2, v3);
                    ss += (v0 * v0 + v1 * v1) + (v2 * v2 + v3 * v3);
                }
                *(u32x4*)(arow + 32 * dh + 16 * k2 + 8 * hi) = pair_swap(pk[0], pk[1]);
            }
        ss = halves_sum(ss);
        if (hi == 0) mg.ssq[(size_t)tl * 16] = ss;
        return;
    }
    bf16* orow = osc + (size_t)tl * 64;
#pragma unroll
    for (int dh = 0; dh < 2; ++dh)
#pragma unroll
        for (int k2 = 0; k2 < 2; ++k2) {
            uint2 pa, pb;
            pa.x = cvtpk(o[dh][8 * k2] * inv, o[dh][8 * k2 + 1] * inv); pa.y = cvtpk(o[dh][8 * k2 + 2] * inv, o[dh][8 * k2 + 3] * inv);
            pb.x = cvtpk(o[dh][8 * k2 + 4] * inv, o[dh][8 * k2 + 5] * inv); pb.y = cvtpk(o[dh][8 * k2 + 6] * inv, o[dh][8 * k2 + 7] * inv);
            if (WT) { __hip_atomic_store((unsigned long long*)(orow + 32 * dh + 16 * k2 + 4 * hi), ((unsigned long long)pa.y << 32) | pa.x, __ATOMIC_RELAXED, __HIP_MEMORY_SCOPE_AGENT);
                      __hip_atomic_store((unsigned long long*)(orow + 32 * dh + 16 * k2 + 8 + 4 * hi), ((unsigned long long)pb.y << 32) | pb.x, __ATOMIC_RELAXED, __HIP_MEMORY_SCOPE_AGENT); }
            else *(u32x4*)(orow + 32 * dh + 16 * k2 + 8 * hi) = pair_swap(pa, pb);
        }
    if (hi == 0) { const float lv = m + __builtin_amdgcn_logf(lsum);
        if (WT) __hip_atomic_store(lsrow + tl, lv, __ATOMIC_RELAXED, __HIP_MEMORY_SCOPE_AGENT); else lsrow[tl] = lv; }
}

__device__ __forceinline__ void attn_unit(const Args& a, const Ctx& c, int l, int cslot) {
    const bf16* proj = (const bf16*)(a.ws + WS_PROJ); bf16* A3 = (bf16*)(a.ws + WS_A3);
    const bf16* qh = (const bf16*)(a.ws + WS_QH); const bf16* kh = (const bf16*)(a.ws + WS_KH); const bf16* vh = (const bf16*)(a.ws + WS_VH);
    float* ssqc = (float*)(a.ws + WS_SMALL + SO_SSQC);
    const int xcd = c.wg & 7, j = c.wg >> 3, p = xcd * 8 + (j >> 2), blk = j & 3, b = p >> 3, h = p & 7;
    bf16* osc01 = (bf16*)(a.ws + WS_XA + (size_t)xcd * 4 * MiB) + (size_t)j * (2 * 512 * 64); bf16* osc2 = (bf16*)(a.ws + WS_ACTX + (size_t)xcd * 4 * MiB + 256 * 1024) + (size_t)j * (512 * 64);
    float* lsc = (float*)(a.ws + WS_ACTX + (size_t)xcd * 4 * MiB) + (size_t)j * (3 * 512);
    {
        LAS float* ext = (LAS float*)(c.lds + EXT_OFF); const float* relb = a.in[I_RELB];
        for (int x = c.tid; x < 3 * 256; x += NTHREADS) {
            const int cfg = x >> 8, xx = x & 255, rel = 159 - xx;
            ext[x] = (rel >= 0 && rel <= 128) ? relb[(int)T5B[cfg][rel] * 8 + h] * LOG2E : NEG;
        }
        __syncthreads();
        for (int x = c.tid; x < 3 * 768; x += NTHREADS) {
            const int s = 1 + x / 768, y = x % 768;
            ext[s * 768 + y] = ((y & 255) + s < 256) ? ext[y + s] : NEG;
        }
    }
    const int q = c.lane & 31, hi = c.lane >> 5;
    __syncthreads();
    LAS unsigned char* vbuf = c.lds + 98304 + c.wave * 4096;
    const MergeArgs mga{osc01, osc2, lsc, A3 + ((size_t)b * SEQ + 512 * blk) * 1024 + 512 + h * 64, ssqc + ((size_t)b * SEQ + 512 * blk) * 16 + 8 + h};
#pragma unroll 1
    for (int hf = 0; hf < 2; ++hf) {
        const int kb0 = 512 * blk + 256 * hf - 128, iq0 = 512 * blk + 256 * hf + 32 * c.wave;
        stage_kv(kh, vh, b, h, 1, 0, kb0, 384, c.lds, c.lds + 49152, c.wave, c.lane, 0, 8);
        attn_task(qh, kh, vh, b, h, 2, 2 * c.wave + hf, 32 * blk, blk, c.lds, vbuf, osc2, lsc, c.lane);
        bf16x8 qf[4];
        const size_t rowq = ((size_t)(b * 8 + h) * SEQ + iq0 + q) * 64;
#pragma unroll
        for (int d0 = 0; d0 < 4; ++d0) qf[d0] = *(const bf16x8*)(qh + rowq + 16 * d0 + 8 * hi);
        asm volatile("s_waitcnt vmcnt(0)" ::: "memory");
        __syncthreads();
        attn_task_lds<false, false>(proj, b, h, 0, 0, iq0, blk, qf, c.lds, c.lds + 49152, 384 * 64, 32 * c.wave, c.lds, osc01, lsc, c.lane, mga);
        __syncthreads();
    }
#pragma unroll 1
    for (int rd_ = 0; rd_ < ((P2_REP & 2) ? 4 : 2); ++rd_) { const int rd = rd_ & 1;
        const int kb0 = 128 * blk - 128, s = c.wave >> 2, r = 2 * rd + s, iq0 = 128 * blk + 32 * (c.wave & 3);
        bf16x8 qf[4];
        const size_t rowq = ((size_t)(b * 8 + h) * SEQ + 4 * (iq0 + q) + r) * 64;
#pragma unroll
        for (int d0 = 0; d0 < 4; ++d0) qf[d0] = *(const bf16x8*)(qh + rowq + 16 * d0 + 8 * hi);
        stage_kv(kh, vh, b, h, 4, 2 * rd, kb0, 256, c.lds, c.lds + 65536, c.wave, c.lane, 0, 8);
        stage_kv(kh, vh, b, h, 4, 2 * rd + 1, kb0, 256, c.lds + 32768, c.lds + 65536 + 32768, c.wave, c.lane, 0, 8);
        asm volatile("s_waitcnt vmcnt(0)" ::: "memory");
        __syncthreads();
        attn_task_lds<false, true>(proj, b, h, 1, r, iq0, blk, qf, c.lds + s * 32768, c.lds + 65536 + s * 32768, 256 * 64, 32 * (c.wave & 3), c.lds, osc01 + 512 * 64, lsc + 512, c.lane, mga);
        __syncthreads();
    }
    __syncthreads();
}

__device__ __forceinline__ void gmlp_unit(const Args& a, const Ctx& c, int l) {
    const bf16* proj = (const bf16*)(a.ws + WS_PROJ); bf16* A3 = (bf16*)(a.ws + WS_A3); float* ssqc = (float*)(a.ws + WS_SMALL + SO_SSQC);
    const bf16* wsp = (const bf16*)(a.ws + WS_WS) + (size_t)l * 8 * 128 * 128;
    const float* lng = a.in[I_LNG] + l * 512; const float* lnb = a.in[I_LNB] + l * 512; const float* gbs = a.in[I_GBS] + l * 8 * 128;
    const int bn = (c.wg & 7) * 16 + (c.wg >> 4), hf = (c.wg >> 3) & 1, t0 = bn * CHUNK;
    const int gl = c.wave & 3, th = c.wave >> 2, g = 4 * hf + gl, q = c.lane & 31, hi = c.lane >> 5;
    u32x4 raw[16];
#pragma unroll
    for (int i = 0; i < 16; ++i) raw[i] = *(const u32x4*)(proj + (size_t)(t0 + c.wave * 16 + i) * 1024 + 512 + c.lane * 8);
    const f32x4 g0 = *(const f32x4*)(lng + c.lane * 8), g1 = *(const f32x4*)(lng + c.lane * 8 + 4), b0 = *(const f32x4*)(lnb + c.lane * 8), b1 = *(const f32x4*)(lnb + c.lane * 8 + 4);
    bf16x8 wf[2][8]; u32x4 uw[2][2][2]; float bias[2];
#pragma unroll
    for (int tt = 0; tt < 2; ++tt) {
        const int t = 32 * (2 * th + tt) + q;
        const bf16* wrow = wsp + ((size_t)g * 128 + t) * 128 + 8 * hi;
#pragma unroll
        for (int ks = 0; ks < 8; ++ks) wf[tt][ks] = *(const bf16x8*)(wrow + 16 * ks);
#pragma unroll
        for (int eh = 0; eh < 2; ++eh)
#pragma unroll
            for (int k2 = 0; k2 < 2; ++k2) uw[tt][eh][k2] = *(const u32x4*)(proj + ((size_t)t0 + t) * 1024 + g * 64 + 32 * eh + 16 * k2 + 8 * hi);
        bias[tt] = gbs[g * 128 + t];
    }
    {
        const int e8 = c.lane & 7, glw = (c.lane >> 3) & 3;
#pragma unroll
        for (int i = 0; i < 16; ++i) {
            float v[8]; float sm = 0.f, sq = 0.f;
#pragma unroll
            for (int e = 0; e < 4; ++e) { v[2 * e] = __uint_as_float(raw[i][e] << 16); v[2 * e + 1] = __uint_as_float(raw[i][e] & 0xffff0000u); sm += v[2 * e] + v[2 * e + 1]; sq += v[2 * e] * v[2 * e] + v[2 * e + 1] * v[2 * e + 1]; }
            sm = wave_sum(sm); sq = wave_sum(sq);
            const float mu = sm * (1.0f / 512.0f), var = fmaxf(sq * (1.0f / 512.0f) - mu * mu, 0.f), rs = rsqrtf(var + EPS);
            if (hi == hf) {
                const int s = c.wave * 16 + i;
                u32x4 w;
                w.x = cvtpk((v[0] - mu) * rs * g0[0] + b0[0], (v[1] - mu) * rs * g0[1] + b0[1]); w.y = cvtpk((v[2] - mu) * rs * g0[2] + b0[2], (v[3] - mu) * rs * g0[3] + b0[3]);
                w.z = cvtpk((v[4] - mu) * rs * g1[0] + b1[0], (v[5] - mu) * rs * g1[1] + b1[1]); w.w = cvtpk((v[6] - mu) * rs * g1[2] + b1[2], (v[7] - mu) * rs * g1[3] + b1[3]);
                *(LAS u32x4*)(c.lds + glw * 16384 + (e8 >> 2) * 8192 + (s >> 4) * 1024 + (s & 15) * 64 + (e8 & 3) * 16) = w;
            }
        }
    }
    __syncthreads();
    {
        const LAS unsigned char* vr = c.lds + gl * 16384 + ((c.lane >> 4) & 1) * 32 + (c.lane & 3) * 8 + (4 * hi + ((c.lane & 15) >> 2)) * 64;
#pragma unroll
        for (int tt = 0; tt < 2; ++tt) {
            const int tti = 2 * th + tt, t = 32 * tti + q;
            const size_t tg = (size_t)t0 + t;
            f32x16 acc[2];
#pragma unroll
            for (int eh = 0; eh < 2; ++eh)
#pragma unroll
                for (int rr = 0; rr < 16; ++rr) acc[eh][rr] = 0.f;
#pragma unroll
            for (int ks = 0; ks < 8; ++ks) {
                if (ks < 2 * tti + 2) {
#pragma unroll
                    for (int eh = 0; eh < 2; ++eh) {
                        const s16x4 lo = vtr(vr + eh * 8192 + ks * 1024), hh = vtr(vr + eh * 8192 + ks * 1024 + 512);
                        const bf16x8 vf = (bf16x8){lo[0], lo[1], lo[2], lo[3], hh[0], hh[1], hh[2], hh[3]};
                        acc[eh] = __builtin_amdgcn_mfma_f32_32x32x16_bf16(vf, wf[tt][ks], acc[eh], 0, 0, 0);
                    }
                }
            }
            float ss = 0.f;
#pragma unroll
            for (int eh = 0; eh < 2; ++eh)
#pragma unroll
                for (int k2 = 0; k2 < 2; ++k2) {
                    uint2 uu[2], pk[2]; pair_unswap(uw[tt][eh][k2], uu[0], uu[1]);
#pragma unroll
                    for (int i = 0; i < 2; ++i) { const int k4 = 2 * k2 + i; const uint2 uv = uu[i];
                        const float o0 = (acc[eh][4 * k4] + bias[tt]) * __uint_as_float(uv.x << 16), o1 = (acc[eh][4 * k4 + 1] + bias[tt]) * __uint_as_float(uv.x & 0xffff0000u);
                        const float o2 = (acc[eh][4 * k4 + 2] + bias[tt]) * __uint_as_float(uv.y << 16), o3 = (acc[eh][4 * k4 + 3] + bias[tt]) * __uint_as_float(uv.y & 0xffff0000u);
                        pk[i].x = cvtpk(o0, o1); pk[i].y = cvtpk(o2, o3);
                        ss += (o0 * o0 + o1 * o1) + (o2 * o2 + o3 * o3); }
                    *(u32x4*)(A3 + tg * 1024 + g * 64 + 32 * eh + 16 * k2 + 8 * hi) = pair_swap(pk[0], pk[1]);
                }
            ss = halves_sum(ss);
            if (hi == 0) ssqc[tg * 16 + g] = ss;
        }
    }
    __syncthreads();
}
}
__device__ __forceinline__ void phase_p2_fast(const Args& a, const Ctx& c, int l, int cslot) {
    p2::attn_unit(a, c, l, cslot);
    p2::gmlp_unit(a, c, l);
    if ((DUP_MASK >> 10) & 1) p2::gmlp_unit(a, c, l);
}

constexpr int NPL = MERGE45 ? 4 : 5;
constexpr int NPHASE = 1 + NPL * DEPTH + 1;
__device__ __forceinline__ Ctx make_ctx(int tid, LAS unsigned char* lds, int zs) {
    Ctx c; c.lds = lds; c.tid = tid; c.lane = tid & 63; c.wave = __builtin_amdgcn_readfirstlane(tid >> 6);
    c.wg = (int)blockIdx.x + zs; c.nwg = (int)gridDim.x + zs; c.gw = c.wg * NWAVES + c.wave; c.ngw = c.nwg * NWAVES; c.gtid = c.wg * NTHREADS + tid; c.ngt = c.nwg * NTHREADS;
    return c;
}
__global__ void __launch_bounds__(NTHREADS, 2) fwd_kernel(Args a0) {
    extern __shared__ __attribute__((aligned(16))) unsigned char lds_raw[];
    LAS unsigned char* const lds0 = (LAS unsigned char*)lds_raw;
    volatile LAS unsigned* MISC = (volatile LAS unsigned*)(lds0 + LDSCTL_OFF);
    int tid_ = threadIdx.x;
    const int wv_ = __builtin_amdgcn_readfirstlane(tid_ >> 6);
    for (int u = tid_; u < (LDS_BYTES - LDSCTL_OFF) / 4; u += NTHREADS) MISC[u] = 0u;
    __syncthreads();
    const int lo = a0.ph_lo, hi = a0.ph_hi;
    XcdBarrier bar; bar.bar = (unsigned*)(a0.ws + WS_CTL) + CW_BAR; bar.x = 0; bar.st = MISC + 8;
    if (hi - lo > 1) bar = xcd_barrier_post((unsigned*)(a0.ws + WS_CTL) + CW_BAR, MISC + 8, tid_);
    if (tid_ == 0) __hip_atomic_store((unsigned*)(a0.ws + WS_CTL) + CW_XT + blockIdx.x, xb_xcc_id() + 1u, __ATOMIC_RELAXED, __HIP_MEMORY_SCOPE_AGENT);
    int pure = 0;
    int ph = 0;
#define RUN_PHASE(kind, body) do { if (ph >= lo && ph < hi) { for (int rep_ = 0; rep_ < (((DUP_MASK >> (kind)) & 1) ? 2 : 1); ++rep_) { int zs_ = 0; asm volatile("" : "+s"(zs_)); Args a = a0; \
        _Pragma("unroll") for (int i_ = 0; i_ < 21; ++i_) a.in[i_] = a0.in[i_] + zs_; a.out = a0.out + zs_; a.ws = a0.ws + zs_; \
        tid_ = wv_ * 64 + (int)__builtin_amdgcn_mbcnt_hi(~0u, __builtin_amdgcn_mbcnt_lo(~0u, (unsigned)zs_)); asm volatile("" : "+v"(tid_)); const Ctx c = make_ctx(tid_, lds0 + zs_, zs_); body; if (ph + 1 < hi || rep_ == 0 && ((DUP_MASK >> (kind)) & 1)) { \
            if (((kind) == 2 || (kind) == 3) && pure && DUP_MASK == 0) group_barrier((unsigned*)(a0.ws + WS_CTL), ((ph - 1) / NPL) * 2 + ((kind) - 2), (int)blockIdx.x + zs_, tid_); else xcd_barrier(bar, tid_); } } } ++ph; } while (0)
    RUN_PHASE(0, { phase_p0a(a, c); phase_p0b(a, c); });
    if (lo == 0 && hi == NPHASE && gridDim.x == 256) {
        tid_ = wv_ * 64 + (int)__builtin_amdgcn_mbcnt_hi(~0u, __builtin_amdgcn_mbcnt_lo(~0u, 0u));
        if (tid_ < 256) { unsigned* xt = (unsigned*)(a0.ws + WS_CTL) + CW_XT; const unsigned v = xb_ld(xt + tid_), r = xb_ld(xt + (tid_ & 7)); if (v != r || v == 0u) MISC[13] = 1u; }
        __syncthreads();
        pure = __builtin_amdgcn_readfirstlane(MISC[13] == 0u ? 1 : 0);
    }
    for (int l = 0; l < DEPTH; ++l) {
        RUN_PHASE(2, phase_p1_fast(a, c, l));
        RUN_PHASE(3, phase_p2_fast(a, c, l, l + 2 * rep_));
        RUN_PHASE(4, phase_p3_fast(a, c, l, l + 2 * rep_, pure));
#if MERGE45
        RUN_PHASE(6, phase_p45(a, c, l, l + 2 * rep_, pure));
#else
        RUN_PHASE(6, phase_p4_fast(a, c, l));
        RUN_PHASE(7, phase_p5_fast(a, c, l));
#endif
    }
    RUN_PHASE(8, phase_p6(a, c));
#undef RUN_PHASE
}

extern "C" void kernel_launch(void* const* d_in, const int* in_sizes, int n_in, void* d_out, int out_size, void* d_ws, size_t ws_size, hipStream_t stream) {
    static int grid = 0;
    if (grid == 0) {
        if (n_in != 21 || out_size != T * D || ws_size < WS_END) { fprintf(stderr, "kernel_launch: unexpected shapes (n_in %d, out %d, ws %zu)\n", n_in, out_size, ws_size); grid = -1; return; }
        int dev = 0, cus = 0, per_cu = 0;
        if (hipGetDevice(&dev) != hipSuccess || hipDeviceGetAttribute(&cus, hipDeviceAttributeMultiprocessorCount, dev) != hipSuccess) { grid = -1; return; }
        if (hipFuncSetAttribute((const void*)fwd_kernel, hipFuncAttributeMaxDynamicSharedMemorySize, LDS_BYTES) != hipSuccess) { fprintf(stderr, "kernel_launch: hipFuncSetAttribute failed\n"); grid = -1; return; }
        if (hipOccupancyMaxActiveBlocksPerMultiprocessor(&per_cu, (const void*)fwd_kernel, NTHREADS, LDS_BYTES) != hipSuccess || per_cu < 1)
            fprintf(stderr, "kernel_launch: occupancy query reports %d workgroups per CU\n", per_cu);
        (void)hipGetLastError();
        grid = cus;
    }
    if (grid < 0) return;
    if (hipMemsetAsync((char*)d_ws + WS_CTL, 0, CTL_BYTES, stream) != hipSuccess) return;
    Args a{};
    for (int i = 0; i < 21; ++i) a.in[i] = (const float*)d_in[i];
    a.out = (float*)d_out; a.ws = (unsigned char*)d_ws;
#if N_LAUNCH_MODE == 1
    a.ph_lo = 0; a.ph_hi = NPHASE;
    hipLaunchKernelGGL(fwd_kernel, dim3(grid), dim3(NTHREADS), LDS_BYTES, stream, a);
#else
    for (int ph = 0; ph < NPHASE; ++ph) {
        a.ph_lo = ph; a.ph_hi = ph + 1;
        hipLaunchKernelGGL(fwd_kernel, dim3(grid), dim3(NTHREADS), LDS_BYTES, stream, a);
    }
#endif
}
```

```cpp
#include <hip/hip_runtime.h>
#include <cstdio>
#include <cstdint>

constexpr int D = 1024, BATCH = 8, SEQ = 2048, T = BATCH * SEQ, DEPTH = 2;
constexpr int AW = 512, HD = 64, INC = 2560, CHUNK = 128;
constexpr int NE = 16, DE = 512, NBKT = 24, TOKCAP = 16384;
constexpr float EPS = 1e-6f;
constexpr float LOG2E = 1.4426950408889634f;
constexpr float C2 = 0.125f * LOG2E;
#ifndef FAST_P2
#define FAST_P2 1
#endif
#ifndef MERGE45
#define MERGE45 1
#endif
#ifndef EPI_TWICE
#define EPI_TWICE 0
#endif
#ifndef P2_REP
#define P2_REP 0
#endif
#ifndef DUP_MASK
#define DUP_MASK 0
#endif
#ifndef N_LAUNCH_MODE
#define N_LAUNCH_MODE 1
#endif

constexpr size_t MiB = 1u << 20;
constexpr size_t WS_CTL = 0, CTL_BYTES = 131072;
constexpr size_t WS_SMALL = 1 * MiB;
constexpr size_t WS_WIN = 9 * MiB;
constexpr size_t WS_WOUT = 19 * MiB;
constexpr size_t WS_WS = 23 * MiB;
constexpr size_t WS_WGU = 24 * MiB;
constexpr size_t WS_WD = 88 * MiB;
constexpr size_t WS_XA = 120 * MiB;
constexpr size_t WS_X2B = 152 * MiB;
constexpr size_t WS_ACTX = 184 * MiB;
constexpr size_t WS_PROJ = 216 * MiB;
constexpr size_t WS_QH = WS_PROJ + 32 * MiB, WS_KH = WS_PROJ + 48 * MiB, WS_VH = WS_PROJ + 64 * MiB;
constexpr size_t WS_A3 = 296 * MiB;
constexpr size_t WS_END = 328 * MiB;
constexpr size_t WS_ACT = WS_PROJ;
constexpr size_t SO_MODV = 0;
constexpr size_t SO_G1 = 512 * 1024;
constexpr size_t SO_G2 = 576 * 1024;
constexpr size_t SO_BIAS1 = 640 * 1024;
constexpr size_t SO_RBIAS = 800 * 1024;
constexpr size_t SO_BIASGU = 1 * MiB;
constexpr size_t SO_GATES = 2 * MiB;
constexpr size_t SO_TOKL = 2 * MiB + 512 * 1024;
constexpr size_t SO_SSQA = 4 * MiB;
constexpr size_t SO_SSQB = 5 * MiB;
constexpr size_t SO_ROWX = 7 * MiB + 512 * 1024;
constexpr size_t SO_RWT = 7 * MiB;
constexpr size_t SO_EXTG = 7 * MiB + 64 * 1024;
constexpr size_t SO_SSQC = 6 * MiB;
constexpr int CW_TMO = 0, CW_CNT = 64  , CW_BAR = 1024, CW_RDY = 8192  , CW_MOD = 32  , CW_SIB = 24576  , CW_PNL = 16384  ,
              CW_XT = 28672  , CW_GRP = 29184  ;

constexpr int NWAVES = 8, NTHREADS = 512;
constexpr int LDS_BYTES = 162816;
constexpr int LDSCTL_OFF = 143360;

#define GAS __attribute__((address_space(1)))
#define LAS __attribute__((address_space(3)))
typedef unsigned short bf16;
typedef short bf16x8 __attribute__((ext_vector_type(8)));
typedef float f32x4 __attribute__((ext_vector_type(4)));
typedef unsigned u32x4 __attribute__((ext_vector_type(4)));
#define LDS_WAIT() asm volatile("s_waitcnt lgkmcnt(0)" ::: "memory")

__device__ __forceinline__ float bf2f(bf16 b) { return __uint_as_float((unsigned)b << 16); }
__device__ __forceinline__ unsigned f2bf(float f) { unsigned u = __float_as_uint(f); return (u + 0x7fffu + ((u >> 16) & 1u)) >> 16; }
__device__ __forceinline__ unsigned pk2(float lo, float hi) { unsigned r; asm volatile("v_cvt_pk_bf16_f32 %0, %1, %2" : "=v"(r) : "v"(lo), "v"(hi)); return r; }
__device__ __forceinline__ float wave_sum(float v) {
    v += __builtin_bit_cast(float, __builtin_amdgcn_update_dpp(0, __builtin_bit_cast(int, v), 0xB1, 0xF, 0xF, true));
    v += __builtin_bit_cast(float, __builtin_amdgcn_update_dpp(0, __builtin_bit_cast(int, v), 0x4E, 0xF, 0xF, true));
    v += __builtin_bit_cast(float, __builtin_amdgcn_update_dpp(0, __builtin_bit_cast(int, v), 0x141, 0xF, 0xF, true));
    v += __builtin_bit_cast(float, __builtin_amdgcn_update_dpp(0, __builtin_bit_cast(int, v), 0x140, 0xF, 0xF, true));
    { auto rr = __builtin_amdgcn_permlane16_swap(__float_as_uint(v), __float_as_uint(v), false, false); v = __uint_as_float(rr[0]) + __uint_as_float(rr[1]); }
    { auto rr = __builtin_amdgcn_permlane32_swap(__float_as_uint(v), __float_as_uint(v), false, false); v = __uint_as_float(rr[0]) + __uint_as_float(rr[1]); }
    return v;
}
__device__ __forceinline__ float rows_sum(float v) {
    { auto rr = __builtin_amdgcn_permlane16_swap(__float_as_uint(v), __float_as_uint(v), false, false); v = __uint_as_float(rr[0]) + __uint_as_float(rr[1]); }
    { auto rr = __builtin_amdgcn_permlane32_swap(__float_as_uint(v), __float_as_uint(v), false, false); v = __uint_as_float(rr[0]) + __uint_as_float(rr[1]); }
    return v;
}
__device__ __forceinline__ float rows_max(float v) {
    { auto rr = __builtin_amdgcn_permlane16_swap(__float_as_uint(v), __float_as_uint(v), false, false); v = fmaxf(__uint_as_float(rr[0]), __uint_as_float(rr[1])); }
    { auto rr = __builtin_amdgcn_permlane32_swap(__float_as_uint(v), __float_as_uint(v), false, false); v = fmaxf(__uint_as_float(rr[0]), __uint_as_float(rr[1])); }
    return v;
}
__device__ __forceinline__ float oct_sum(float v) {
    v += __builtin_bit_cast(float, __builtin_amdgcn_update_dpp(0, __builtin_bit_cast(int, v), 0xB1, 0xF, 0xF, true));
    v += __builtin_bit_cast(float, __builtin_amdgcn_update_dpp(0, __builtin_bit_cast(int, v), 0x4E, 0xF, 0xF, true));
    v += __builtin_bit_cast(float, __builtin_amdgcn_update_dpp(0, __builtin_bit_cast(int, v), 0x141, 0xF, 0xF, true));
    return v;
}
__device__ __forceinline__ float gelu_exact(float x) { return 0.5f * x * (1.0f + erff(x * 0.70710678118654752f)); }
__device__ __forceinline__ float silu_f(float x) { return x / (1.0f + __expf(-x)); }

__device__ const unsigned char T5B[3][132] = {
{0,1,2,3,4,5,6,7,8,9,10,11,12,13,14,15,16,16,16,16,16,16,17,17,17,17,17,17,17,17,18,18,18,18,18,18,18,18,18,18,19,19,19,19,19,19,19,19,19,19,19,19,19,19,20,20,20,20,20,20,20,20,20,20,20,20,20,20,20,20,20,20,20,21,21,21,21,21,21,21,21,21,21,21,21,21,21,21,21,21,21,21,21,21,21,21,21,21,21,22,22,22,22,22,22,22,22,22,22,22,22,22,22,22,22,22,22,22,22,22,22,22,22,22,22,22,22,22,22,0,0,0},
{0,4,8,12,16,16,17,17,18,18,19,19,19,19,20,20,20,20,20,21,21,21,21,21,21,22,22,22,22,22,22,22,22,22,23,23,23,23,23,23,23,23,23,23,23,23,24,24,24,24,24,24,24,24,24,24,24,24,24,24,24,24,25,25,25,25,25,25,25,25,25,25,25,25,25,25,25,25,25,25,25,25,25,26,26,26,26,26,26,26,26,26,26,26,26,26,26,26,26,26,26,26,26,26,26,26,26,26,26,26,26,26,26,27,27,27,27,27,27,27,27,27,27,27,27,27,27,27,27,0,0,0},
{0,16,18,19,20,21,21,22,22,23,23,23,24,24,24,24,25,25,25,25,25,26,26,26,26,26,26,26,26,27,27,27,27,27,27,27,27,27,27,28,28,28,28,28,28,28,28,28,28,28,28,28,29,29,29,29,29,29,29,29,29,29,29,29,29,29,29,29,29,29,30,30,30,30,30,30,30,30,30,30,30,30,30,30,30,30,30,30,30,30,30,30,30,30,30,31,31,31,31,31,31,31,31,31,31,31,31,31,31,31,31,31,31,31,31,31,31,31,31,31,31,31,31,31,31,31,31,31,31,0,0,0}};

#define XB_TMO      128
#define XB_XCNT(j)  (256  + 64 * (j))
#define XB_XSUB(j)  (1280 + 64 * (j))
#define XB_XGEN(j)  (2304 + 64 * (j))
#define XB_TOP      3328
#define XB_TOPGEN   3392
#define XCD_BAR_WORDS 3456
#define XB_SPIN_CAP (1u << 18)

__device__ __forceinline__ unsigned xb_ld(unsigned* p)              { return __hip_atomic_load(p, __ATOMIC_RELAXED, __HIP_MEMORY_SCOPE_AGENT); }
__device__ __forceinline__ unsigned xb_add(unsigned* p, unsigned v) { return __hip_atomic_fetch_add(p, v, __ATOMIC_RELAXED, __HIP_MEMORY_SCOPE_AGENT); }
__device__ __forceinline__ unsigned xb_xcc_id() { return (unsigned)__builtin_amdgcn_s_getreg((3 << 11) | 20) & 0xFu; }
#define XB_SPIN(cond, bar) do { unsigned _sp = 0; while (cond) { __builtin_amdgcn_s_sleep(1); \
    if ((++_sp & 255u) == 0u) { if (xb_ld(&(bar)[XB_TMO])) break; if (_sp > XB_SPIN_CAP) { atomicAdd(&(bar)[XB_TMO], 1u); break; } } } } while (0)

struct XcdBarrier {
    unsigned* bar; unsigned x;
    volatile LAS unsigned* st;
};
__device__ __forceinline__ XcdBarrier xcd_barrier_post(unsigned* bar, volatile LAS unsigned* st, int tid) {
    XcdBarrier b; b.bar = bar; b.x = xb_xcc_id(); b.st = st;
    if (tid == 0) (void)xb_add(&bar[XB_XCNT(b.x)], 1u);
    return b;
}
__device__ __forceinline__ void xcd_barrier_complete(unsigned* bar, unsigned x, unsigned& nloc, unsigned& nx) {
    const unsigned G = gridDim.x * gridDim.y * gridDim.z;
    unsigned sum, cnt, mine, sp = 0u;
    for (;;) {
        sum = 0u; cnt = 0u; mine = 0u;
#pragma unroll
        for (unsigned j = 0; j < 16; ++j) { const unsigned c = xb_ld(&bar[XB_XCNT(j)]); sum += c; cnt += (c > 0u) ? 1u : 0u; mine = (j == x) ? c : mine; }
        if (sum == G) break;
        __builtin_amdgcn_s_sleep(1);
        if ((++sp & 255u) == 0u) { if (xb_ld(&bar[XB_TMO])) break; if (sp > XB_SPIN_CAP) { atomicAdd(&bar[XB_TMO], 1u); break; } }
    }
    nloc = mine > 0u ? mine : 1u; nx = cnt > 0u ? cnt : 1u;
}
__device__ __forceinline__ void xcd_barrier(const XcdBarrier& b, int tid) {
    asm volatile("s_waitcnt vmcnt(0)" ::: "memory");
    __syncthreads();
    if (tid == 0) {
        unsigned* bar = b.bar;
        __builtin_amdgcn_s_waitcnt(0);
        unsigned nloc = b.st[0], nx = b.st[1];
        if (nloc == 0u) { xcd_barrier_complete(bar, b.x, nloc, nx); b.st[0] = nloc; b.st[1] = nx; }
        const unsigned old = xb_add(&bar[XB_XSUB(b.x)], 1u);
        const unsigned gen = old / nloc;
        if (old + 1u == (gen + 1u) * nloc) {
            __builtin_amdgcn_fence(__ATOMIC_RELEASE, "agent");
            asm volatile("s_waitcnt vmcnt(0)" ::: "memory");
            const unsigned og = xb_add(&bar[XB_TOP], 1u);
            const unsigned tg = og / nx;
            if (og + 1u == (tg + 1u) * nx) xb_add(&bar[XB_TOPGEN], 1u);
            else XB_SPIN(xb_ld(&bar[XB_TOPGEN]) == tg, bar);
            __builtin_amdgcn_fence(__ATOMIC_ACQUIRE, "agent");
            xb_add(&bar[XB_XGEN(b.x)], 1u);
            asm volatile("s_waitcnt vmcnt(0)" ::: "memory");
        } else {
            XB_SPIN(xb_ld(&bar[XB_XGEN(b.x)]) == gen, bar);
            __builtin_amdgcn_fence(__ATOMIC_ACQUIRE, "agent");
            asm volatile("s_waitcnt vmcnt(0)" ::: "memory");
        }
    }
    __syncthreads();
}

__device__ __forceinline__ void group_barrier(unsigned* ctl, int inst, int wg, int tid) {
    asm volatile("s_waitcnt vmcnt(0)" ::: "memory");
    __syncthreads();
    if (tid == 0) {
        unsigned* w = ctl + CW_GRP + (inst * 8 + (wg & 7)) * 16; unsigned* bar = ctl + CW_BAR;
        __builtin_amdgcn_s_waitcnt(0);
        (void)xb_add(w, 1u);
        XB_SPIN(xb_ld(w) < 32u, bar);
        __builtin_amdgcn_fence(__ATOMIC_ACQUIRE, "agent");
        asm volatile("s_waitcnt vmcnt(0)" ::: "memory");
    }
    __syncthreads();
}

struct Args { const float* in[21]; float* out; unsigned char* ws; int ph_lo, ph_hi; };
enum { I_X = 0, I_C, I_RELB, I_RW, I_RB, I_MODW, I_MODB, I_N1G, I_WIN, I_LNG, I_LNB, I_GWS, I_GBS, I_ONA, I_ONB, I_WOUT, I_N2G, I_WG, I_WU, I_WD, I_FING };

struct Ctx {
    int tid, lane, wave, wg, nwg, gw, ngw, gtid, ngt;
    LAS unsigned char* lds;
};

__device__ __forceinline__ void bucket_experts(int bkt, int& e0, int& e1) {
    const int grp = bkt / 6, pi = bkt % 6;
    const int pa = (pi >= 3) + (pi >= 5);
    const int pb = pi + 1 - (pa == 0 ? 0 : (pa == 1 ? 2 : 3));
    e0 = grp * 4 + pa; e1 = grp * 4 + pb;
}
__device__ __forceinline__ float rstd_from16(const float* ssq, int t) {
    const f32x4* p = (const f32x4*)(ssq + (size_t)t * 16);
    const f32x4 a = p[0], b = p[1], c = p[2], d = p[3];
    const float s = ((a.x + a.y) + (a.z + a.w)) + ((b.x + b.y) + (b.z + b.w)) + ((c.x + c.y) + (c.z + c.w)) + ((d.x + d.y) + (d.z + d.w));
    return rsqrtf(s * (1.0f / 1024.0f) + EPS);
}

__device__ __forceinline__ void tr_item(const float* W, int ldw, int k0, int n0, bf16* WT, int ldt, int drow0, const float* kscale, float nscale, LAS float* scr, int lane) {
    {
        f32x4 v[8];
#pragma unroll
        for (int j = 0; j < 8; ++j) v[j] = __builtin_nontemporal_load((const f32x4*)&W[(size_t)(k0 + 8 * j + (lane >> 3)) * ldw + n0 + (lane & 7) * 4]);
#pragma unroll
        for (int j = 0; j < 8; ++j) { const int kk = 8 * j + (lane >> 3); const float sc = (kscale ? kscale[k0 + kk] : 1.0f) * nscale; LAS float* d = scr + kk * 33 + (lane & 7) * 4;
            d[0] = v[j][0] * sc; d[1] = v[j][1] * sc; d[2] = v[j][2] * sc; d[3] = v[j][3] * sc; }
    }
    LDS_WAIT(); asm volatile("" ::: "memory");
    const int c = lane & 7;
#pragma unroll
    for (int j = 0; j < 4; ++j) {
        const int n = (lane >> 3) + 8 * j; const LAS float* s = scr + (8 * c) * 33 + n;
        u32x4 o; o.x = pk2(s[0 * 33], s[1 * 33]); o.y = pk2(s[2 * 33], s[3 * 33]); o.z = pk2(s[4 * 33], s[5 * 33]); o.w = pk2(s[6 * 33], s[7 * 33]);
        __builtin_nontemporal_store(o, (u32x4*)(WT + (size_t)(drow0 + n) * ldt + k0 + 8 * c));
    }
    LDS_WAIT(); asm volatile("" ::: "memory");
}
__device__ __forceinline__ void conv_wdown(const Args& a, const Ctx& c) {
    LAS float* scr = (LAS float*)(c.lds + c.wave * 8704);
    bf16* wd = (bf16*)(a.ws + WS_WD);
    int first, step, cnt;
    if (c.nwg == 256) {
        if (c.wg < 128) { first = c.gw; step = 1024; cnt = 2; }
        else if (c.wg < 160) { first = 2048 + (c.gw - 1024); step = 256; cnt = 3; }
        else if (c.wg < 192) { first = 2816 + (c.gw - 1280); step = 256; cnt = 5; }
        else { first = 4096 + (c.gw - 1536); step = 512; cnt = 8; }
    }
    else { first = c.gw; step = c.ngw; cnt = (DEPTH * NE * 256 - c.gw + c.ngw - 1) / c.ngw; }
    for (int i = 0; i < cnt; ++i) {
        const int it = first + i * step;
        const int le = it >> 8, q = it & 255, kb = q / 32, nb = q % 32;
        tr_item(a.in[I_WD] + (size_t)le * 512 * 1024, 1024, kb * 64, nb * 32, wd + (size_t)le * 1024 * 512, 512, nb * 32, nullptr, 1.0f, scr, c.lane);
    }
}
__device__ __forceinline__ void conv_panel_item(const float* W, int ldw, int n0, bf16* WT, int drow0, float nscale, const float* sh, float* out, int ob, LAS unsigned char* lds, int wave, int lane, int tid, bool nts) {
    LAS float* scr = (LAS float*)(lds + wave * 12800); LAS float* shl = (LAS float*)(lds + wave * 12800 + 8704);
    LAS float* red = (LAS float*)(lds + 8 * 12800);
    const int kbase = wave * 128;
#pragma unroll
    for (int i = 0; i < 16; ++i) { const int id = lane + 64 * i, b = id >> 7, kk = id & 127; shl[id] = sh[b * 6144 + kbase + kk]; }
    const int n = lane & 31, bh = lane >> 5;
    float acc[4] = {0.f, 0.f, 0.f, 0.f};
#pragma unroll 1
    for (int tI = 0; tI < 2; ++tI) {
        const int k0 = kbase + 64 * tI;
        {
            f32x4 v[8];
#pragma unroll
            for (int j = 0; j < 8; ++j) v[j] = __builtin_nontemporal_load((const f32x4*)&W[(size_t)(k0 + 8 * j + (lane >> 3)) * ldw + n0 + (lane & 7) * 4]);
#pragma unroll
            for (int j = 0; j < 8; ++j) { LAS float* d = scr + (8 * j + (lane >> 3)) * 33 + (lane & 7) * 4; d[0] = v[j][0] * nscale; d[1] = v[j][1] * nscale; d[2] = v[j][2] * nscale; d[3] = v[j][3] * nscale; }
        }
        LDS_WAIT(); asm volatile("" ::: "memory");
        const int cc = lane & 7;
#pragma unroll
        for (int j = 0; j < 4; ++j) {
            const int nn = (lane >> 3) + 8 * j; const LAS float* s = scr + (8 * cc) * 33 + nn;
            u32x4 o; o.x = pk2(s[0 * 33], s[1 * 33]); o.y = pk2(s[2 * 33], s[3 * 33]); o.z = pk2(s[4 * 33], s[5 * 33]); o.w = pk2(s[6 * 33], s[7 * 33]);
            if (nts) __builtin_nontemporal_store(o, (u32x4*)(WT + (size_t)(drow0 + nn) * 1024 + k0 + 8 * cc)); else *(u32x4*)(WT + (size_t)(drow0 + nn) * 1024 + k0 + 8 * cc) = o;
        }
#pragma unroll 4
        for (int k4 = 0; k4 < 64; k4 += 4) {
            const float v0 = scr[(k4 + 0) * 33 + n], v1 = scr[(k4 + 1) * 33 + n], v2 = scr[(k4 + 2) * 33 + n], v3 = scr[(k4 + 3) * 33 + n];
#pragma unroll
            for (int i = 0; i < 4; ++i) { const f32x4 s4 = *(const LAS f32x4*)(shl + (4 * bh + i) * 128 + 64 * tI + k4); acc[i] += (s4.x * v0 + s4.y * v1) + (s4.z * v2 + s4.w * v3); }
        }
        LDS_WAIT(); asm volatile("" ::: "memory");
    }
#pragma unroll
    for (int i = 0; i < 4; ++i) red[(wave * 8 + 4 * bh + i) * 32 + n] = acc[i];
    __syncthreads();
    if (tid < 256) { const int b = tid >> 5, nn = tid & 31; float s = 0.f;
#pragma unroll
        for (int w = 0; w < 8; ++w) s += red[(w * 8 + b) * 32 + nn];
        out[(size_t)b * ob + nn] = s; }
    __syncthreads();
}
template <class SH>
__device__ __forceinline__ void bias_item(const float* Wc, int ldw, const SH* sh, int shs, float* out, int ob, float scale, const float* addv, LAS float* red, int tid) {
    const int c4 = tid & 15, kc = tid >> 4;
    f32x4 acc[8];
#pragma unroll
    for (int b = 0; b < 8; ++b) acc[b] = (f32x4){0.f, 0.f, 0.f, 0.f};
#pragma unroll 1
    for (int k0 = kc * 32; k0 < kc * 32 + 32; k0 += 16) {
        f32x4 w[16];
#pragma unroll
        for (int u = 0; u < 16; ++u) w[u] = __builtin_nontemporal_load((const f32x4*)&Wc[(size_t)(k0 + u) * ldw + c4 * 4]);
#pragma unroll
        for (int u = 0; u < 16; ++u)
#pragma unroll
            for (int b = 0; b < 8; ++b) acc[b] = acc[b] + w[u] * (float)sh[b * shs + k0 + u];
    }
#pragma unroll
    for (int b = 0; b < 8; ++b) *(LAS f32x4*)(red + (kc * 8 + b) * 64 + c4 * 4) = acc[b];
    __syncthreads();
    {
        const int b = tid >> 6, nn = tid & 63; float s = 0.f;
#pragma unroll
        for (int k2 = 0; k2 < 32; ++k2) s += red[(k2 * 8 + b) * 64 + nn];
        __hip_atomic_store(out + (size_t)b * ob + nn, s * scale + (addv ? addv[nn] : 0.f), __ATOMIC_RELAXED, __HIP_MEMORY_SCOPE_AGENT);
    }
    __syncthreads();
}
__device__ __forceinline__ void phase_p0a(const Args& a, const Ctx& c) {
    float* modv = (float*)(a.ws + WS_SMALL + SO_MODV);
    if (c.wg < 192) {
        LAS float* cact = (LAS float*)(c.lds + 65536);
        for (int i = c.tid; i < 8 * 1024; i += NTHREADS) cact[i] = silu_f(a.in[I_C][i]);
        __syncthreads();
        const int l = c.wg / 96, j0 = (c.wg % 96) * 64;
        bias_item(a.in[I_MODW] + (size_t)l * 1024 * 6144 + j0, 6144, cact, 1024, modv + (size_t)l * 8 * 6144 + j0, 6144, 1.0f, a.in[I_MODB] + l * 6144 + j0, (LAS float*)c.lds, c.tid);
        asm volatile("s_waitcnt vmcnt(0)" ::: "memory");
        __syncthreads();
        if (c.tid == 0) __hip_atomic_fetch_add((unsigned*)(a.ws + WS_CTL) + CW_MOD, 1u, __ATOMIC_RELAXED, __HIP_MEMORY_SCOPE_AGENT);
    }
    {
        float* extg = (float*)(a.ws + WS_SMALL + SO_EXTG); const float* relb = a.in[I_RELB];
        for (int i = c.gtid; i < 8 * 768; i += c.ngt) { const int h = i / 768, x = i % 768, cfg = x >> 8, rel = 159 - (x & 255);
            extg[i] = (rel >= 0 && rel <= 128) ? relb[(int)T5B[cfg][rel] * 8 + h] * LOG2E : -1e30f; }
    }
    {
        bf16* rwt = (bf16*)(a.ws + WS_SMALL + SO_RWT);
        for (int i = c.gtid; i < 16 * 1024; i += c.ngt) { const int e = i >> 10, kk = i & 1023; rwt[i] = (bf16)f2bf(a.in[I_RW][kk * 16 + e]); }
    }
    LAS float* scr = (LAS float*)(c.lds + c.wave * 8704);
    {
        bf16* wtout = (bf16*)(a.ws + WS_WOUT);
        for (int it = c.gw; it < DEPTH * 512; it += c.ngw) {
            const int l = it >> 9, q = it & 511, kb = q / 32, nb = q % 32, k0 = kb * 64;
            const float* ks = (k0 < 512) ? (a.in[I_ONA] + l * 512) : (a.in[I_ONB] + l * 512 - 512);
            tr_item(a.in[I_WOUT] + (size_t)l * 1024 * 1024, 1024, k0, nb * 32, wtout + (size_t)l * 1024 * 1024, 1024, nb * 32, ks, 1.0f, scr, c.lane);
        }
    }
    {
        bf16* ws = (bf16*)(a.ws + WS_WS); const float* g = a.in[I_GWS];
        for (int i = c.gtid; i < DEPTH * 8 * 128 * 128; i += c.ngt) {
            const int col = i & 127, t = (i >> 7) & 127, ks = col >> 4, hh = (col >> 3) & 1, jj = col & 7, s = 16 * ks + 8 * (jj >> 2) + 4 * hh + (jj & 3);
            ws[i] = (bf16)f2bf(s <= t ? g[(i & ~127) + s] : 0.f);
        }
    }
    conv_wdown(a, c);
}

__device__ __forceinline__ void phase_p0b(const Args& a, const Ctx& c) {
    {
        unsigned* w = (unsigned*)(a.ws + WS_CTL) + CW_MOD; unsigned* tmo = (unsigned*)(a.ws + WS_CTL) + CW_TMO;
        if (c.tid < 64) {
            unsigned sp = 0;
            while ((unsigned)__builtin_amdgcn_readfirstlane(__hip_atomic_load(w, __ATOMIC_RELAXED, __HIP_MEMORY_SCOPE_AGENT)) < 192u) {
                __builtin_amdgcn_s_sleep(2);
                if ((++sp & 255u) == 0u) { if (__builtin_amdgcn_readfirstlane(__hip_atomic_load(tmo, __ATOMIC_RELAXED, __HIP_MEMORY_SCOPE_AGENT)) != 0u) break;
                    if (sp > (1u << 20)) { if (c.lane == 0) __hip_atomic_store(tmo, 0x11u, __ATOMIC_RELAXED, __HIP_MEMORY_SCOPE_AGENT); break; } }
            }
            __builtin_amdgcn_fence(__ATOMIC_ACQUIRE, "agent");
            asm volatile("s_waitcnt vmcnt(0)" ::: "memory");
        }
        __syncthreads();
    }
    const float* modv = (const float*)(a.ws + WS_SMALL + SO_MODV);
    float* G1 = (float*)(a.ws + WS_SMALL + SO_G1); float* G2 = (float*)(a.ws + WS_SMALL + SO_G2);
    for (int i = c.gtid; i < DEPTH * BATCH * 1024; i += c.ngt) {
        const int k = i & 1023, lb = i >> 10, l = lb / BATCH;
        G1[i] = a.in[I_N1G][l * 1024 + k] * (1.0f + modv[(size_t)lb * 6144 + 1024 + k]);
        G2[i] = a.in[I_N2G][l * 1024 + k] * (1.0f + modv[(size_t)lb * 6144 + 4096 + k]);
    }
    {
        float* rb = (float*)(a.ws + WS_SMALL + SO_RBIAS);
        for (int i = c.gw; i < DEPTH * BATCH * 16; i += c.ngw) {
            const int e = i & 15, lb = i >> 4; const float* sh = modv + (size_t)lb * 6144 + 3072; float acc = 0.f;
#pragma unroll
            for (int j = 0; j < 16; ++j) { const int kk = c.lane + 64 * j; acc += sh[kk] * a.in[I_RW][kk * 16 + e]; }
            acc = wave_sum(acc);
            if (c.lane == 0) rb[i] = acc;
        }
    }
    {
        float* bias1 = (float*)(a.ws + WS_SMALL + SO_BIAS1); float* biasgu = (float*)(a.ws + WS_SMALL + SO_BIASGU);
        bf16* wtin = (bf16*)(a.ws + WS_WIN); bf16* wgu = (bf16*)(a.ws + WS_WGU);
        for (int it = c.wg; it < 160 + 1024; it += c.nwg) {
            if (it < 160) {
                const int l = it / 80, n0 = (it % 80) * 32; const float sc = (n0 >= 1024 && n0 < 1536) ? C2 : 1.0f;
                conv_panel_item(a.in[I_WIN] + (size_t)l * 1024 * INC, INC, n0, wtin + (size_t)l * INC * 1024, n0, sc, modv + (size_t)l * 8 * 6144, bias1 + (size_t)l * 8 * INC + n0, INC, c.lds, c.wave, c.lane, c.tid, l != 0);
            } else {
                const int r = it - 160, le = r >> 5, q = r & 31, half = q >> 4, nb = q & 15, n0 = nb * 32, l = le >> 4, e = le & 15;
                const float* W = (half ? a.in[I_WU] : a.in[I_WG]) + (size_t)le * 1024 * 512;
                const int drow0 = (n0 / 128) * 256 + (n0 % 128) + half * 128;
                conv_panel_item(W, 512, n0, wgu + (size_t)le * 1024 * 1024, drow0, 1.0f, modv + (size_t)l * 8 * 6144 + 3072, biasgu + ((size_t)l * 8 * 16 + e) * 1024 + drow0, 16 * 1024, c.lds, c.wave, c.lane, c.tid, true);
            }
        }
    }
    {
        bf16* A1 = (bf16*)(a.ws + WS_ACTX); float* ssq = (float*)(a.ws + WS_SMALL + SO_SSQA);
        const float* x = a.in[I_X];
        f32x4 ng[4];
#pragma unroll
        for (int j = 0; j < 4; ++j) ng[j] = *(const f32x4*)(a.in[I_N1G] + (c.lane + 64 * j) * 4);
        for (int t0 = c.gw; t0 < T; t0 += 4 * c.ngw) {
            f32x4 xv[4][4], sv[4][4];
#pragma unroll
            for (int i = 0; i < 4; ++i) { const int t = min(t0 + i * c.ngw, T - 1), b = t / SEQ; const f32x4* xr = (const f32x4*)(x + (size_t)t * 1024);
#pragma unroll
                for (int j = 0; j < 4; ++j) { xv[i][j] = __builtin_nontemporal_load(&xr[c.lane + 64 * j]); sv[i][j] = *(const f32x4*)(modv + (size_t)b * 6144 + 1024 + (c.lane + 64 * j) * 4); } }
#pragma unroll
            for (int i = 0; i < 4; ++i) {
                const int t = t0 + i * c.ngw; float s = 0.f;
                if (t < T) {
#pragma unroll
                    for (int j = 0; j < 4; ++j) {
                        const int kk = (c.lane + 64 * j) * 4; const f32x4 v = xv[i][j], sc = sv[i][j];
                        s += (v.x * v.x + v.y * v.y) + (v.z * v.z + v.w * v.w);
                        uint2 o; o.x = pk2(v.x * ng[j].x * (1.0f + sc.x), v.y * ng[j].y * (1.0f + sc.y)); o.y = pk2(v.z * ng[j].z * (1.0f + sc.z), v.w * ng[j].w * (1.0f + sc.w));
                        *(uint2*)(A1 + (size_t)t * 1024 + kk) = o;
                    }
                }
                s = wave_sum(s);
                if (t < T) {
                    if (c.lane < 16) ssq[(size_t)t * 16 + c.lane] = (c.lane == 0) ? s : 0.f;
                    if (c.lane == 0) ((int*)(a.ws + WS_SMALL + SO_ROWX))[t] = t;
                }
            }
        }
    }
}

typedef short rt_bf16x8 __attribute__((ext_vector_type(8)));
__device__ __forceinline__ void route_tokens(const Args& a, const Ctx& c, int l, int cslot, int tbase, int nw, const rt_bf16x8 (&wpre)[32]) {
    const bf16* A2 = (const bf16*)(a.ws + WS_ACTX); const bf16* rwt = (const bf16*)(a.ws + WS_SMALL + SO_RWT);
    const float* ssq = (const float*)(a.ws + WS_SMALL + SO_SSQB); const float* rbias = (const float*)(a.ws + WS_SMALL + SO_RBIAS) + l * 8 * 16;
    float* gates = (float*)(a.ws + WS_SMALL + SO_GATES); int* tokl = (int*)(a.ws + WS_SMALL + SO_TOKL);
    unsigned* cnt = (unsigned*)(a.ws + WS_CTL) + CW_CNT + cslot * 32; const float* rb = a.in[I_RB];
    const int fr = c.lane & 15, fq = c.lane >> 4;
    LAS unsigned* hist = (LAS unsigned*)(c.lds + 131072 + 1024); LAS unsigned* base = (LAS unsigned*)(c.lds + 131072 + 1024 + 128);
    {
        if (c.tid < 32) hist[c.tid] = 0u;
        for (int i0 = c.tid; i0 < nw * 16 * 128; i0 += 8 * NTHREADS) {
            u32x4 rr[8];
#pragma unroll
            for (int j = 0; j < 8; ++j) { const int i = i0 + j * NTHREADS, row = i >> 7, ch = i & 127; rr[j] = *(const u32x4*)(A2 + (size_t)(tbase + row) * 1024 + ch * 8); }
#pragma unroll
            for (int j = 0; j < 8; ++j) { const int i = i0 + j * NTHREADS, row = i >> 7, ch = i & 127; *(LAS u32x4*)(c.lds + row * 2048 + ((ch ^ (row & 15)) << 4)) = rr[j]; }
        }
        __syncthreads();
        const bool act = c.wave < nw;
        const int rloc = (act ? c.wave : 0) * 16 + fr, t = tbase + rloc, b = t >> 11;
        const LAS unsigned char* arow = c.lds + rloc * 2048; const bf16* wrow = rwt + fr * 1024 + 8 * fq;
        f32x4 acc = {0.f, 0.f, 0.f, 0.f};
        {
            bf16x8 aq[2][8];
#define RT_LD(buf, bt_) do { _Pragma("unroll") for (int i = 0; i < 8; ++i) { const int k0_ = ((bt_) * 8 + i) * 32; \
                aq[buf][i] = *(const LAS bf16x8*)(arow + ((((k0_ >> 3) + fq) ^ (rloc & 15)) << 4)); } } while (0)
            RT_LD(0, 0);
#pragma unroll
            for (int bt = 0; bt < 4; ++bt) {
                if (bt < 3) RT_LD((bt + 1) & 1, bt + 1);
#pragma unroll
                for (int i = 0; i < 8; ++i) acc = __builtin_amdgcn_mfma_f32_16x16x32_bf16(wpre[bt * 8 + i], aq[bt & 1][i], acc, 0, 0, 0);
            }
#undef RT_LD
        }
        const float rs = rstd_from16(ssq, t);
        float lg[4], p[4], sel[4];
#pragma unroll
        for (int j = 0; j < 4; ++j) lg[j] = rs * acc[j] + rbias[b * 16 + 4 * fq + j];
        float mx = fmaxf(fmaxf(lg[0], lg[1]), fmaxf(lg[2], lg[3]));
        mx = rows_max(mx);
        float ps = 0.f;
#pragma unroll
        for (int j = 0; j < 4; ++j) { p[j] = __expf(lg[j] - mx); ps += p[j]; }
        ps = rows_sum(ps);
        const float inv = 1.0f / ps;
#pragma unroll
        for (int j = 0; j < 4; ++j) { p[j] *= inv; sel[j] = p[j] + rb[4 * fq + j]; }
        float m1 = -INFINITY, m2 = -INFINITY;
#pragma unroll
        for (int j = 0; j < 4; ++j) { const float v = sel[j]; if (v > m1) { m2 = m1; m1 = v; } else if (v > m2) { m2 = v; } }
        const float gs = m1 + m2;
        int best = 0; float bests = __uint_as_float((unsigned)__builtin_amdgcn_ds_bpermute(fr << 2, (int)__float_as_uint(gs)));
#pragma unroll
        for (int gg = 1; gg < 4; ++gg) { const float o = __uint_as_float((unsigned)__builtin_amdgcn_ds_bpermute((fr + 16 * gg) << 2, (int)__float_as_uint(gs))); if (o > bests) { bests = o; best = gg; } }
        int bkt = 0; unsigned rank = 0u; float ga = 0.f, gb = 0.f;
        const bool win = act && (fq == best);
        if (win) {
            int i1 = 0; float v1 = sel[0];
            if (sel[1] > v1) { v1 = sel[1]; i1 = 1; } if (sel[2] > v1) { v1 = sel[2]; i1 = 2; } if (sel[3] > v1) { v1 = sel[3]; i1 = 3; }
            int i2 = -1; float v2 = -INFINITY;
            if (i1 != 0 && sel[0] > v2) { v2 = sel[0]; i2 = 0; } if (i1 != 1 && sel[1] > v2) { v2 = sel[1]; i2 = 1; } if (i1 != 2 && sel[2] > v2) { v2 = sel[2]; i2 = 2; } if (i1 != 3 && sel[3] > v2) { v2 = sel[3]; i2 = 3; }
            const int ea = min(i1, i2), eb = max(i1, i2);
            const float pa = (ea == 0) ? p[0] : (ea == 1) ? p[1] : (ea == 2) ? p[2] : p[3];
            const float pb = (eb == 0) ? p[0] : (eb == 1) ? p[1] : (eb == 2) ? p[2] : p[3];
            const int pi = (ea == 0) ? (eb - 1) : (ea == 1) ? (eb + 1) : 5;
            bkt = best * 6 + pi; ga = pa / (pa + pb); gb = pb / (pa + pb);
            rank = atomicAdd((unsigned*)(hist + bkt), 1u);
        }
        __syncthreads();
        if (c.tid < NBKT) { const unsigned n = hist[c.tid]; base[c.tid] = n ? atomicAdd(&cnt[c.tid], n) : 0u; }
        __syncthreads();
        if (win) {
            const unsigned pos = base[bkt] + rank;
            tokl[bkt * TOKCAP + (int)pos] = t;
            gates[(size_t)t * 2] = ga; gates[(size_t)t * 2 + 1] = gb;
        }
        __syncthreads();
    }
}

__device__ __forceinline__ void phase_p6(const Args& a, const Ctx& c) {
    const float* ssq = (const float*)(a.ws + WS_SMALL + SO_SSQA); const float* fg = a.in[I_FING];
    const int* rowx = (const int*)(a.ws + WS_SMALL + SO_ROWX); const bf16* x2b = (const bf16*)(a.ws + WS_X2B);
    typedef unsigned u32x2 __attribute__((ext_vector_type(2)));
    f32x4 g[4];
#pragma unroll
    for (int j = 0; j < 4; ++j) g[j] = ((const f32x4*)fg)[c.lane + 64 * j];
    for (int t0 = c.gw; t0 < T; t0 += 8 * c.ngw) {
        int rr[8]; float sp[8]; u32x2 xr[8][4];
#pragma unroll
        for (int i = 0; i < 8; ++i) { const int t = min(t0 + i * c.ngw, T - 1); rr[i] = rowx[t]; sp[i] = ssq[(size_t)t * 16 + (c.lane & 15)]; }
#pragma unroll
        for (int i = 0; i < 8; ++i) { const u32x2* p = (const u32x2*)(x2b + (size_t)rr[i] * 1024);
#pragma unroll
            for (int j = 0; j < 4; ++j) xr[i][j] = __builtin_nontemporal_load(&p[c.lane + 64 * j]); }
#pragma unroll
        for (int i = 0; i < 8; ++i) {
            const int t = t0 + i * c.ngw;
            const float s = wave_sum(sp[i]) * 0.25f;
            const float rs = rsqrtf(s * (1.0f / 1024.0f) + EPS);
            if (t < T) {
                f32x4* orow = (f32x4*)(a.out + (size_t)t * 1024);
#pragma unroll
                for (int j = 0; j < 4; ++j) { const u32x2 rw = xr[i][j];
                    f32x4 v; v.x = __uint_as_float(rw.x << 16) * rs * g[j].x; v.y = __uint_as_float(rw.x & 0xffff0000u) * rs * g[j].y; v.z = __uint_as_float(rw.y << 16) * rs * g[j].z; v.w = __uint_as_float(rw.y & 0xffff0000u) * rs * g[j].w;
                    __builtin_nontemporal_store(v, &orow[c.lane + 64 * j]); }
            }
        }
    }
}

namespace mm {
constexpr int BM = 256, BK = 64, HALF = 128, HTB = HALF * BK * 2, STAGE_BYTES = 8 * HTB;
__device__ __forceinline__ int lds_byte(int r, int c) { const int st = (r >> 4) * 2 + (c >> 5), rr = r & 15, cc = c & 31, ob = rr * 64 + cc * 2; return st * 1024 + (ob ^ (((ob >> 9) & 1) << 5)); }
__device__ __forceinline__ void stage_rc(int b, int& R, int& C) { const int st = b / 1024, sb = b % 1024, swz = sb ^ (((sb >> 9) & 1) << 5); R = (st >> 1) * 16 + swz / 64; C = (st & 1) * 32 + (swz % 64) / 2; }
__device__ __forceinline__ int perm32(int rho) { const int n = rho >> 4, i = rho & 15; return 8 * (i >> 2) + 4 * n + (i & 3); }
__device__ __forceinline__ int xcd_remap(int L, int nU) { const int q = nU / 8, r = nU % 8, xcd = L % 8, off = L / 8; return (xcd < r ? xcd * (q + 1) : r * (q + 1) + (xcd - r) * q) + off; }

constexpr int SIDE_OFF = 146432;
constexpr int TAB_OFF = 131072;
struct MUnit { const char* A; const char* B; int first, last; int i0, i1, i2, i3, i4, i5; };

__device__ __forceinline__ unsigned cvt_pk_bf16(float lo, float hi) { unsigned r; asm volatile("v_cvt_pk_bf16_f32 %0, %1, %2" : "=v"(r) : "v"(lo), "v"(hi)); return r; }
typedef float f32x2 __attribute__((ext_vector_type(2)));
__device__ __forceinline__ f32x2 gelu_pk(f32x2 v) {
    f32x2 c; c.x = __builtin_amdgcn_fmed3f(v.x, -4.25f, 4.25f); c.y = __builtin_amdgcn_fmed3f(v.y, -4.25f, 4.25f);
    const f32x2 u = c * c;
    f32x2 q = u * (-8.460361597e-10f) + 7.570799355e-08f;
    q = q * u + (-2.938792968e-06f); q = q * u + 6.552695497e-05f; q = q * u + (-9.404465092e-04f); q = q * u + 9.257818770e-03f; q = q * u + (-6.545349156e-02f); q = q * u + 3.984200383e-01f;
    const f32x2 ph = c * q + 0.5f;
    return v * ph;
}
__device__ __forceinline__ void gelu_pk4(f32x2 (&v)[4]) {
    f32x2 c[4], u[4], q[4];
#pragma unroll
    for (int i = 0; i < 4; ++i) { c[i].x = __builtin_amdgcn_fmed3f(v[i].x, -4.25f, 4.25f); c[i].y = __builtin_amdgcn_fmed3f(v[i].y, -4.25f, 4.25f); }
#pragma unroll
    for (int i = 0; i < 4; ++i) u[i] = c[i] * c[i];
#pragma unroll
    for (int i = 0; i < 4; ++i) q[i] = u[i] * (-8.460361597e-10f) + 7.570799355e-08f;
#pragma unroll
    for (int i = 0; i < 4; ++i) q[i] = q[i] * u[i] + (-2.938792968e-06f);
#pragma unroll
    for (int i = 0; i < 4; ++i) q[i] = q[i] * u[i] + 6.552695497e-05f;
#pragma unroll
    for (int i = 0; i < 4; ++i) q[i] = q[i] * u[i] + (-9.404465092e-04f);
#pragma unroll
    for (int i = 0; i < 4; ++i) q[i] = q[i] * u[i] + 9.257818770e-03f;
#pragma unroll
    for (int i = 0; i < 4; ++i) q[i] = q[i] * u[i] + (-6.545349156e-02f);
#pragma unroll
    for (int i = 0; i < 4; ++i) q[i] = q[i] * u[i] + 3.984200383e-01f;
#pragma unroll
    for (int i = 0; i < 4; ++i) v[i] = v[i] * (c[i] * q[i] + 0.5f);
}

struct SchedP1;
template <class S> struct sched_halfm { static constexpr bool v = false; };
template <> struct sched_halfm<SchedP1> { static constexpr bool v = true; };
template <class Epi, class Sched, bool GATHER>
__device__ __forceinline__ void mm_phase(LAS unsigned char* lds, const Sched& S, const Epi& E, const int tid) {
    const int wid = __builtin_amdgcn_readfirstlane(tid >> 6), lane = tid & 63, wr = wid >> 2, wc = wid & 3, fr = lane & 15, fq = lane >> 4;
    const int nt = S.nt; const unsigned lda = S.lda, ldb = S.ldb;
    int Rr[2], Cc;
    unsigned voffA[2], voffB[2];
#pragma unroll
    for (int i = 0; i < 2; ++i) { int R, C; stage_rc(tid * 16 + i * 8192, R, C); const int Rb = Epi::PERM ? ((R & ~31) + perm32(R & 31)) : R;
        Rr[i] = R; Cc = C; voffA[i] = (unsigned)R * lda + (unsigned)C * 2u; voffB[i] = (unsigned)Rb * ldb + (unsigned)C * 2u; }
    const size_t kstep = (size_t)(BK * 2);
    const size_t hstepA = (size_t)HALF * lda, hstepB = (size_t)HALF * ldb;
    const unsigned ldsw = (unsigned)wid * 1024u;
    const int aoff = lds_byte(wr * 64 + fr, fq * 8), boff = lds_byte(wc * 32 + fr, fq * 8);
#define MM_SA(b, h) (((b) * 2 + (h)) * HTB)
#define MM_SB(b, h) ((4 + (b) * 2 + (h)) * HTB)
#define MM_STAGE_B(bufoff, gbase) do { _Pragma("unroll") for (int _i = 0; _i < 2; ++_i) \
        __builtin_amdgcn_global_load_lds((const unsigned*)((const char*)(gbase) + voffB[_i]), (LAS unsigned*)(lds + (bufoff) + ldsw + _i * 8192), 16, 0, 0); } while (0)
#define MM_STAGE_A(bufoff, nx, h, koff) do { \
        const char* gb_ = GATHER ? (cA + (koff)) : (((nx) ? nA : cA) + (size_t)(h) * hstepA + (koff)); \
        _Pragma("unroll") for (int _i = 0; _i < 2; ++_i) { \
            unsigned vo_ = GATHER ? vAc[h][_i] : voffA[_i]; \
            if (GATHER) { if (nx) vo_ = S.gather1(nslot, (h) * 128 + Rr[_i], Cc, lds); } \
            __builtin_amdgcn_global_load_lds((const unsigned*)(gb_ + vo_), (LAS unsigned*)(lds + (bufoff) + ldsw + _i * 8192), 16, 0, 0); } } while (0)
#define MM_LDA(dst, b, h) do { _Pragma("unroll") for (int m = 0; m < 4; ++m) _Pragma("unroll") for (int k = 0; k < 2; ++k) dst[m][k] = *(const LAS bf16x8*)(lds + MM_SA(b, h) + aoff + m * 2048 + k * 1024); } while (0)
#define MM_LDB(dst, b, h) do { _Pragma("unroll") for (int n = 0; n < 2; ++n) _Pragma("unroll") for (int k = 0; k < 2; ++k) dst[n][k] = *(const LAS bf16x8*)(lds + MM_SB(b, h) + boff + n * 2048 + k * 1024); } while (0)
#define MM_MMA(ai, bj, At, Bt) do { __builtin_amdgcn_s_setprio(1); _Pragma("unroll") for (int m = 0; m < 4; ++m) _Pragma("unroll") for (int n = 0; n < 2; ++n) _Pragma("unroll") for (int k = 0; k < 2; ++k) \
        acc[ai][bj][m][n] = __builtin_amdgcn_mfma_f32_16x16x32_bf16(Bt[n][k], At[m][k], acc[ai][bj][m][n], 0, 0, 0); __builtin_amdgcn_s_setprio(0); } while (0)
#define MM_WAIT_V(n) asm volatile("s_waitcnt vmcnt(" #n ")" ::: "memory")
#define MM_WAIT_L(n) asm volatile("s_waitcnt lgkmcnt(" #n ")" ::: "memory")
#define MM_BAR __builtin_amdgcn_s_barrier()
#define MM_SCHED __builtin_amdgcn_sched_barrier(0)
#define MM_ZERO() do { _Pragma("unroll") for (int a_ = 0; a_ < 2; ++a_) _Pragma("unroll") for (int b_ = 0; b_ < 2; ++b_) _Pragma("unroll") for (int m_ = 0; m_ < 4; ++m_) _Pragma("unroll") for (int n_ = 0; n_ < 2; ++n_) \
        acc[a_][b_][m_][n_] = (f32x4){0.f, 0.f, 0.f, 0.f}; } while (0)
    MUnit cur, nxt; int ui = 0;
    if (!S.next(0, cur)) return;
    f32x4 acc[2][2][4][2];
    MM_ZERO();
    bf16x8 At[4][2], B0[2][2], B1[2][2];
    unsigned vAc[2][2]; int nslot = 0;
    if constexpr (GATHER) { S.gather(0, Rr, Cc, vAc, lds); }
    else {
#pragma unroll
        for (int h = 0; h < 2; ++h)
#pragma unroll
            for (int i = 0; i < 2; ++i) vAc[h][i] = 0u;
    }
    const char* cA = cur.A; const char* cB = cur.B;
    const char* nA = cA;
    MM_STAGE_B(MM_SB(0, 0), cB); MM_STAGE_B(MM_SB(0, 1), cB + hstepB); MM_STAGE_A(MM_SA(0, 0), false, 0, 0); MM_STAGE_A(MM_SA(0, 1), false, 1, 0);
    if (wr == 1) MM_BAR;
    MM_WAIT_V(2); MM_BAR;
    MM_STAGE_B(MM_SB(1, 0), cB + kstep); MM_STAGE_A(MM_SA(1, 0), false, 0, kstep); MM_STAGE_B(MM_SB(1, 1), cB + hstepB + kstep);
    MM_WAIT_V(6); MM_BAR;
    for (;;) {
        const bool has_next = S.next(ui + 1, nxt);
        nA = has_next ? nxt.A : cA; const char* nB = has_next ? nxt.B : cB;
        nslot = has_next ? ui + 1 : ui;
        const bool hm = sched_halfm<Sched>::v && cur.i2 != 0;
        for (int t = 0; t < nt; t += 2) {
            const bool last = (t == nt - 2);
            const size_t k1 = (size_t)(t + 1) * kstep;
            const size_t k2 = last ? 0 : (size_t)(t + 2) * kstep;
            const size_t k3 = k2 + kstep;
            const char* b2 = (last ? nB : cB) + k2; const char* b3 = b2 + kstep;
            MM_LDB(B0, 0, 0); MM_LDB(B1, 0, 1); MM_SCHED; MM_LDA(At, 0, 0); MM_STAGE_A(MM_SA(1, 1), false, 1, k1);
            MM_WAIT_V(8); MM_WAIT_L(0); MM_BAR; MM_MMA(0, 0, At, B0); MM_MMA(0, 1, At, B1); MM_BAR; MM_SCHED;
            MM_LDA(At, 0, 1); MM_STAGE_B(MM_SB(0, 0), b2); MM_STAGE_B(MM_SB(0, 1), b2 + hstepB); MM_STAGE_A(MM_SA(0, 0), last, 0, k2);
            MM_WAIT_V(8); MM_WAIT_L(0); MM_BAR; if (!hm) { MM_MMA(1, 0, At, B0); MM_MMA(1, 1, At, B1); } MM_BAR; MM_SCHED;
            MM_LDB(B0, 1, 0); MM_LDB(B1, 1, 1); MM_SCHED; MM_LDA(At, 1, 0); MM_STAGE_A(MM_SA(0, 1), last, 1, k2);
            MM_WAIT_V(8); MM_WAIT_L(0); MM_BAR; MM_MMA(0, 0, At, B0); MM_MMA(0, 1, At, B1); MM_BAR; MM_SCHED;
            MM_LDA(At, 1, 1); MM_STAGE_B(MM_SB(1, 0), b3); MM_STAGE_B(MM_SB(1, 1), b3 + hstepB); MM_STAGE_A(MM_SA(1, 0), last, 0, k3);
            MM_WAIT_V(8); MM_WAIT_L(0); MM_BAR; if (!hm) { MM_MMA(1, 0, At, B0); MM_MMA(1, 1, At, B1); } MM_BAR; MM_SCHED;
        }
        const bool epi = cur.last != 0;
        int fr_ = fr, fq_ = fq, wr_ = wr, wc_ = wc; asm volatile("" : "+v"(fr_), "+v"(fq_), "+s"(wr_), "+s"(wc_));
        if constexpr (Epi::HAS_MID) E.mid(acc, ui, epi, wr_, fr_, lds);
        if (epi) { if (wr == 0) MM_BAR; E(acc, cur, ui, wr_, wc_, fr_, fq_, lds);
#if EPI_TWICE
            E(acc, cur, ui, wr_, wc_, fr_, fq_, lds);
#endif
        }
        if (!has_next) break;
        if (nxt.first) MM_ZERO();
        cur = nxt; cA = nA; cB = nB; ++ui;
        if constexpr (GATHER) { S.gather(ui, Rr, Cc, vAc, lds); }
        if (epi) { if (wr == 1) MM_BAR; }
    }
    MM_WAIT_V(0);
    MM_BAR;
#undef MM_SA
#undef MM_SB
#undef MM_STAGE_A
#undef MM_STAGE_B
#undef MM_LDA
#undef MM_LDB
#undef MM_MMA
#undef MM_WAIT_V
#undef MM_WAIT_L
#undef MM_BAR
#undef MM_SCHED
#undef MM_ZERO
}

struct SchedDense {
    const char* A; const char* B; int nM, nN, nU, G, c, nt; unsigned lda, ldb;
    __device__ __forceinline__ bool next(int i, MUnit& u) const {
        const int L = i * G + c; if (L >= nU) return false;
        const int wgid = xcd_remap(L, nU);
        const int nig = 8 * nN, gid = wgid / nig, fm = gid * 8, gsz = (nM - fm) < 8 ? (nM - fm) : 8;
        const int pm = fm + ((wgid % nig) % gsz), pn = (wgid % nig) / gsz;
        u.A = A + (size_t)pm * 256 * lda; u.B = B + (size_t)pn * 256 * ldb; u.first = 1; u.last = 1; u.i0 = pm; u.i1 = pn; u.i2 = 0; u.i3 = 0; u.i4 = 0; u.i5 = 0;
        return true;
    }
    __device__ __forceinline__ void gather(int, const int (&)[2], int, unsigned (&)[2][2], LAS unsigned char*) const {}
    __device__ __forceinline__ unsigned gather1(int, int, int, LAS unsigned char*) const { return 0u; }
};
struct SchedP1 {
    const char* A; const char* B; int nM, nN, nU, G, c, nt; unsigned lda, ldb;
    __device__ __forceinline__ bool next(int i, MUnit& u) const {
        int L = i * G + c, hm = 0;
        if (G == 256 && nU == 640 && i == 2) { hm = 1 + ((c >> 3) & 1); L = 512 + (c & 7) + 8 * (c >> 4); }
        if (L >= nU) return false;
        const int wgid = xcd_remap(L, nU);
        const int nig = 8 * nN, gid = wgid / nig, fm = gid * 8, gsz = (nM - fm) < 8 ? (nM - fm) : 8;
        const int pm = fm + ((wgid % nig) % gsz), pn = (wgid % nig) / gsz;
        u.A = A; u.B = B + (size_t)pn * 256 * ldb; u.first = 1; u.last = 1; u.i0 = pm; u.i1 = pn; u.i2 = hm; u.i3 = 0; u.i4 = 0; u.i5 = 0;
        return true;
    }
    __device__ __forceinline__ void gather(int slot, const int (&Rr)[2], int Cc, unsigned (&v)[2][2], LAS unsigned char* lds) const {
        const LAS int* tk = (const LAS int*)(lds + TAB_OFF + slot * 3072);
#pragma unroll
        for (int h = 0; h < 2; ++h)
#pragma unroll
            for (int i = 0; i < 2; ++i) v[h][i] = (unsigned)tk[h * 128 + Rr[i]] * 2048u + (unsigned)Cc * 2u;
    }
    __device__ __forceinline__ unsigned gather1(int slot, int row, int Cc, LAS unsigned char* lds) const {
        return (unsigned)((const LAS int*)(lds + TAB_OFF + slot * 3072))[row] * 2048u + (unsigned)Cc * 2u;
    }
};
struct SchedP3 {
    const char* A; const char* B; int nM, nN, nU, G, c, nt; unsigned lda, ldb;
    __device__ __forceinline__ bool next(int i, MUnit& u) const {
        const int L = (i >> 1) * G + c, sub = i & 1; if (L >= nU) return false;
        const int wgid = xcd_remap(L, nU);
        const int nig = 8 * nN, gid = wgid / nig, fm = gid * 8, gsz = (nM - fm) < 8 ? (nM - fm) : 8;
        const int pm = fm + ((wgid % nig) % gsz), pn = (wgid % nig) / gsz;
        u.A = A + (size_t)pm * 256 * lda + sub * 1024; u.B = B + (size_t)pn * 256 * ldb + sub * 1024; u.first = (sub == 0); u.last = (sub == 1); u.i0 = pm; u.i1 = pn; u.i2 = 0; u.i3 = 0; u.i4 = 0; u.i5 = 0;
        return true;
    }
    __device__ __forceinline__ void gather(int, const int (&)[2], int, unsigned (&)[2][2], LAS unsigned char*) const {}
    __device__ __forceinline__ unsigned gather1(int, int, int, LAS unsigned char*) const { return 0u; }
};
struct SchedP4 {
    const int* tokl; const unsigned* cnt; const char* A2; const char* Wgu; LAS const int* pre; int nU, G, c, nt; unsigned lda, ldb;
    __device__ __forceinline__ bool next(int i, MUnit& u) const {
        const int L = i * G + c; if (L >= nU) return false;
        const int id = xcd_remap(L, nU), tile_id = id >> 3, pn = id & 7;
        int bkt = 0;
        for (int b = 1; b < NBKT; ++b) if (pre[b] <= tile_id) bkt = b;
        const int rt = tile_id - pre[bkt]; int e0, e1; bucket_experts(bkt, e0, e1);
        const int slot = pn >> 2, tile = pn & 3, e = slot ? e1 : e0;
        u.A = A2; u.B = Wgu + ((size_t)e * 1024 + tile * 256) * 2048; u.first = 1; u.last = 1;
        u.i0 = bkt; u.i1 = rt; u.i2 = pn; u.i3 = pre[32 + bkt]; u.i4 = pre[bkt] * 256; u.i5 = e;
        return true;
    }
    __device__ __forceinline__ void gather(int slot, const int (&Rr)[2], int Cc, unsigned (&v)[2][2], LAS unsigned char* lds) const {
        const LAS int* tk = (const LAS int*)(lds + TAB_OFF + slot * 3072);
#pragma unroll
        for (int h = 0; h < 2; ++h)
#pragma unroll
            for (int i = 0; i < 2; ++i) v[h][i] = (unsigned)tk[h * 128 + Rr[i]] * 2048u + (unsigned)Cc * 2u;
    }
    __device__ __forceinline__ unsigned gather1(int slot, int row, int Cc, LAS unsigned char* lds) const {
        return (unsigned)((const LAS int*)(lds + TAB_OFF + slot * 3072))[row] * 2048u + (unsigned)Cc * 2u;
    }
};
struct SchedP5 {
    const unsigned* cnt; const char* act; const char* Wd; LAS const int* pre; int nU, G, c, nt; unsigned lda, ldb;
    __device__ __forceinline__ bool next(int i, MUnit& u) const {
        const int L = (i >> 1) * G + c, sub = i & 1; if (L >= nU) return false;
        const int id = xcd_remap(L, nU), tile_id = id >> 2, pn = id & 3;
        int bkt = 0;
        for (int b = 1; b < NBKT; ++b) if (pre[b] <= tile_id) bkt = b;
        const int rt = tile_id - pre[bkt]; int e0, e1; bucket_experts(bkt, e0, e1);
        const int e = sub ? e1 : e0, off = pre[bkt] * 256;
        u.A = act + (size_t)(off + rt * 256) * 2048 + sub * 1024; u.B = Wd + ((size_t)e * 1024 + pn * 256) * 1024; u.first = (sub == 0); u.last = (sub == 1);
        u.i0 = bkt; u.i1 = rt; u.i2 = pn; u.i3 = pre[32 + bkt]; u.i4 = pre[64 + bkt]; u.i5 = (i >> 1) * 3072;
        return true;
    }
    __device__ __forceinline__ void gather(int, const int (&)[2], int, unsigned (&)[2][2], LAS unsigned char*) const {}
    __device__ __forceinline__ unsigned gather1(int, int, int, LAS unsigned char*) const { return 0u; }
};

struct EpiP1 {
    static constexpr bool PERM = true, HAS_MID = false;
    bf16* proj; const float* ssq; const float* bias1;
    __device__ __forceinline__ void operator()(const f32x4 (&acc)[2][2][4][2], const MUnit& u, int slot, int wr, int wc, int fr, int fq, LAS unsigned char* lds) const {
        const int pm = u.i0, pn = u.i1, b = pm >> 3;
        const int hm = u.i2;
        const int row0 = pm * 256 + wr * 64 + fr + (hm == 2 ? 128 : 0), col0 = pn * 256 + wc * 32 + 8 * fq;
        const LAS float* rtab = (const LAS float*)(lds + TAB_OFF + slot * 3072 + 1024);
        f32x4 bv[2][2];
#pragma unroll
        for (int bj = 0; bj < 2; ++bj)
#pragma unroll
            for (int n = 0; n < 2; ++n) bv[bj][n] = *(const f32x4*)(bias1 + b * INC + col0 + bj * 128 + 4 * n);
        const bool act = pn < 4;
#pragma unroll
        for (int ai = 0; ai < 2; ++ai) if (ai == 0 || hm == 0)
#pragma unroll
            for (int m = 0; m < 4; ++m) {
                const int row = row0 + ai * 128 + m * 16; const float rs = rtab[wr * 64 + fr + ai * 128 + m * 16];
                const int tq = row & 2047;
#pragma unroll
                for (int bj = 0; bj < 2; ++bj) {
                    f32x4 v0 = acc[ai][bj][m][0] * rs + bv[bj][0], v1 = acc[ai][bj][m][1] * rs + bv[bj][1];
                    if (act) { f32x2 gq[4] = {(f32x2){v0[0], v0[1]}, (f32x2){v0[2], v0[3]}, (f32x2){v1[0], v1[1]}, (f32x2){v1[2], v1[3]}}; gelu_pk4(gq);
                        v0 = (f32x4){gq[0].x, gq[0].y, gq[1].x, gq[1].y}; v1 = (f32x4){gq[2].x, gq[2].y, gq[3].x, gq[3].y}; }
                    u32x4 w; w.x = cvt_pk_bf16(v0[0], v0[1]); w.y = cvt_pk_bf16(v0[2], v0[3]); w.z = cvt_pk_bf16(v1[0], v1[1]); w.w = cvt_pk_bf16(v1[2], v1[3]);
                    if (act) *(u32x4*)(proj + (size_t)row * 1024 + col0 + bj * 128) = w;
                    else { const int c512 = ((pn - 4) & 1) * 256 + bj * 128 + wc * 32 + 8 * fq, which = (pn - 4) >> 1;
                        *(u32x4*)(proj + (size_t)(32 + 16 * which) * (MiB / 2) + ((size_t)((b * 8 + (c512 >> 6)) * 2048 + tq)) * 64 + (c512 & 63)) = w; }
                }
            }
    }
};
template <bool L0, bool WT>
struct EpiP3 {
    static constexpr bool PERM = true, HAS_MID = true;
    const float* xin;        const bf16* x2b;
    bf16* x1; bf16* A2; float* ssq; const float* g1;     const float* G2;
    __device__ __forceinline__ void mid(f32x4 (&acc)[2][2][4][2], int ui, bool epi, int wr, int fr, LAS unsigned char* lds) const {
        const LAS float* rho = (const LAS float*)(lds + TAB_OFF + (ui >> 1) * 3072 + 1024);
#pragma unroll
        for (int ai = 0; ai < 2; ++ai)
#pragma unroll
            for (int m = 0; m < 4; ++m) { const float r0 = rho[ai * 128 + wr * 64 + m * 16 + fr]; const float r = epi ? 1.0f : r0;
#pragma unroll
                for (int bj = 0; bj < 2; ++bj)
#pragma unroll
                    for (int n = 0; n < 2; ++n) acc[ai][bj][m][n] = acc[ai][bj][m][n] * r; }
    }
    __device__ __forceinline__ void operator()(const f32x4 (&acc)[2][2][4][2], const MUnit& u, int ui, int wr, int wc, int fr, int fq, LAS unsigned char* lds) const {
        const int pm = u.i0, pn = u.i1, b = pm >> 3;
        const int row0 = pm * 256 + wr * 64 + fr, col0 = pn * 256 + wc * 32 + 8 * fq;
        const LAS float* rbt = (const LAS float*)(lds + TAB_OFF + (ui >> 1) * 3072 + 2048); const LAS int* rxt = (const LAS int*)(lds + TAB_OFF + (ui >> 1) * 3072);
        f32x4 gv[2][2], Gv[2][2];
#pragma unroll
        for (int bj = 0; bj < 2; ++bj)
#pragma unroll
            for (int n = 0; n < 2; ++n) { gv[bj][n] = *(const f32x4*)(g1 + b * 6144 + col0 + bj * 128 + 4 * n); Gv[bj][n] = *(const f32x4*)(G2 + b * 1024 + col0 + bj * 128 + 4 * n); }
        constexpr int AH = L0 ? 2 : 4;
        f32x4 PF[L0 ? AH : 1][2][2]; u32x4 RW[L0 ? 1 : AH][2];
#define P3_LOAD(ai_, m_) do { const int rl_ = (ai_) * 128 + wr * 64 + (m_) * 16 + fr; _Pragma("unroll") for (int bj = 0; bj < 2; ++bj) { \
            if (L0) { const float* xp = xin + (size_t)(pm * 256 + rl_) * 1024 + col0 + bj * 128; PF[L0 ? ((m_) % AH) : 0][bj][0] = __builtin_nontemporal_load((const f32x4*)xp); PF[L0 ? ((m_) % AH) : 0][bj][1] = __builtin_nontemporal_load((const f32x4*)(xp + 4)); } \
            else RW[L0 ? 0 : ((m_) % AH)][bj] = *(const u32x4*)(x2b + (size_t)rxt[rl_] * 1024 + col0 + bj * 128); } } while (0)
#pragma unroll
        for (int m = 0; m < AH; ++m) P3_LOAD(0, m);
#pragma unroll
        for (int ai = 0; ai < 2; ++ai)
#pragma unroll
            for (int m = 0; m < 4; ++m) {
                const int rl = ai * 128 + wr * 64 + m * 16 + fr, row = pm * 256 + rl; float ss = 0.f; const float rb = rbt[rl];
                f32x4 pp[2][2];
#pragma unroll
                for (int bj = 0; bj < 2; ++bj) {
                    if (L0) { pp[bj][0] = PF[L0 ? (m % AH) : 0][bj][0]; pp[bj][1] = PF[L0 ? (m % AH) : 0][bj][1]; }
                    else { const u32x4 raw = RW[L0 ? 0 : (m % AH)][bj];
                        pp[bj][0] = (f32x4){__uint_as_float(raw.x << 16), __uint_as_float(raw.x & 0xffff0000u), __uint_as_float(raw.y << 16), __uint_as_float(raw.y & 0xffff0000u)};
                        pp[bj][1] = (f32x4){__uint_as_float(raw.z << 16), __uint_as_float(raw.z & 0xffff0000u), __uint_as_float(raw.w << 16), __uint_as_float(raw.w & 0xffff0000u)}; }
                }
                { constexpr int dummy_ = 0; (void)dummy_; const int it_ = ai * 4 + m + AH; if (it_ < 8) P3_LOAD(it_ >> 2, it_ & 3); }
#pragma unroll
                for (int bj = 0; bj < 2; ++bj) {
                    const f32x4 p0 = pp[bj][0], p1 = pp[bj][1];
                    const f32x4 v0 = p0 + gv[bj][0] * (acc[ai][bj][m][0] * rb), v1 = p1 + gv[bj][1] * (acc[ai][bj][m][1] * rb);
                    ss += ((v0[0] * v0[0] + v0[1] * v0[1]) + (v0[2] * v0[2] + v0[3] * v0[3])) + ((v1[0] * v1[0] + v1[1] * v1[1]) + (v1[2] * v1[2] + v1[3] * v1[3]));
                    const size_t o = (size_t)row * 1024 + col0 + bj * 128;
                    u32x4 w; w.x = cvt_pk_bf16(v0[0], v0[1]); w.y = cvt_pk_bf16(v0[2], v0[3]); w.z = cvt_pk_bf16(v1[0], v1[1]); w.w = cvt_pk_bf16(v1[2], v1[3]);
                    *(u32x4*)(x1 + o) = w;
                    const f32x4 a0 = v0 * Gv[bj][0], a1 = v1 * Gv[bj][1];
                    u32x4 z; z.x = cvt_pk_bf16(a0[0], a0[1]); z.y = cvt_pk_bf16(a0[2], a0[3]); z.z = cvt_pk_bf16(a1[0], a1[1]); z.w = cvt_pk_bf16(a1[2], a1[3]);
                    if constexpr (WT) { const __amdgpu_buffer_rsrc_t rs2 = __builtin_amdgcn_make_buffer_rsrc((void*)A2, (short)0, 0x2000000, 0x00020000);
                      __builtin_amdgcn_raw_buffer_store_b128(z, rs2, (int)((unsigned)o * 2u), 0, 16); }
                    else *(u32x4*)(A2 + o) = z;
                }
                ss = rows_sum(ss);
                if (fq == 0) { if constexpr (WT) __hip_atomic_store(ssq + (size_t)row * 16 + pn * 4 + wc, ss, __ATOMIC_RELAXED, __HIP_MEMORY_SCOPE_AGENT); else ssq[(size_t)row * 16 + pn * 4 + wc] = ss; }
            }
#undef P3_LOAD
    }
};
struct EpiP4 {
    static constexpr bool PERM = true, HAS_MID = false;
    bf16* act; const int* tokl; const float* ssq; const float* biasgu;     const float* gates; int wt;
    __device__ __forceinline__ void side(const MUnit& u, int wid, int lane, LAS unsigned char* lds) const {
        const float* src = biasgu + ((size_t)wid * 16 + u.i5) * 1024 + (u.i2 & 3) * 256 + ((lane ^ wid) << 2);
        __builtin_amdgcn_global_load_lds((const unsigned*)src, (LAS unsigned*)(lds + SIDE_OFF + wid * 1024), 16, 0, 0);
    }
    __device__ __forceinline__ void operator()(const f32x4 (&acc)[2][2][4][2], const MUnit& u, int uslot, int wr, int wc, int fr, int fq, LAS unsigned char* lds) const {
        const int rt = u.i1, pn = u.i2, off = u.i4, e = u.i5, slot = pn >> 2, tile = pn & 3;
        const LAS int* ttab = (const LAS int*)(lds + TAB_OFF + uslot * 3072); const LAS float* rtab = (const LAS float*)(lds + TAB_OFF + uslot * 3072 + 1024); const LAS float* gtab = (const LAS float*)(lds + TAB_OFF + uslot * 3072 + 2048);
        const LAS unsigned char* sb = lds + SIDE_OFF; const int ch = wc * 8 + 2 * fq;
        int tq[8]; float rq[8], gq[8];
#pragma unroll
        for (int i = 0; i < 8; ++i) { const int rl = (i >> 2) * 128 + wr * 64 + (i & 3) * 16 + fr; tq[i] = ttab[rl]; rq[i] = rtab[rl]; gq[i] = gtab[rl]; }
        f32x4 bq[2][4];
#define E4_LDB(buf, i_) do { const int b_ = tq[i_] >> 11; _Pragma("unroll") for (int nn = 0; nn < 2; ++nn) { bq[buf][nn] = *(const LAS f32x4*)(sb + b_ * 1024 + (((ch + nn) ^ b_) << 4)); \
            bq[buf][2 + nn] = *(const LAS f32x4*)(sb + b_ * 1024 + (((32 + ch + nn) ^ b_) << 4)); } } while (0)
        E4_LDB(0, 0);
#pragma unroll
        for (int ai = 0; ai < 2; ++ai)
#pragma unroll
            for (int m = 0; m < 4; ++m) {
                const int it = ai * 4 + m;
                if (it < 7) E4_LDB((it + 1) & 1, it + 1);
                const int rl = ai * 128 + wr * 64 + m * 16 + fr, r = rt * 256 + rl;
                const float rs = rq[it]; const float g = gq[it];
                unsigned wv[4];
#pragma unroll
                for (int nn = 0; nn < 2; ++nn) {
                    const f32x4 bg = bq[it & 1][nn], bu = bq[it & 1][2 + nn];
                    const f32x4 hg = acc[ai][0][m][nn] * rs + bg, hu = acc[ai][1][m][nn] * rs + bu;
#pragma unroll
                    for (int hp = 0; hp < 2; ++hp) {
                        const f32x2 g2 = (f32x2){hg[2 * hp], hg[2 * hp + 1]}, u2 = (f32x2){hu[2 * hp], hu[2 * hp + 1]};
                        const f32x2 t2 = g2 * (-1.4426950408889634f);
                        f32x2 e2; e2.x = __builtin_amdgcn_exp2f(t2.x); e2.y = __builtin_amdgcn_exp2f(t2.y);
                        const f32x2 d2 = e2 + 1.0f;
                        f32x2 r2; r2.x = __builtin_amdgcn_rcpf(d2.x); r2.y = __builtin_amdgcn_rcpf(d2.y);
                        const f32x2 o2 = (g2 * u2) * (r2 * g);
                        wv[2 * nn + hp] = cvt_pk_bf16(o2.x, o2.y);
                    }
                }
                u32x4 w; w.x = wv[0]; w.y = wv[1]; w.z = wv[2]; w.w = wv[3];
                if (wt) { const __amdgpu_buffer_rsrc_t rs = __builtin_amdgcn_make_buffer_rsrc((void*)act, (short)0, 0x3000000, 0x00020000);
                    __builtin_amdgcn_raw_buffer_store_b128(w, rs, (int)(((unsigned)(off + r) * 1024u + (unsigned)(slot * 512 + tile * 128 + wc * 32 + 8 * fq)) * 2u), 0, 16); }
                else *(u32x4*)(act + (size_t)(off + r) * 1024 + slot * 512 + tile * 128 + wc * 32 + 8 * fq) = w;
                ;
            }
#undef E4_LDB
    }
};
struct EpiP5 {
    static constexpr bool PERM = true, HAS_MID = false;
    const bf16* x1; bf16* x2b; bf16* A1; float* ssq; const float* g2;     const float* G1n; int haveNext;
    __device__ __forceinline__ void side(const MUnit& u, int wid, int lane, LAS unsigned char* lds) const {
        const int co = u.i2 * 256 + ((lane ^ wid) << 2);
        __builtin_amdgcn_global_load_lds((const unsigned*)(g2 + wid * 6144 + co), (LAS unsigned*)(lds + SIDE_OFF + wid * 1024), 16, 0, 0);
        if (haveNext) __builtin_amdgcn_global_load_lds((const unsigned*)(G1n + wid * 1024 + co), (LAS unsigned*)(lds + SIDE_OFF + 8192 + wid * 1024), 16, 0, 0);
    }
    __device__ __forceinline__ void operator()(const f32x4 (&acc)[2][2][4][2], const MUnit& u, int ui, int wr, int wc, int fr, int fq, LAS unsigned char* lds) const {
        const int rt = u.i1, pn = u.i2, n = u.i3, xoff = u.i4;
        const int col0 = pn * 256 + wc * 32 + 8 * fq;
        const LAS int* ttab = (const LAS int*)(lds + TAB_OFF + u.i5);
        const LAS unsigned char* sb = lds + SIDE_OFF; const int ch = wc * 8 + 2 * fq;
        int tq[8];
#pragma unroll
        for (int i = 0; i < 8; ++i) tq[i] = ttab[(i >> 2) * 128 + wr * 64 + (i & 3) * 16 + fr];
        u32x4 raw[4][2];
#pragma unroll
        for (int m = 0; m < 4; ++m) {
#pragma unroll
            for (int bj = 0; bj < 2; ++bj) raw[m][bj] = *(const u32x4*)(x1 + (size_t)tq[m] * 1024 + col0 + bj * 128); }
#pragma unroll
        for (int ai = 0; ai < 2; ++ai)
#pragma unroll
            for (int m = 0; m < 4; ++m) {
                const int rl = ai * 128 + wr * 64 + m * 16 + fr, r = rt * 256 + rl; const bool valid = r < n;
                const int t = tq[ai * 4 + m]; const int b = t >> 11; float ss = 0.f;
                const size_t orow = (size_t)(xoff + r);
                u32x4 w[2], z[2];
                f32x4 gq[2][2];
#pragma unroll
                for (int bj = 0; bj < 2; ++bj) { const int c0 = ch + 32 * bj;
                    gq[bj][0] = *(const LAS f32x4*)(sb + b * 1024 + ((c0 ^ b) << 4)); gq[bj][1] = *(const LAS f32x4*)(sb + b * 1024 + (((c0 + 1) ^ b) << 4)); }
                const u32x4 rw0 = raw[m][0], rw1 = raw[m][1];
                if (ai == 0) { const int tn = tq[4 + m];
#pragma unroll
                    for (int bj = 0; bj < 2; ++bj) raw[m][bj] = *(const u32x4*)(x1 + (size_t)tn * 1024 + col0 + bj * 128); }
#pragma unroll
                for (int bj = 0; bj < 2; ++bj) {
                    const f32x4 ga = gq[bj][0], gb = gq[bj][1];
                    const u32x4 rw = bj ? rw1 : rw0;
                    const f32x4 p0 = (f32x4){__uint_as_float(rw.x << 16), __uint_as_float(rw.x & 0xffff0000u), __uint_as_float(rw.y << 16), __uint_as_float(rw.y & 0xffff0000u)};
                    const f32x4 p1 = (f32x4){__uint_as_float(rw.z << 16), __uint_as_float(rw.z & 0xffff0000u), __uint_as_float(rw.w << 16), __uint_as_float(rw.w & 0xffff0000u)};
                    const f32x4 v0 = p0 + ga * acc[ai][bj][m][0], v1 = p1 + gb * acc[ai][bj][m][1];
                    ss += ((v0[0] * v0[0] + v0[1] * v0[1]) + (v0[2] * v0[2] + v0[3] * v0[3])) + ((v1[0] * v1[0] + v1[1] * v1[1]) + (v1[2] * v1[2] + v1[3] * v1[3]));
                    w[bj].x = cvt_pk_bf16(v0[0], v0[1]); w[bj].y = cvt_pk_bf16(v0[2], v0[3]); w[bj].z = cvt_pk_bf16(v1[0], v1[1]); w[bj].w = cvt_pk_bf16(v1[2], v1[3]);
                    if (haveNext) { const int c0 = ch + 32 * bj; const f32x4 Ga = *(const LAS f32x4*)(sb + 8192 + b * 1024 + ((c0 ^ b) << 4)), Gb = *(const LAS f32x4*)(sb + 8192 + b * 1024 + (((c0 + 1) ^ b) << 4));
                        const f32x4 a0 = v0 * Ga, a1 = v1 * Gb;
                        z[bj].x = cvt_pk_bf16(a0[0], a0[1]); z[bj].y = cvt_pk_bf16(a0[2], a0[3]); z[bj].z = cvt_pk_bf16(a1[0], a1[1]); z[bj].w = cvt_pk_bf16(a1[2], a1[3]); }
                }
                ss = rows_sum(ss);
                if (valid) {
#pragma unroll
                    for (int bj = 0; bj < 2; ++bj) {
                        *(u32x4*)(x2b + orow * 1024 + col0 + bj * 128) = w[bj];
                        if (haveNext) *(u32x4*)(A1 + (size_t)t * 1024 + col0 + bj * 128) = z[bj];
                    }
                    if (fq == 0) ssq[(size_t)t * 16 + pn * 4 + wc] = ss;
                }
            }
    }
};

struct MUnit45 : MUnit { int kind, nt, slot, tile; unsigned ldb; };
struct Sched45 {
    const char* A2; const char* Wgu; const char* act; const char* Wd; LAS const int* pre; int t0, ntl, rank, n4;
    __device__ __forceinline__ bool next(int i, MUnit45& u) const {
        if (i < n4) {
            const int en = rank + 32 * i, tile_id = t0 + (en >> 3), pn = en & 7;
            int bkt = 0;
            for (int b = 1; b < NBKT; ++b) if (pre[b] <= tile_id) bkt = b;
            bkt = __builtin_amdgcn_readfirstlane(bkt);
            const int pb_ = __builtin_amdgcn_readfirstlane(pre[bkt]);
            const int rt = tile_id - pb_; int e0, e1; bucket_experts(bkt, e0, e1);
            const int slot = pn >> 2, tile = pn & 3, e = slot ? e1 : e0;
            u.A = A2; u.B = Wgu + ((size_t)e * 1024 + tile * 256) * 2048; u.first = 1; u.last = 1;
            u.i0 = bkt; u.i1 = rt; u.i2 = pn; u.i3 = __builtin_amdgcn_readfirstlane(pre[32 + bkt]); u.i4 = pb_ * 256; u.i5 = e;
            u.kind = 0; u.nt = 16; u.slot = i; u.tile = tile_id; u.ldb = 2048u;
            return true;
        }
        const int j = i - n4, k5 = j >> 1, sub = j & 1, en = rank + 32 * (n4 + k5) - 8 * ntl; if (en >= 4 * ntl) return false;
        const int tile_id = t0 + (en >> 2), pn = en & 3;
        int bkt = 0;
        for (int b = 1; b < NBKT; ++b) if (pre[b] <= tile_id) bkt = b;
        bkt = __builtin_amdgcn_readfirstlane(bkt);
        const int pb_ = __builtin_amdgcn_readfirstlane(pre[bkt]);
        const int rt = tile_id - pb_; int e0, e1; bucket_experts(bkt, e0, e1);
        const int e = sub ? e1 : e0, off = pb_ * 256;
        u.A = act + (size_t)(off + rt * 256) * 2048 + sub * 1024; u.B = Wd + ((size_t)e * 1024 + pn * 256) * 1024; u.first = (sub == 0); u.last = (sub == 1);
        u.i0 = bkt; u.i1 = rt; u.i2 = pn; u.i3 = __builtin_amdgcn_readfirstlane(pre[32 + bkt]); u.i4 = __builtin_amdgcn_readfirstlane(pre[64 + bkt]); u.i5 = 9216 + k5 * 1024;
        u.kind = 1; u.nt = 8; u.slot = k5; u.tile = tile_id; u.ldb = 1024u;
        return true;
    }
    __device__ __forceinline__ unsigned aoff(const MUnit45& u, int row, int Cc, LAS unsigned char* lds) const {
        if (u.kind == 0) return (unsigned)((const LAS int*)(lds + TAB_OFF + u.slot * 3072))[row] * 2048u + (unsigned)Cc * 2u;
        return (unsigned)row * 2048u + (unsigned)Cc * 2u;
    }
};
template <class Epi4, class Epi5>
__device__ __forceinline__ void mm_phase45(LAS unsigned char* lds, const Sched45& S, const Epi4& E4, const Epi5& E5, const int tid, unsigned* ready, unsigned* tmo) {
    const int wid = __builtin_amdgcn_readfirstlane(tid >> 6), lane = tid & 63, wr = wid >> 2, wc = wid & 3, fr = lane & 15, fq = lane >> 4;
    int Rr[2], RbV[2], Cc;
#pragma unroll
    for (int i = 0; i < 2; ++i) { int R, C; stage_rc(tid * 16 + i * 8192, R, C); Rr[i] = R; RbV[i] = (R & ~31) + perm32(R & 31); Cc = C; }
    const size_t kstep = (size_t)(BK * 2);
    const unsigned ldsw = (unsigned)wid * 1024u;
    const int aoff = lds_byte(wr * 64 + fr, fq * 8), boff = lds_byte(wc * 32 + fr, fq * 8);
#define MM_SA(b, h) (((b) * 2 + (h)) * HTB)
#define MM_SB(b, h) ((4 + (b) * 2 + (h)) * HTB)
#define MM_STAGE_B(bufoff, nx, hb, koff) do { \
        const unsigned ldb_ = (nx) ? pf.ldb : cur.ldb; const char* gb_ = ((nx) ? pf.B : cur.B) + (size_t)(hb) * 128u * ldb_ + (koff); \
        _Pragma("unroll") for (int _i = 0; _i < 2; ++_i) { \
            const unsigned vo_ = (unsigned)RbV[_i] * ldb_ + (unsigned)Cc * 2u; \
            __builtin_amdgcn_global_load_lds((const unsigned*)(gb_ + vo_), (LAS unsigned*)(lds + (bufoff) + ldsw + _i * 8192), 16, 0, 0); } } while (0)
#define MM_STAGE_A(bufoff, nx, h, koff) do { \
        const char* gb_ = ((nx) ? pf.A : cur.A) + (koff); \
        _Pragma("unroll") for (int _i = 0; _i < 2; ++_i) { \
            unsigned vo_ = vAc[h][_i]; \
            if (nx) vo_ = S.aoff(pf, (h) * 128 + Rr[_i], Cc, lds); \
            __builtin_amdgcn_global_load_lds((const unsigned*)(gb_ + vo_), (LAS unsigned*)(lds + (bufoff) + ldsw + _i * 8192), 16, 0, 0); } } while (0)
#define MM_LDA(dst, b, h) do { _Pragma("unroll") for (int m = 0; m < 4; ++m) _Pragma("unroll") for (int k = 0; k < 2; ++k) dst[m][k] = *(const LAS bf16x8*)(lds + MM_SA(b, h) + aoff + m * 2048 + k * 1024); } while (0)
#define MM_LDB(dst, b, h) do { _Pragma("unroll") for (int n = 0; n < 2; ++n) _Pragma("unroll") for (int k = 0; k < 2; ++k) dst[n][k] = *(const LAS bf16x8*)(lds + MM_SB(b, h) + boff + n * 2048 + k * 1024); } while (0)
#define MM_MMA(ai, bj, At, Bt) do { __builtin_amdgcn_s_setprio(1); _Pragma("unroll") for (int m = 0; m < 4; ++m) _Pragma("unroll") for (int n = 0; n < 2; ++n) _Pragma("unroll") for (int k = 0; k < 2; ++k) \
        acc[ai][bj][m][n] = __builtin_amdgcn_mfma_f32_16x16x32_bf16(Bt[n][k], At[m][k], acc[ai][bj][m][n], 0, 0, 0); __builtin_amdgcn_s_setprio(0); } while (0)
#define MM_WAIT_V(n) asm volatile("s_waitcnt vmcnt(" #n ")" ::: "memory")
#define MM_WAIT_L(n) asm volatile("s_waitcnt lgkmcnt(" #n ")" ::: "memory")
#define MM_BAR __builtin_amdgcn_s_barrier()
#define MM_SCHED __builtin_amdgcn_sched_barrier(0)
#define MM_ZERO() do { _Pragma("unroll") for (int a_ = 0; a_ < 2; ++a_) _Pragma("unroll") for (int b_ = 0; b_ < 2; ++b_) _Pragma("unroll") for (int m_ = 0; m_ < 4; ++m_) _Pragma("unroll") for (int n_ = 0; n_ < 2; ++n_) \
        acc[a_][b_][m_][n_] = (f32x4){0.f, 0.f, 0.f, 0.f}; } while (0)
    MUnit45 cur, nxt, pf; int ui = 0;
    if (!S.next(0, cur)) return;
    nxt = cur; pf = cur;
    f32x4 acc[2][2][4][2];
    MM_ZERO();
    bf16x8 At[4][2], B0[2][2], B1[2][2];
    unsigned vAc[2][2];
#pragma unroll
    for (int h = 0; h < 2; ++h)
#pragma unroll
        for (int i = 0; i < 2; ++i) vAc[h][i] = S.aoff(cur, h * 128 + Rr[i], Cc, lds);
    MM_STAGE_B(MM_SB(0, 0), false, 0, 0); MM_STAGE_B(MM_SB(0, 1), false, 1, 0); MM_STAGE_A(MM_SA(0, 0), false, 0, 0); MM_STAGE_A(MM_SA(0, 1), false, 1, 0);
    if (wr == 1) MM_BAR;
    MM_WAIT_V(2); MM_BAR;
    MM_STAGE_B(MM_SB(1, 0), false, 0, kstep); MM_STAGE_A(MM_SA(1, 0), false, 0, kstep); MM_STAGE_B(MM_SB(1, 1), false, 1, kstep);
    MM_WAIT_V(6); MM_BAR;
    for (;;) {
        const bool has_next = S.next(ui + 1, nxt);
        const bool need_wait = has_next && nxt.kind == 1 && nxt.first;
        const bool defer = need_wait && cur.kind == 0;
        pf = (has_next && !defer) ? nxt : cur;
        const int nt = cur.nt;
        for (int t = 0; t < nt; t += 2) {
            const bool last = (t == nt - 2);
            const size_t k1 = (size_t)(t + 1) * kstep;
            const size_t k2 = last ? 0 : (size_t)(t + 2) * kstep;
            const size_t k3 = k2 + kstep;
            if (t == 2 && cur.last) { int ln_ = lane, wd_ = wid; asm volatile("" : "+v"(ln_), "+s"(wd_)); if (cur.kind == 0) E4.side(cur, wd_, ln_, lds); else E5.side(cur, wd_, ln_, lds); }
            if (last && need_wait && !defer) {
                if (tid < 64) {
                    unsigned* w = ready + 16 * nxt.tile; unsigned sp = 0;
                    while ((unsigned)__builtin_amdgcn_readfirstlane(__hip_atomic_load(w, __ATOMIC_RELAXED, __HIP_MEMORY_SCOPE_AGENT)) < 64u) {
                        __builtin_amdgcn_s_sleep(2);
                        if ((++sp & 255u) == 0u) { if (__builtin_amdgcn_readfirstlane(__hip_atomic_load(tmo, __ATOMIC_RELAXED, __HIP_MEMORY_SCOPE_AGENT)) != 0u) break;
                            if (sp > (1u << 20)) { if (lane == 0) __hip_atomic_store(tmo, 0x45u, __ATOMIC_RELAXED, __HIP_MEMORY_SCOPE_AGENT); break; } }
                    }
                    __builtin_amdgcn_fence(__ATOMIC_ACQUIRE, "agent");
                    asm volatile("s_waitcnt vmcnt(0)" ::: "memory");
                }
                asm volatile("" ::: "memory"); MM_BAR; asm volatile("" ::: "memory");
            }
            MM_LDB(B0, 0, 0); MM_LDB(B1, 0, 1); MM_SCHED; MM_LDA(At, 0, 0); MM_STAGE_A(MM_SA(1, 1), false, 1, k1);
            MM_WAIT_V(8); MM_WAIT_L(0); MM_BAR; MM_MMA(0, 0, At, B0); MM_MMA(0, 1, At, B1); MM_BAR; MM_SCHED;
            MM_LDA(At, 0, 1); MM_STAGE_B(MM_SB(0, 0), last, 0, k2); MM_STAGE_B(MM_SB(0, 1), last, 1, k2); MM_STAGE_A(MM_SA(0, 0), last, 0, k2);
            MM_WAIT_V(8); MM_WAIT_L(0); MM_BAR; MM_MMA(1, 0, At, B0); MM_MMA(1, 1, At, B1); MM_BAR; MM_SCHED;
            MM_LDB(B0, 1, 0); MM_LDB(B1, 1, 1); MM_SCHED; MM_LDA(At, 1, 0); MM_STAGE_A(MM_SA(0, 1), last, 1, k2);
            MM_WAIT_V(8); MM_WAIT_L(0); MM_BAR; MM_MMA(0, 0, At, B0); MM_MMA(0, 1, At, B1); MM_BAR; MM_SCHED;
            MM_LDA(At, 1, 1); MM_STAGE_B(MM_SB(1, 0), last, 0, k3); MM_STAGE_B(MM_SB(1, 1), last, 1, k3); MM_STAGE_A(MM_SA(1, 0), last, 0, k3);
            MM_WAIT_V(8); MM_WAIT_L(0); MM_BAR; MM_MMA(1, 0, At, B0); MM_MMA(1, 1, At, B1); MM_BAR; MM_SCHED;
        }
        const bool epi = cur.last != 0;
        int fr_ = fr, fq_ = fq, wr_ = wr, wc_ = wc; asm volatile("" : "+v"(fr_), "+v"(fq_), "+s"(wr_), "+s"(wc_));
        if (epi) {
            if (wr == 0) MM_BAR;
            if (cur.kind == 0) {
                E4(acc, cur, cur.slot, wr_, wc_, fr_, fq_, lds);
                asm volatile("s_waitcnt vmcnt(0)" ::: "memory");
                if (lane == 0) __hip_atomic_fetch_add(ready + 16 * cur.tile, 1u, __ATOMIC_RELAXED, __HIP_MEMORY_SCOPE_AGENT);
            } else E5(acc, cur, ui, wr_, wc_, fr_, fq_, lds);
        }
        if (!has_next) break;
        if (nxt.first) MM_ZERO();
        cur = nxt; ++ui;
#pragma unroll
        for (int h = 0; h < 2; ++h)
#pragma unroll
            for (int i = 0; i < 2; ++i) vAc[h][i] = S.aoff(cur, h * 128 + Rr[i], Cc, lds);
        if (defer) {
            MM_WAIT_V(0);
            if (tid < 64) {
                unsigned* w = ready + 16 * cur.tile; unsigned sp = 0;
                while ((unsigned)__builtin_amdgcn_readfirstlane(__hip_atomic_load(w, __ATOMIC_RELAXED, __HIP_MEMORY_SCOPE_AGENT)) < 64u) {
                    __builtin_amdgcn_s_sleep(2);
                    if ((++sp & 255u) == 0u) { if (__builtin_amdgcn_readfirstlane(__hip_atomic_load(tmo, __ATOMIC_RELAXED, __HIP_MEMORY_SCOPE_AGENT)) != 0u) break;
                        if (sp > (1u << 20)) { if (lane == 0) __hip_atomic_store(tmo, 0x46u, __ATOMIC_RELAXED, __HIP_MEMORY_SCOPE_AGENT); break; } }
                }
                __builtin_amdgcn_fence(__ATOMIC_ACQUIRE, "agent");
                asm volatile("s_waitcnt vmcnt(0)" ::: "memory");
            }
            asm volatile("" ::: "memory"); MM_BAR; asm volatile("" ::: "memory");
            MM_STAGE_B(MM_SB(0, 0), false, 0, 0); MM_STAGE_B(MM_SB(0, 1), false, 1, 0); MM_STAGE_A(MM_SA(0, 0), false, 0, 0); MM_STAGE_A(MM_SA(0, 1), false, 1, 0);
            if (wr == 1) MM_BAR;
            MM_WAIT_V(2); MM_BAR;
            MM_STAGE_B(MM_SB(1, 0), false, 0, kstep); MM_STAGE_A(MM_SA(1, 0), false, 0, kstep); MM_STAGE_B(MM_SB(1, 1), false, 1, kstep);
            MM_WAIT_V(6); MM_BAR;
        } else if (epi) { if (wr == 1) MM_BAR; }
    }
    MM_WAIT_V(0);
    MM_BAR;
#undef MM_SA
#undef MM_SB
#undef MM_STAGE_A
#undef MM_STAGE_B
#undef MM_LDA
#undef MM_LDB
#undef MM_MMA
#undef MM_WAIT_V
#undef MM_WAIT_L
#undef MM_BAR
#undef MM_SCHED
#undef MM_ZERO
}
}

__device__ __forceinline__ int build_tile_prefix(const unsigned* cnt, LAS int* pre, int tid) {
    if (tid == 0) { int s = 0, x = 0; for (int b = 0; b < NBKT; ++b) { const unsigned n = cnt[b]; pre[b] = s; pre[32 + b] = (int)n; pre[64 + b] = x; s += (int)((n + 255u) >> 8); x += (int)n; } pre[NBKT] = s; }
    __syncthreads();
    return pre[NBKT];
}
__device__ __forceinline__ void phase_p1_fast(const Args& a, const Ctx& c, int l) {
    mm::SchedP1 S; S.A = (const char*)(a.ws + (l == 0 ? WS_ACTX : WS_A3)); S.B = (const char*)(a.ws + WS_WIN) + (size_t)l * INC * 1024 * 2;
    S.nM = 64; S.nN = 10; S.nU = 640; S.G = c.nwg; S.c = c.wg; S.nt = 16; S.lda = 2048; S.ldb = 2048;
    mm::EpiP1 E{(bf16*)(a.ws + WS_PROJ), (const float*)(a.ws + WS_SMALL + SO_SSQA), (const float*)(a.ws + WS_SMALL + SO_BIAS1) + (size_t)l * 8 * INC};
    {
        const int* rowx = (const int*)(a.ws + WS_SMALL + SO_ROWX);
        mm::MUnit u;
        for (int i = 0; i < 3 && S.next(i, u); ++i) {
            if (c.tid < 256) { const int r = u.i0 * 256 + (u.i2 ? (c.tid & 127) + (u.i2 == 2 ? 128 : 0) : c.tid);
                ((LAS int*)(c.lds + mm::TAB_OFF + i * 3072))[c.tid] = r;
                ((LAS float*)(c.lds + mm::TAB_OFF + i * 3072 + 1024))[c.tid] = rstd_from16(E.ssq, r); }
        }
        __syncthreads();
    }
    mm::mm_phase<mm::EpiP1, mm::SchedP1, true>(c.lds, S, E, c.tid);
}
template <bool L0, bool WT>
__device__ __forceinline__ void phase_p3_impl(const Args& a, const Ctx& c, int l, int cslot) {
    mm::SchedP3 S; S.A = (const char*)(a.ws + WS_A3); S.B = (const char*)(a.ws + WS_WOUT) + (size_t)l * 1024 * 1024 * 2;
    S.nM = 64; S.nN = 4; S.nU = 256; S.G = c.nwg; S.c = c.wg; S.nt = 8; S.lda = 2048; S.ldb = 2048;
    mm::EpiP3<L0, WT> E{a.in[I_X], (const bf16*)(a.ws + WS_X2B), (bf16*)(a.ws + WS_XA), (bf16*)(a.ws + WS_ACTX), (float*)(a.ws + WS_SMALL + SO_SSQB),
                    (const float*)(a.ws + WS_SMALL + SO_MODV) + (size_t)l * 8 * 6144 + 2048, (const float*)(a.ws + WS_SMALL + SO_G2) + (size_t)l * 8 * 1024};
    {
        const float* ssqc = (const float*)(a.ws + WS_SMALL + SO_SSQC); const int* rowx = (const int*)(a.ws + WS_SMALL + SO_ROWX);
        mm::MUnit u;
        for (int i = 0; i < 3 && S.next(2 * i, u); ++i) {
            if (c.tid < 256) {
                const f32x4* p = (const f32x4*)(ssqc + (size_t)(u.i0 * 256 + c.tid) * 16);
                const f32x4 a0 = p[0], a1 = p[1], b0 = p[2], b1 = p[3];
                const float sa = ((a0.x + a0.y) + (a0.z + a0.w)) + ((a1.x + a1.y) + (a1.z + a1.w)), sb = ((b0.x + b0.y) + (b0.z + b0.w)) + ((b1.x + b1.y) + (b1.z + b1.w));
                const float ra = rsqrtf(sa * (1.0f / 512.0f) + EPS), rb = rsqrtf(sb * (1.0f / 512.0f) + EPS);
                ((LAS int*)(c.lds + mm::TAB_OFF + i * 3072))[c.tid] = rowx[u.i0 * 256 + c.tid];
                ((LAS float*)(c.lds + mm::TAB_OFF + i * 3072 + 1024))[c.tid] = ra / rb;
                ((LAS float*)(c.lds + mm::TAB_OFF + i * 3072 + 2048))[c.tid] = rb;
            }
        }
        __syncthreads();
    }
    mm::mm_phase<mm::EpiP3<L0, WT>, mm::SchedP3, false>(c.lds, S, E, c.tid);
    mm::MUnit u0;
    if (S.next(0, u0)) {
        unsigned* pnl = (unsigned*)(a.ws + WS_CTL) + CW_PNL + (cslot * 64 + u0.i0) * 16; unsigned* tmo = (unsigned*)(a.ws + WS_CTL) + CW_TMO;
        asm volatile("s_waitcnt vmcnt(0)" ::: "memory");
        __syncthreads();
        rt_bf16x8 wpre[32];
        { const bf16* wrow = (const bf16*)(a.ws + WS_SMALL + SO_RWT) + (c.lane & 15) * 1024 + 8 * (c.lane >> 4);
#pragma unroll
          for (int i = 0; i < 32; ++i) wpre[i] = *(const rt_bf16x8*)(wrow + 32 * i); }
        if (c.tid == 0) __hip_atomic_fetch_add(pnl, 1u, __ATOMIC_RELAXED, __HIP_MEMORY_SCOPE_AGENT);
        if (c.tid < 64) {
            unsigned sp = 0;
            while ((unsigned)__builtin_amdgcn_readfirstlane(__hip_atomic_load(pnl, __ATOMIC_RELAXED, __HIP_MEMORY_SCOPE_AGENT)) < 4u) {
                __builtin_amdgcn_s_sleep(2);
                if ((++sp & 255u) == 0u) { if (__builtin_amdgcn_readfirstlane(__hip_atomic_load(tmo, __ATOMIC_RELAXED, __HIP_MEMORY_SCOPE_AGENT)) != 0u) break;
                    if (sp > (1u << 20)) { if (c.lane == 0) __hip_atomic_store(tmo, 0x33u, __ATOMIC_RELAXED, __HIP_MEMORY_SCOPE_AGENT); break; } }
            }
            __builtin_amdgcn_fence(__ATOMIC_ACQUIRE, "agent");
            asm volatile("s_waitcnt vmcnt(0)" ::: "memory");
        }
        __syncthreads();
        route_tokens(a, c, l, cslot, u0.i0 * 256 + u0.i1 * 64, 4, wpre);
    }
}
__device__ __forceinline__ void phase_p3_fast(const Args& a, const Ctx& c, int l, int cslot, int pure) {
    if (pure) { if (l == 0) phase_p3_impl<true, false>(a, c, l, cslot); else phase_p3_impl<false, false>(a, c, l, cslot); }
    else { if (l == 0) phase_p3_impl<true, true>(a, c, l, cslot); else phase_p3_impl<false, true>(a, c, l, cslot); }
}
__device__ __forceinline__ void phase_p4_fast(const Args& a, const Ctx& c, int l) {
    const unsigned* cnt = (const unsigned*)(a.ws + WS_CTL) + CW_CNT + l * 32;
    LAS int* pre = (LAS int*)(c.lds + LDSCTL_OFF + 256);
    const int ntile = build_tile_prefix(cnt, pre, c.tid);
    mm::SchedP4 S; S.tokl = (const int*)(a.ws + WS_SMALL + SO_TOKL); S.cnt = cnt; S.A2 = (const char*)(a.ws + WS_ACTX); S.Wgu = (const char*)(a.ws + WS_WGU) + (size_t)l * NE * 1024 * 1024 * 2; S.pre = pre;
    S.nU = ntile * 8; S.G = c.nwg; S.c = c.wg; S.nt = 16; S.lda = 2048; S.ldb = 2048;
    mm::EpiP4 E{(bf16*)(a.ws + WS_ACT), S.tokl, (const float*)(a.ws + WS_SMALL + SO_SSQB), (const float*)(a.ws + WS_SMALL + SO_BIASGU) + (size_t)l * 8 * 16 * 1024, (const float*)(a.ws + WS_SMALL + SO_GATES), 0};
    {
        mm::MUnit u;
        for (int i = 0; i < 3 && S.next(i, u); ++i) {
            if (c.tid < 256) {
                const int rr = u.i1 * 256 + c.tid; const bool valid = rr < u.i3; const int t = valid ? S.tokl[u.i0 * TOKCAP + rr] : 0;
                ((LAS int*)(c.lds + mm::TAB_OFF + i * 3072))[c.tid] = t;
                ((LAS float*)(c.lds + mm::TAB_OFF + i * 3072 + 1024))[c.tid] = rstd_from16(E.ssq, t);
                ((LAS float*)(c.lds + mm::TAB_OFF + i * 3072 + 2048))[c.tid] = valid ? E.gates[(size_t)t * 2 + (u.i2 >> 2)] : 0.f;
                if (valid && u.i2 == 0) ((int*)(a.ws + WS_SMALL + SO_ROWX))[t] = pre[64 + u.i0] + rr;
            }
        }
        __syncthreads();
    }
    mm::mm_phase<mm::EpiP4, mm::SchedP4, true>(c.lds, S, E, c.tid);
}
__device__ __forceinline__ void phase_p5_fast(const Args& a, const Ctx& c, int l) {
    const unsigned* cnt = (const unsigned*)(a.ws + WS_CTL) + CW_CNT + l * 32;
    LAS int* pre = (LAS int*)(c.lds + LDSCTL_OFF + 256);
    const int ntile = build_tile_prefix(cnt, pre, c.tid);
    mm::SchedP5 S; S.cnt = cnt; S.act = (const char*)(a.ws + WS_ACT); S.Wd = (const char*)(a.ws + WS_WD) + (size_t)l * NE * 1024 * 512 * 2; S.pre = pre;
    S.nU = ntile * 4; S.G = c.nwg; S.c = c.wg; S.nt = 8; S.lda = 2048; S.ldb = 1024;
    mm::EpiP5 E{(const bf16*)(a.ws + WS_XA), (bf16*)(a.ws + WS_X2B), (bf16*)(a.ws + WS_A3), (float*)(a.ws + WS_SMALL + SO_SSQA),
                (const float*)(a.ws + WS_SMALL + SO_MODV) + (size_t)l * 8 * 6144 + 5120, (const float*)(a.ws + WS_SMALL + SO_G1) + (size_t)(l + 1 < DEPTH ? l + 1 : l) * 8 * 1024, (l + 1 < DEPTH) ? 1 : 0};
    const int* tokl_ = (const int*)(a.ws + WS_SMALL + SO_TOKL);
    {
        mm::MUnit u;
        for (int i = 0; i < 3 && S.next(2 * i, u); ++i) {
            if (c.tid < 256) { const int rr = u.i1 * 256 + c.tid; ((LAS int*)(c.lds + mm::TAB_OFF + i * 3072))[c.tid] = (rr < u.i3) ? tokl_[u.i0 * TOKCAP + rr] : 0; }
        }
        __syncthreads();
    }
    mm::mm_phase<mm::EpiP5, mm::SchedP5, false>(c.lds, S, E, c.tid);
}


__device__ __forceinline__ void phase_p45(const Args& a, const Ctx& c, int l, int rslot, int pure) {
    const unsigned* cnt = (const unsigned*)(a.ws + WS_CTL) + CW_CNT + l * 32;
    LAS int* pre = (LAS int*)(c.lds + LDSCTL_OFF + 256);
    const int ntile = build_tile_prefix(cnt, pre, c.tid);
    mm::Sched45 S; S.A2 = (const char*)(a.ws + WS_ACTX); S.Wgu = (const char*)(a.ws + WS_WGU) + (size_t)l * NE * 1024 * 1024 * 2; S.act = (const char*)(a.ws + WS_ACT);
    S.Wd = (const char*)(a.ws + WS_WD) + (size_t)l * NE * 1024 * 512 * 2; S.pre = pre;
    { const int x = c.wg & 7; S.t0 = (x * ntile) >> 3; S.ntl = (((x + 1) * ntile) >> 3) - S.t0; S.rank = c.wg >> 3; S.n4 = (8 * S.ntl > S.rank) ? (8 * S.ntl - S.rank + 31) / 32 : 0; }
    const int* tokl = (const int*)(a.ws + WS_SMALL + SO_TOKL);
    mm::EpiP4 E4{(bf16*)(a.ws + WS_ACT), tokl, (const float*)(a.ws + WS_SMALL + SO_SSQB), (const float*)(a.ws + WS_SMALL + SO_BIASGU) + (size_t)l * 8 * 16 * 1024, (const float*)(a.ws + WS_SMALL + SO_GATES), pure ? 0 : 1};
    mm::EpiP5 E5{(const bf16*)(a.ws + WS_XA), (bf16*)(a.ws + WS_X2B), (bf16*)(a.ws + WS_A3), (float*)(a.ws + WS_SMALL + SO_SSQA),
                 (const float*)(a.ws + WS_SMALL + SO_MODV) + (size_t)l * 8 * 6144 + 5120, (const float*)(a.ws + WS_SMALL + SO_G1) + (size_t)(l + 1 < DEPTH ? l + 1 : l) * 8 * 1024, (l + 1 < DEPTH) ? 1 : 0};
    {
        mm::MUnit45 u;
        for (int i = 0; i < 3 + 4 && S.next(i, u); ++i) {
            if (u.kind == 1 && !u.first) continue;
            if (c.tid < 256) {
                const int rr = u.i1 * 256 + c.tid; const bool valid = rr < u.i3; const int t = valid ? tokl[u.i0 * TOKCAP + rr] : 0;
                if (u.kind == 0) {
                    ((LAS int*)(c.lds + mm::TAB_OFF + u.slot * 3072))[c.tid] = t;
                    ((LAS float*)(c.lds + mm::TAB_OFF + u.slot * 3072 + 1024))[c.tid] = rstd_from16(E4.ssq, t);
                    ((LAS float*)(c.lds + mm::TAB_OFF + u.slot * 3072 + 2048))[c.tid] = valid ? E4.gates[(size_t)t * 2 + (u.i2 >> 2)] : 0.f;
                    if (valid && u.i2 == 0) ((int*)(a.ws + WS_SMALL + SO_ROWX))[t] = pre[64 + u.i0] + rr;
                } else ((LAS int*)(c.lds + mm::TAB_OFF + u.i5))[c.tid] = t;
            }
        }
        __syncthreads();
    }
    mm::mm_phase45(c.lds, S, E4, E5, c.tid, (unsigned*)(a.ws + WS_CTL) + CW_RDY + rslot * 96 * 16, (unsigned*)(a.ws + WS_CTL) + CW_TMO);
}
namespace p2 {
typedef float f32x16 __attribute__((ext_vector_type(16)));
typedef short s16x4 __attribute__((ext_vector_type(4)));
constexpr int EXT_OFF = 131072;
constexpr int ST_OFF = 131072 + 4096;
constexpr float NEG = -1e30f;
__device__ __forceinline__ int crow(int r, int hi) { return (r & 3) + 8 * (r >> 2) + 4 * hi; }
__device__ __forceinline__ s16x4 vtr(const LAS unsigned char* p) { return __builtin_bit_cast(s16x4, __builtin_amdgcn_ds_read_tr16_b64_v4i16((LAS s16x4*)p)); }
__device__ __forceinline__ unsigned cvtpk(float lo, float hi) { unsigned r; asm volatile("v_cvt_pk_bf16_f32 %0, %1, %2" : "=v"(r) : "v"(lo), "v"(hi)); return r; }
__device__ __forceinline__ float halves_max(float v) { auto rr = __builtin_amdgcn_permlane32_swap(__float_as_uint(v), __float_as_uint(v), false, false); return fmaxf(__uint_as_float(rr[0]), __uint_as_float(rr[1])); }
__device__ __forceinline__ float halves_sum(float v) { auto rr = __builtin_amdgcn_permlane32_swap(__float_as_uint(v), __float_as_uint(v), false, false); return __uint_as_float(rr[0]) + __uint_as_float(rr[1]); }
__device__ __forceinline__ u32x4 pair_swap(uint2 a, uint2 b) {
    auto r0 = __builtin_amdgcn_permlane32_swap(a.x, b.x, false, false); auto r1 = __builtin_amdgcn_permlane32_swap(a.y, b.y, false, false);
    u32x4 w; w.x = r0[0]; w.y = r1[0]; w.z = r0[1]; w.w = r1[1]; return w;
}
__device__ __forceinline__ void pair_unswap(u32x4 w, uint2& a, uint2& b) {
    auto r0 = __builtin_amdgcn_permlane32_swap(w.x, w.z, false, false); auto r1 = __builtin_amdgcn_permlane32_swap(w.y, w.w, false, false);
    a.x = r0[0]; a.y = r1[0]; b.x = r0[1]; b.y = r1[1];
}

__device__ __forceinline__ void attn_task(const bf16* qh, const bf16* kh, const bf16* vh, int b, int h, int cfg, int r, int iq0, int blk, LAS unsigned char* lds, LAS unsigned char* vbuf, bf16* osc, float* lsc, int lane) {
    const int d = 1 << (2 * cfg), q = lane & 31, hi = lane >> 5;
    const int kbase = iq0 - 128;
    const size_t rowq = ((size_t)(b * 8 + h) * SEQ + d * (iq0 + q) + r) * 64;
    bf16x8 qf[4];
#pragma unroll
    for (int d0 = 0; d0 < 4; ++d0) qf[d0] = *(const bf16x8*)(qh + rowq + 16 * d0 + 8 * hi);
    f32x16 S[5];
    const int e0_ = 31 - q + 4 * hi, sft_ = e0_ & 3;
    const LAS float* ext = (const LAS float*)(lds + EXT_OFF) + sft_ * 768 + cfg * 256 + (e0_ - sft_);
#pragma unroll
    for (int a = 0; a < 5; ++a) {
        if (kbase + 32 * a >= 0) {
            const size_t rowk = ((size_t)(b * 8 + h) * SEQ + d * (kbase + 32 * a + q) + r) * 64 + 8 * hi;
            bf16x8 kf[4];
#pragma unroll
            for (int d0 = 0; d0 < 4; ++d0) kf[d0] = *(const bf16x8*)(kh + rowk + 16 * d0);
            f32x16 s;
#pragma unroll
            for (int k8 = 0; k8 < 4; ++k8) { const f32x4 ev = *(const LAS f32x4*)(ext + 32 * a + 8 * k8); s[4 * k8] = ev[0]; s[4 * k8 + 1] = ev[1]; s[4 * k8 + 2] = ev[2]; s[4 * k8 + 3] = ev[3]; }
#pragma unroll
            for (int d0 = 0; d0 < 4; ++d0) s = __builtin_amdgcn_mfma_f32_32x32x16_bf16(kf[d0], qf[d0], s, 0, 0, 0);
            S[a] = s;
        } else {
#pragma unroll
            for (int rr = 0; rr < 16; ++rr) S[a][rr] = NEG;
        }
    }
    float m = NEG;
#pragma unroll
    for (int a = 0; a < 5; ++a)
#pragma unroll
        for (int rr = 0; rr < 16; ++rr) m = fmaxf(m, S[a][rr]);
    m = halves_max(m);
    float lsum = 0.f;
#pragma unroll
    for (int a = 0; a < 5; ++a)
#pragma unroll
        for (int rr = 0; rr < 16; ++rr) { const float p = __builtin_amdgcn_exp2f(S[a][rr] - m); S[a][rr] = p; lsum += p; }
    lsum = halves_sum(lsum);
    f32x16 o[2];
#pragma unroll
    for (int dh = 0; dh < 2; ++dh)
#pragma unroll
        for (int rr = 0; rr < 16; ++rr) o[dh][rr] = 0.f;
    const LAS unsigned char* vrd = vbuf + ((lane >> 4) & 1) * 32 + (lane & 3) * 8 + (4 * hi + ((lane & 15) >> 2)) * 64;
    u32x4 vreg[4][4];
#pragma unroll
    for (int a = 1; a < 5; ++a)
        if (kbase + 32 * a >= 0) {
#pragma unroll
            for (int i = 0; i < 4; ++i) { const int id = lane + 64 * i, kv = id >> 3, d8 = id & 7;
                vreg[a - 1][i] = *(const u32x4*)(vh + ((size_t)(b * 8 + h) * SEQ + d * (kbase + 32 * a + kv) + r) * 64 + d8 * 8); }
        }
#pragma unroll
    for (int a = 1; a < 5; ++a) {
        if (kbase + 32 * a >= 0) {
#pragma unroll
            for (int i = 0; i < 4; ++i) { const int id = lane + 64 * i, kv = id >> 3, d8 = id & 7;
                *(LAS u32x4*)(vbuf + (d8 >> 2) * 2048 + (kv >> 4) * 1024 + (kv & 15) * 64 + (d8 & 3) * 16) = vreg[a - 1][i]; }
            asm volatile("s_waitcnt lgkmcnt(0)" ::: "memory");
            const LAS unsigned char* vr = vrd;
#pragma unroll
            for (int ks = 0; ks < 2; ++ks) {
                u32x4 pw; pw.x = cvtpk(S[a][8 * ks + 0], S[a][8 * ks + 1]); pw.y = cvtpk(S[a][8 * ks + 2], S[a][8 * ks + 3]); pw.z = cvtpk(S[a][8 * ks + 4], S[a][8 * ks + 5]); pw.w = cvtpk(S[a][8 * ks + 6], S[a][8 * ks + 7]);
                const bf16x8 pb = __builtin_bit_cast(bf16x8, pw);
#pragma unroll
                for (int dh = 0; dh < 2; ++dh) {
                    const s16x4 lo = vtr(vr + dh * 2048 + ks * 1024), hh = vtr(vr + dh * 2048 + ks * 1024 + 512);
                    const bf16x8 vf = (bf16x8){lo[0], lo[1], lo[2], lo[3], hh[0], hh[1], hh[2], hh[3]};
                    o[dh] = __builtin_amdgcn_mfma_f32_32x32x16_bf16(vf, pb, o[dh], 0, 0, 0);
                }
            }
            asm volatile("s_waitcnt lgkmcnt(0)" ::: "memory");
        }
    }
    const int tl = d * (iq0 + q) + r - 512 * blk;
    const float inv = __builtin_amdgcn_rcpf(lsum);
    bf16* orow = osc + (size_t)tl * 64;
#pragma unroll
    for (int dh = 0; dh < 2; ++dh)
#pragma unroll
        for (int k2 = 0; k2 < 2; ++k2) {
            uint2 pa, pb;
            pa.x = cvtpk(o[dh][8 * k2] * inv, o[dh][8 * k2 + 1] * inv); pa.y = cvtpk(o[dh][8 * k2 + 2] * inv, o[dh][8 * k2 + 3] * inv);
            pb.x = cvtpk(o[dh][8 * k2 + 4] * inv, o[dh][8 * k2 + 5] * inv); pb.y = cvtpk(o[dh][8 * k2 + 6] * inv, o[dh][8 * k2 + 7] * inv);
            *(u32x4*)(orow + 32 * dh + 16 * k2 + 8 * hi) = pair_swap(pa, pb);
        }
    if (hi == 0) lsc[cfg * 512 + tl] = m + __builtin_amdgcn_logf(lsum);
}

__device__ __forceinline__ void stage_kv(const bf16* kh, const bf16* vh, int b, int h, int d, int r, int kb0, int R, LAS unsigned char* kl, LAS unsigned char* vl, int wave, int lane, int slot0, int nslots) {
    const int nk = R >> 3;
    for (int n = slot0 + wave; n < 2 * nk; n += nslots) {
        if (n < nk) {
            const int row = 8 * n + (lane >> 3), idx = max(kb0 + row, 0);
            {
                const int cch = (lane & 7) ^ ((row >> 1) & 7);
                const bf16* src = kh + ((size_t)(b * 8 + h) * SEQ + d * idx + r) * 64 + cch * 8;
                __builtin_amdgcn_global_load_lds((const unsigned*)src, (LAS unsigned*)(kl + n * 1024), 16, 0, 0);
            }
        } else {
            const int m = n - nk, p = m >> 1, dh = m & 1, row = 16 * p + (lane >> 2), idx = max(kb0 + row, 0);
            {
                const bf16* src = vh + ((size_t)(b * 8 + h) * SEQ + d * idx + r) * 64 + dh * 32 + (lane & 3) * 8;
                __builtin_amdgcn_global_load_lds((const unsigned*)src, (LAS unsigned*)(vl + dh * (R * 64) + p * 1024), 16, 0, 0);
            }
        }
    }
}
struct MergeArgs { const bf16* osc0; const bf16* osc2; const float* lsc; bf16* a3; float* ssq; };
template <bool WT, bool MG>
__device__ __forceinline__ void attn_task_lds(const bf16* proj, int b, int h, int cfg, int r, int iq0, int blk, const bf16x8 (&qf)[4], const LAS unsigned char* kl, const LAS unsigned char* vl, int vdh, int row0,
                                              LAS unsigned char* lds, bf16* osc, float* lsrow, int lane, const MergeArgs& mg) {
    const int d = 1 << (2 * cfg), q = lane & 31, hi = lane >> 5;
    const int kbase = iq0 - 128;
    f32x16 S[5];
    const int e0_ = 31 - q + 4 * hi, sft_ = e0_ & 3;
    const LAS float* ext = (const LAS float*)(lds + EXT_OFF) + sft_ * 768 + cfg * 256 + (e0_ - sft_);
#pragma unroll
    for (int a = 0; a < 5; ++a) {
        const int eo = (kbase + 32 * a >= 0) ? 32 * a : 160;
#pragma unroll
        for (int k8 = 0; k8 < 4; ++k8) { const f32x4 ev = *(const LAS f32x4*)(ext + eo + 8 * k8); S[a][4 * k8] = ev[0]; S[a][4 * k8 + 1] = ev[1]; S[a][4 * k8 + 2] = ev[2]; S[a][4 * k8 + 3] = ev[3]; }
    }
    const int tl = d * (iq0 + q) + r - 512 * blk;
    u32x4 A0[2][2], A2[2][2]; float l0 = 0.f, l2 = 0.f;
    if constexpr (MG) {
        l0 = mg.lsc[tl]; l2 = mg.lsc[1024 + tl];
#pragma unroll
        for (int dh = 0; dh < 2; ++dh)
#pragma unroll
            for (int k2 = 0; k2 < 2; ++k2) { A0[dh][k2] = *(const u32x4*)(mg.osc0 + (size_t)tl * 64 + 32 * dh + 16 * k2 + 8 * hi); A2[dh][k2] = *(const u32x4*)(mg.osc2 + (size_t)tl * 64 + 32 * dh + 16 * k2 + 8 * hi); }
    }
    {
        bf16x8 kf[2][4];
#define AT_LDK(buf, a_) do { const int row_ = row0 + 32 * (a_) + q; const LAS unsigned char* kr_ = kl + row_ * 128; const int sw_ = (row_ >> 1) & 7; \
            _Pragma("unroll") for (int d0 = 0; d0 < 4; ++d0) kf[buf][d0] = *(const LAS bf16x8*)(kr_ + (((2 * d0 + hi) ^ sw_) << 4)); } while (0)
        AT_LDK(0, 0);
#pragma unroll
        for (int a = 0; a < 5; ++a) {
            if (a < 4) AT_LDK((a + 1) & 1, a + 1);
#pragma unroll
            for (int d0 = 0; d0 < 4; ++d0) S[a] = __builtin_amdgcn_mfma_f32_32x32x16_bf16(kf[a & 1][d0], qf[d0], S[a], 0, 0, 0);
        }
#undef AT_LDK
    }
    float m = NEG;
#pragma unroll
    for (int a = 0; a < 5; ++a)
#pragma unroll
        for (int rr = 0; rr < 16; ++rr) m = fmaxf(m, S[a][rr]);
    m = halves_max(m);
    float lsum = 0.f;
#pragma unroll
    for (int a = 0; a < 5; ++a)
#pragma unroll
        for (int rr = 0; rr < 16; ++rr) { const float p = __builtin_amdgcn_exp2f(S[a][rr] - m); S[a][rr] = p; lsum += p; }
    lsum = halves_sum(lsum);
    f32x16 o[2];
#pragma unroll
    for (int dh = 0; dh < 2; ++dh)
#pragma unroll
        for (int rr = 0; rr < 16; ++rr) o[dh][rr] = 0.f;
    const LAS unsigned char* vrd = vl + ((lane >> 4) & 1) * 32 + (lane & 3) * 8 + (4 * hi + ((lane & 15) >> 2)) * 64 + (row0 >> 4) * 1024;
    {
        s16x4 vr[2][4];
#define AT_LDV(buf, st_) do { _Pragma("unroll") for (int dh = 0; dh < 2; ++dh) { const LAS unsigned char* vp_ = vrd + dh * vdh + (st_) * 1024; vr[buf][2 * dh] = vtr(vp_); vr[buf][2 * dh + 1] = vtr(vp_ + 512); } } while (0)
        AT_LDV(0, 0);
#pragma unroll
        for (int st = 0; st < 10; ++st) {
            if (st < 9) AT_LDV((st + 1) & 1, st + 1);
            const int a = st >> 1, ks = st & 1;
            u32x4 pw; pw.x = cvtpk(S[a][8 * ks + 0], S[a][8 * ks + 1]); pw.y = cvtpk(S[a][8 * ks + 2], S[a][8 * ks + 3]); pw.z = cvtpk(S[a][8 * ks + 4], S[a][8 * ks + 5]); pw.w = cvtpk(S[a][8 * ks + 6], S[a][8 * ks + 7]);
            const bf16x8 pb = __builtin_bit_cast(bf16x8, pw);
#pragma unroll
            for (int dh = 0; dh < 2; ++dh) {
                const s16x4 lo = vr[st & 1][2 * dh], hh = vr[st & 1][2 * dh + 1];
                const bf16x8 vf = (bf16x8){lo[0], lo[1], lo[2], lo[3], hh[0], hh[1], hh[2], hh[3]};
                o[dh] = __builtin_amdgcn_mfma_f32_32x32x16_bf16(vf, pb, o[dh], 0, 0, 0);
            }
        }
#undef AT_LDV
    }
    const float inv = __builtin_amdgcn_rcpf(lsum);
    if constexpr (MG) {
        const float l1 = m + __builtin_amdgcn_logf(lsum);
        const float mx = fmaxf(l0, fmaxf(l1, l2));
        float w0 = __builtin_amdgcn_exp2f(l0 - mx), w1 = __builtin_amdgcn_exp2f(l1 - mx), w2 = __builtin_amdgcn_exp2f(l2 - mx);
        const float iw = __builtin_amdgcn_rcpf(w0 + w1 + w2); w0 *= iw; w2 *= iw; w1 *= iw * inv;
        float ss = 0.f;
        bf16* arow = mg.a3 + (size_t)tl * 1024;
#pragma unroll
        for (int dh = 0; dh < 2; ++dh)
#pragma unroll
            for (int k2 = 0; k2 < 2; ++k2) {
                uint2 x0[2], x2[2], pk[2]; pair_unswap(A0[dh][k2], x0[0], x0[1]); pair_unswap(A2[dh][k2], x2[0], x2[1]);
#pragma unroll
                for (int i = 0; i < 2; ++i) {
                    const int ob = 8 * k2 + 4 * i;
                    const float v0 = w1 * o[dh][ob] + w0 * __uint_as_float(x0[i].x << 16) + w2 * __uint_as_float(x2[i].x << 16);
                    const float v1 = w1 * o[dh][ob + 1] + w0 * __uint_as_float(x0[i].x & 0xffff0000u) + w2 * __uint_as_float(x2[i].x & 0xffff0000u);
                    const float v2 = w1 * o[dh][ob + 2] + w0 * __uint_as_float(x0[i].y << 16) + w2 * __uint_as_float(x2[i].y << 16);
                    const float v3 = w1 * o[dh][ob + 3] + w0 * __uint_as_float(x0[i].y & 0xffff0000u) + w2 * __uint_as_float(x2[i].y & 0xffff0000u);
                    pk[i].x = cvtpk(v0, v1); pk[i].y = cvtpk(v2, v3);
                    ss += (v0 * v0 + v1 * v1) + (v2 * v2 + v3 * v3);
                }
                *(u32x4*)(arow + 32 * dh + 16 * k2 + 8 * hi) = pair_swap(pk[0], pk[1]);
            }
        ss = halves_sum(ss);
        if (hi == 0) mg.ssq[(size_t)tl * 16] = ss;
        return;
    }
    bf16* orow = osc + (size_t)tl * 64;
#pragma unroll
    for (int dh = 0; dh < 2; ++dh)
#pragma unroll
        for (int k2 = 0; k2 < 2; ++k2) {
            uint2 pa, pb;
            pa.x = cvtpk(o[dh][8 * k2] * inv, o[dh][8 * k2 + 1] * inv); pa.y = cvtpk(o[dh][8 * k2 + 2] * inv, o[dh][8 * k2 + 3] * inv);
            pb.x = cvtpk(o[dh][8 * k2 + 4] * inv, o[dh][8 * k2 + 5] * inv); pb.y = cvtpk(o[dh][8 * k2 + 6] * inv, o[dh][8 * k2 + 7] * inv);
            if (WT) { __hip_atomic_store((unsigned long long*)(orow + 32 * dh + 16 * k2 + 4 * hi), ((unsigned long long)pa.y << 32) | pa.x, __ATOMIC_RELAXED, __HIP_MEMORY_SCOPE_AGENT);
                      __hip_atomic_store((unsigned long long*)(orow + 32 * dh + 16 * k2 + 8 + 4 * hi), ((unsigned long long)pb.y << 32) | pb.x, __ATOMIC_RELAXED, __HIP_MEMORY_SCOPE_AGENT); }
            else *(u32x4*)(orow + 32 * dh + 16 * k2 + 8 * hi) = pair_swap(pa, pb);
        }
    if (hi == 0) { const float lv = m + __builtin_amdgcn_logf(lsum);
        if (WT) __hip_atomic_store(lsrow + tl, lv, __ATOMIC_RELAXED, __HIP_MEMORY_SCOPE_AGENT); else lsrow[tl] = lv; }
}

__device__ __forceinline__ void attn_unit(const Args& a, const Ctx& c, int l, int cslot) {
    const bf16* proj = (const bf16*)(a.ws + WS_PROJ); bf16* A3 = (bf16*)(a.ws + WS_A3);
    const bf16* qh = (const bf16*)(a.ws + WS_QH); const bf16* kh = (const bf16*)(a.ws + WS_KH); const bf16* vh = (const bf16*)(a.ws + WS_VH);
    float* ssqc = (float*)(a.ws + WS_SMALL + SO_SSQC);
    const int xcd = c.wg & 7, j = c.wg >> 3, p = xcd * 8 + (j >> 2), blk = j & 3, b = p >> 3, h = p & 7;
    bf16* osc01 = (bf16*)(a.ws + WS_XA + (size_t)xcd * 4 * MiB) + (size_t)j * (2 * 512 * 64); bf16* osc2 = (bf16*)(a.ws + WS_ACTX + (size_t)xcd * 4 * MiB + 256 * 1024) + (size_t)j * (512 * 64);
    float* lsc = (float*)(a.ws + WS_ACTX + (size_t)xcd * 4 * MiB) + (size_t)j * (3 * 512);
    {
        LAS float* ext = (LAS float*)(c.lds + EXT_OFF); const float* extg = (const float*)(a.ws + WS_SMALL + SO_EXTG) + h * 768;
        for (int x = c.tid; x < 3 * 256; x += NTHREADS) ext[x] = extg[x];
        __syncthreads();
        for (int x = c.tid; x < 3 * 768; x += NTHREADS) {
            const int s = 1 + x / 768, y = x % 768;
            ext[s * 768 + y] = ((y & 255) + s < 256) ? ext[y + s] : NEG;
        }
    }
    const int q = c.lane & 31, hi = c.lane >> 5;
    __syncthreads();
    LAS unsigned char* vbuf = c.lds + 98304 + c.wave * 4096;
    const MergeArgs mga{osc01, osc2, lsc, A3 + ((size_t)b * SEQ + 512 * blk) * 1024 + 512 + h * 64, ssqc + ((size_t)b * SEQ + 512 * blk) * 16 + 8 + h};
#pragma unroll 1
    for (int hf = 0; hf < 2; ++hf) {
        const int kb0 = 512 * blk + 256 * hf - 128, iq0 = 512 * blk + 256 * hf + 32 * c.wave;
        stage_kv(kh, vh, b, h, 1, 0, kb0, 384, c.lds, c.lds + 49152, c.wave, c.lane, 0, 8);
        attn_task(qh, kh, vh, b, h, 2, 2 * c.wave + hf, 32 * blk, blk, c.lds, vbuf, osc2, lsc, c.lane);
        bf16x8 qf[4];
        const size_t rowq = ((size_t)(b * 8 + h) * SEQ + iq0 + q) * 64;
#pragma unroll
        for (int d0 = 0; d0 < 4; ++d0) qf[d0] = *(const bf16x8*)(qh + rowq + 16 * d0 + 8 * hi);
        asm volatile("s_waitcnt vmcnt(0)" ::: "memory");
        __syncthreads();
        attn_task_lds<false, false>(proj, b, h, 0, 0, iq0, blk, qf, c.lds, c.lds + 49152, 384 * 64, 32 * c.wave, c.lds, osc01, lsc, c.lane, mga);
        __syncthreads();
    }
#pragma unroll 1
    for (int rd_ = 0; rd_ < ((P2_REP & 2) ? 4 : 2); ++rd_) { const int rd = rd_ & 1;
        const int kb0 = 128 * blk - 128, s = c.wave >> 2, r = 2 * rd + s, iq0 = 128 * blk + 32 * (c.wave & 3);
        bf16x8 qf[4];
        const size_t rowq = ((size_t)(b * 8 + h) * SEQ + 4 * (iq0 + q) + r) * 64;
#pragma unroll
        for (int d0 = 0; d0 < 4; ++d0) qf[d0] = *(const bf16x8*)(qh + rowq + 16 * d0 + 8 * hi);
        stage_kv(kh, vh, b, h, 4, 2 * rd, kb0, 256, c.lds, c.lds + 65536, c.wave, c.lane, 0, 8);
        stage_kv(kh, vh, b, h, 4, 2 * rd + 1, kb0, 256, c.lds + 32768, c.lds + 65536 + 32768, c.wave, c.lane, 0, 8);
        asm volatile("s_waitcnt vmcnt(0)" ::: "memory");
        __syncthreads();
        attn_task_lds<false, true>(proj, b, h, 1, r, iq0, blk, qf, c.lds + s * 32768, c.lds + 65536 + s * 32768, 256 * 64, 32 * (c.wave & 3), c.lds, osc01 + 512 * 64, lsc + 512, c.lane, mga);
        __syncthreads();
    }
    __syncthreads();
}

__device__ __forceinline__ void gmlp_unit(const Args& a, const Ctx& c, int l) {
    const bf16* proj = (const bf16*)(a.ws + WS_PROJ); bf16* A3 = (bf16*)(a.ws + WS_A3); float* ssqc = (float*)(a.ws + WS_SMALL + SO_SSQC);
    const bf16* wsp = (const bf16*)(a.ws + WS_WS) + (size_t)l * 8 * 128 * 128;
    const float* lng = a.in[I_LNG] + l * 512; const float* lnb = a.in[I_LNB] + l * 512; const float* gbs = a.in[I_GBS] + l * 8 * 128;
    const int bn = (c.wg & 7) * 16 + (c.wg >> 4), hf = (c.wg >> 3) & 1, t0 = bn * CHUNK;
    const int gl = c.wave & 3, th = c.wave >> 2, g = 4 * hf + gl, q = c.lane & 31, hi = c.lane >> 5;
    u32x4 raw[16];
#pragma unroll
    for (int i = 0; i < 16; ++i) raw[i] = *(const u32x4*)(proj + (size_t)(t0 + c.wave * 16 + i) * 1024 + 512 + c.lane * 8);
    const f32x4 g0 = *(const f32x4*)(lng + c.lane * 8), g1 = *(const f32x4*)(lng + c.lane * 8 + 4), b0 = *(const f32x4*)(lnb + c.lane * 8), b1 = *(const f32x4*)(lnb + c.lane * 8 + 4);
    bf16x8 wf[2][8]; u32x4 uw[2][2][2]; float bias[2];
#pragma unroll
    for (int tt = 0; tt < 2; ++tt) {
        const int t = 32 * (2 * th + tt) + q;
        const bf16* wrow = wsp + ((size_t)g * 128 + t) * 128 + 8 * hi;
#pragma unroll
        for (int ks = 0; ks < 8; ++ks) wf[tt][ks] = *(const bf16x8*)(wrow + 16 * ks);
#pragma unroll
        for (int eh = 0; eh < 2; ++eh)
#pragma unroll
            for (int k2 = 0; k2 < 2; ++k2) uw[tt][eh][k2] = *(const u32x4*)(proj + ((size_t)t0 + t) * 1024 + g * 64 + 32 * eh + 16 * k2 + 8 * hi);
        bias[tt] = gbs[g * 128 + t];
    }
    {
        const int e8 = c.lane & 7, glw = (c.lane >> 3) & 3;
#pragma unroll
        for (int i = 0; i < 16; ++i) {
            float v[8]; float sm = 0.f, sq = 0.f;
#pragma unroll
            for (int e = 0; e < 4; ++e) { v[2 * e] = __uint_as_float(raw[i][e] << 16); v[2 * e + 1] = __uint_as_float(raw[i][e] & 0xffff0000u); sm += v[2 * e] + v[2 * e + 1]; sq += v[2 * e] * v[2 * e] + v[2 * e + 1] * v[2 * e + 1]; }
            sm = wave_sum(sm); sq = wave_sum(sq);
            const float mu = sm * (1.0f / 512.0f), var = fmaxf(sq * (1.0f / 512.0f) - mu * mu, 0.f), rs = rsqrtf(var + EPS);
            if (hi == hf) {
                const int s = c.wave * 16 + i;
                u32x4 w;
                w.x = cvtpk((v[0] - mu) * rs * g0[0] + b0[0], (v[1] - mu) * rs * g0[1] + b0[1]); w.y = cvtpk((v[2] - mu) * rs * g0[2] + b0[2], (v[3] - mu) * rs * g0[3] + b0[3]);
                w.z = cvtpk((v[4] - mu) * rs * g1[0] + b1[0], (v[5] - mu) * rs * g1[1] + b1[1]); w.w = cvtpk((v[6] - mu) * rs * g1[2] + b1[2], (v[7] - mu) * rs * g1[3] + b1[3]);
                *(LAS u32x4*)(c.lds + glw * 16384 + (e8 >> 2) * 8192 + (s >> 4) * 1024 + (s & 15) * 64 + (e8 & 3) * 16) = w;
            }
        }
    }
    __syncthreads();
    {
        const LAS unsigned char* vr = c.lds + gl * 16384 + ((c.lane >> 4) & 1) * 32 + (c.lane & 3) * 8 + (4 * hi + ((c.lane & 15) >> 2)) * 64;
#pragma unroll
        for (int tt = 0; tt < 2; ++tt) {
            const int tti = 2 * th + tt, t = 32 * tti + q;
            const size_t tg = (size_t)t0 + t;
            f32x16 acc[2];
#pragma unroll
            for (int eh = 0; eh < 2; ++eh)
#pragma unroll
                for (int rr = 0; rr < 16; ++rr) acc[eh][rr] = 0.f;
#pragma unroll
            for (int ks = 0; ks < 8; ++ks) {
                if (ks < 2 * tti + 2) {
#pragma unroll
                    for (int eh = 0; eh < 2; ++eh) {
                        const s16x4 lo = vtr(vr + eh * 8192 + ks * 1024), hh = vtr(vr + eh * 8192 + ks * 1024 + 512);
                        const bf16x8 vf = (bf16x8){lo[0], lo[1], lo[2], lo[3], hh[0], hh[1], hh[2], hh[3]};
                        acc[eh] = __builtin_amdgcn_mfma_f32_32x32x16_bf16(vf, wf[tt][ks], acc[eh], 0, 0, 0);
                    }
                }
            }
            float ss = 0.f;
#pragma unroll
            for (int eh = 0; eh < 2; ++eh)
#pragma unroll
                for (int k2 = 0; k2 < 2; ++k2) {
                    uint2 uu[2], pk[2]; pair_unswap(uw[tt][eh][k2], uu[0], uu[1]);
#pragma unroll
                    for (int i = 0; i < 2; ++i) { const int k4 = 2 * k2 + i; const uint2 uv = uu[i];
                        const float o0 = (acc[eh][4 * k4] + bias[tt]) * __uint_as_float(uv.x << 16), o1 = (acc[eh][4 * k4 + 1] + bias[tt]) * __uint_as_float(uv.x & 0xffff0000u);
                        const float o2 = (acc[eh][4 * k4 + 2] + bias[tt]) * __uint_as_float(uv.y << 16), o3 = (acc[eh][4 * k4 + 3] + bias[tt]) * __uint_as_float(uv.y & 0xffff0000u);
                        pk[i].x = cvtpk(o0, o1); pk[i].y = cvtpk(o2, o3);
                        ss += (o0 * o0 + o1 * o1) + (o2 * o2 + o3 * o3); }
                    *(u32x4*)(A3 + tg * 1024 + g * 64 + 32 * eh + 16 * k2 + 8 * hi) = pair_swap(pk[0], pk[1]);
                }
            ss = halves_sum(ss);
            if (hi == 0) ssqc[tg * 16 + g] = ss;
        }
    }
    __syncthreads();
}
}
__device__ __forceinline__ void phase_p2_fast(const Args& a, const Ctx& c, int l, int cslot) {
    if (c.wave < 4) __builtin_amdgcn_s_setprio(1);
    p2::attn_unit(a, c, l, cslot);
    p2::gmlp_unit(a, c, l);
    __builtin_amdgcn_s_setprio(0);
    if ((DUP_MASK >> 10) & 1) p2::gmlp_unit(a, c, l);
}

constexpr int NPL = MERGE45 ? 4 : 5;
constexpr int NPHASE = 1 + NPL * DEPTH + 1;
__device__ __forceinline__ Ctx make_ctx(int tid, LAS unsigned char* lds, int zs) {
    Ctx c; c.lds = lds; c.tid = tid; c.lane = tid & 63; c.wave = __builtin_amdgcn_readfirstlane(tid >> 6);
    c.wg = (int)blockIdx.x + zs; c.nwg = (int)gridDim.x + zs; c.gw = c.wg * NWAVES + c.wave; c.ngw = c.nwg * NWAVES; c.gtid = c.wg * NTHREADS + tid; c.ngt = c.nwg * NTHREADS;
    return c;
}
__global__ void __launch_bounds__(NTHREADS, 2) fwd_kernel(Args a0) {
    extern __shared__ __attribute__((aligned(16))) unsigned char lds_raw[];
    LAS unsigned char* const lds0 = (LAS unsigned char*)lds_raw;
    volatile LAS unsigned* MISC = (volatile LAS unsigned*)(lds0 + LDSCTL_OFF);
    int tid_ = threadIdx.x;
    const int wv_ = __builtin_amdgcn_readfirstlane(tid_ >> 6);
    for (int u = tid_; u < (LDS_BYTES - LDSCTL_OFF) / 4; u += NTHREADS) MISC[u] = 0u;
    __syncthreads();
    const int lo = a0.ph_lo, hi = a0.ph_hi;
    XcdBarrier bar; bar.bar = (unsigned*)(a0.ws + WS_CTL) + CW_BAR; bar.x = 0; bar.st = MISC + 8;
    if (hi - lo > 1) bar = xcd_barrier_post((unsigned*)(a0.ws + WS_CTL) + CW_BAR, MISC + 8, tid_);
    if (tid_ == 0) __hip_atomic_store((unsigned*)(a0.ws + WS_CTL) + CW_XT + blockIdx.x, xb_xcc_id() + 1u, __ATOMIC_RELAXED, __HIP_MEMORY_SCOPE_AGENT);
    int pure = 0;
    int ph = 0;
#define RUN_PHASE(kind, body) do { if (ph >= lo && ph < hi) { for (int rep_ = 0; rep_ < (((DUP_MASK >> (kind)) & 1) ? 2 : 1); ++rep_) { int zs_ = 0; asm volatile("" : "+s"(zs_)); Args a = a0; \
        _Pragma("unroll") for (int i_ = 0; i_ < 21; ++i_) a.in[i_] = a0.in[i_] + zs_; a.out = a0.out + zs_; a.ws = a0.ws + zs_; \
        tid_ = wv_ * 64 + (int)__builtin_amdgcn_mbcnt_hi(~0u, __builtin_amdgcn_mbcnt_lo(~0u, (unsigned)zs_)); asm volatile("" : "+v"(tid_)); const Ctx c = make_ctx(tid_, lds0 + zs_, zs_); body; if (ph + 1 < hi || rep_ == 0 && ((DUP_MASK >> (kind)) & 1)) { \
            if (((kind) == 2 || (kind) == 3) && pure && DUP_MASK == 0) group_barrier((unsigned*)(a0.ws + WS_CTL), ((ph - 1) / NPL) * 2 + ((kind) - 2), (int)blockIdx.x + zs_, tid_); else xcd_barrier(bar, tid_); } } } ++ph; } while (0)
    RUN_PHASE(0, { phase_p0a(a, c); phase_p0b(a, c); });
    if (lo == 0 && hi == NPHASE && gridDim.x == 256) {
        tid_ = wv_ * 64 + (int)__builtin_amdgcn_mbcnt_hi(~0u, __builtin_amdgcn_mbcnt_lo(~0u, 0u));
        if (tid_ < 256) { unsigned* xt = (unsigned*)(a0.ws + WS_CTL) + CW_XT; const unsigned v = xb_ld(xt + tid_), r = xb_ld(xt + (tid_ & 7)); if (v != r || v == 0u) MISC[13] = 1u; }
        __syncthreads();
        pure = __builtin_amdgcn_readfirstlane(MISC[13] == 0u ? 1 : 0);
    }
    for (int l = 0; l < DEPTH; ++l) {
        RUN_PHASE(2, phase_p1_fast(a, c, l));
        RUN_PHASE(3, phase_p2_fast(a, c, l, l + 2 * rep_));
        RUN_PHASE(4, phase_p3_fast(a, c, l, l + 2 * rep_, pure));
#if MERGE45
        RUN_PHASE(6, phase_p45(a, c, l, l + 2 * rep_, pure));
#else
        RUN_PHASE(6, phase_p4_fast(a, c, l));
        RUN_PHASE(7, phase_p5_fast(a, c, l));
#endif
    }
    RUN_PHASE(8, phase_p6(a, c));
#undef RUN_PHASE
}

extern "C" void kernel_launch(void* const* d_in, const int* in_sizes, int n_in, void* d_out, int out_size, void* d_ws, size_t ws_size, hipStream_t stream) {
    static int grid = 0;
    if (grid == 0) {
        if (n_in != 21 || out_size != T * D || ws_size < WS_END) { fprintf(stderr, "kernel_launch: unexpected shapes (n_in %d, out %d, ws %zu)\n", n_in, out_size, ws_size); grid = -1; return; }
        int dev = 0, cus = 0, per_cu = 0;
        if (hipGetDevice(&dev) != hipSuccess || hipDeviceGetAttribute(&cus, hipDeviceAttributeMultiprocessorCount, dev) != hipSuccess) { grid = -1; return; }
        if (hipFuncSetAttribute((const void*)fwd_kernel, hipFuncAttributeMaxDynamicSharedMemorySize, LDS_BYTES) != hipSuccess) { fprintf(stderr, "kernel_launch: hipFuncSetAttribute failed\n"); grid = -1; return; }
        if (hipOccupancyMaxActiveBlocksPerMultiprocessor(&per_cu, (const void*)fwd_kernel, NTHREADS, LDS_BYTES) != hipSuccess || per_cu < 1)
            fprintf(stderr, "kernel_launch: occupancy query reports %d workgroups per CU\n", per_cu);
        (void)hipGetLastError();
        grid = cus;
    }
    if (grid < 0) return;
    if (hipMemsetAsync((char*)d_ws + WS_CTL, 0, CTL_BYTES, stream) != hipSuccess) return;
    Args a{};
    for (int i = 0; i < 21; ++i) a.in[i] = (const float*)d_in[i];
    a.out = (float*)d_out; a.ws = (unsigned char*)d_ws;
#if N_LAUNCH_MODE == 1
    a.ph_lo = 0; a.ph_hi = NPHASE;
    hipLaunchKernelGGL(fwd_kernel, dim3(grid), dim3(NTHREADS), LDS_BYTES, stream, a);
#else
    for (int ph = 0; ph < NPHASE; ++ph) {
        a.ph_lo = ph; a.ph_hi = ph + 1;
        hipLaunchKernelGGL(fwd_kernel, dim3(grid), dim3(NTHREADS), LDS_BYTES, stream, a);
    }
#endif
}
```
